# Optimizing an MI355X kernel written in HIP

```python
import math
import jax, jax.numpy as jnp
from jax import lax
import numpy as np

D_MODEL = 1024
BATCH = 4
SEQ = 4096
DEPTH = 1
DEC_BATCH = 32
DEC_SEQ = 4
PAST_LEN = 8192
PAGE_SIZE = 128

D_CONV = D_MODEL // 2
CONV_GROUPS = 8
CONV_W = 3
N_HEADS = 4
HEAD_DK = 64
HEAD_DV = 2 * HEAD_DK
D_ATTN = N_HEADS * HEAD_DV
D_MIX = D_CONV + D_ATTN
D_IN = 3 * D_CONV + 3 * D_ATTN
N_MEM = 256
MEM_HEADS = 4
MEM_DH = D_MODEL // MEM_HEADS
D_FF = 2816
FFN_W = 3
REL_BUCKETS = 32
REL_MAX_EXACT = 16
REL_MAX_DIST = 128
Q_BLOCK = 128
EPS = 1e-6
NEG = -1e30

kernel_name = "hymba_conv_diffattn_decoder_step"


def rmsnorm(x, w):
    xf = x.astype(jnp.float32)
    y = xf * lax.rsqrt(jnp.mean(xf * xf, axis=-1, keepdims=True) + EPS)
    return (y * w.astype(jnp.float32)).astype(x.dtype)


def causal_dwconv(x, prefix, w, b):
    width = w.shape[0]
    t = x.shape[1]
    xp = jnp.concatenate([prefix.astype(x.dtype), x], axis=1)
    y = b
    for j in range(width):
        y = y + w[j] * xp[:, j:j + t]
    return y, xp[:, -(width - 1):]


def t5_bucket(rel):
    n = jnp.maximum(rel, 0)
    nf = jnp.maximum(n, 1).astype(jnp.float32)
    large = REL_MAX_EXACT + (jnp.log(nf / REL_MAX_EXACT) / math.log(REL_MAX_DIST / REL_MAX_EXACT)
                             * (REL_BUCKETS - REL_MAX_EXACT)).astype(jnp.int32)
    large = jnp.minimum(large, REL_BUCKETS - 1)
    return jnp.where(n < REL_MAX_EXACT, n, large)


def diff_attn_core(q, k, v, q_pos, k_pos, rel_bias, lam):
    rel = q_pos[:, None] - k_pos[None, :]
    bias = rel_bias[t5_bucket(rel)].astype(jnp.float32)
    bias = jnp.where((rel >= 0)[..., None], bias, NEG)
    bias = jnp.transpose(bias, (2, 0, 1))[None, :, None]
    s = jnp.einsum('bqhcd,bkhcd->bhcqk', q, k).astype(jnp.float32) * (HEAD_DK ** -0.5) + bias
    p = jax.nn.softmax(s, axis=-1)
    a = p[:, :, 0] - lam * p[:, :, 1]
    return jnp.einsum('bhqk,bkhd->bqhd', a.astype(v.dtype), v)


def diff_attn_prompt(q, k, v, rel_bias, lam):
    b, s = q.shape[0], q.shape[1]
    nb = s // Q_BLOCK
    qb = jnp.transpose(q.reshape(b, nb, Q_BLOCK, N_HEADS, 2, HEAD_DK), (1, 0, 2, 3, 4, 5))
    k_pos = jnp.arange(s)

    def block(args):
        i, q_i = args
        q_pos = i * Q_BLOCK + jnp.arange(Q_BLOCK)
        return diff_attn_core(q_i, k, v, q_pos, k_pos, rel_bias, lam)

    out = lax.map(block, (jnp.arange(nb), qb))
    return jnp.transpose(out, (1, 0, 2, 3, 4)).reshape(b, s, N_HEADS, HEAD_DV)


def split_mix(z):
    o = [0, D_CONV, 2 * D_CONV, 3 * D_CONV, 3 * D_CONV + D_ATTN, 3 * D_CONV + 2 * D_ATTN, D_IN]
    return [z[..., o[i]:o[i + 1]] for i in range(6)]


def head_norm(o, w, lam_init):
    o = rmsnorm(o, w) * (1.0 - lam_init)
    return o.reshape(o.shape[0], o.shape[1], D_ATTN)


def memory_kv(mem, norm_mem_w, w_ckv):
    kv = rmsnorm(mem, norm_mem_w) @ w_ckv
    b, m = mem.shape[0], mem.shape[1]
    return (kv[..., :D_MODEL].reshape(b, m, MEM_HEADS, MEM_DH),
            kv[..., D_MODEL:].reshape(b, m, MEM_HEADS, MEM_DH))


def cross_attn(h, mk, mv, w_cq, w_co):
    b, t = h.shape[0], h.shape[1]
    q = (h @ w_cq).reshape(b, t, MEM_HEADS, MEM_DH)
    s = jnp.einsum('bqhd,bkhd->bhqk', q, mk).astype(jnp.float32) * (MEM_DH ** -0.5)
    p = jax.nn.softmax(s, axis=-1)
    o = jnp.einsum('bhqk,bkhd->bqhd', p.astype(mv.dtype), mv).reshape(b, t, D_MODEL)
    return o @ w_co


def conv_ffn(h, prefix, w_up, conv_w, conv_b, w_down):
    up = h @ w_up
    c, new_state = causal_dwconv(up, prefix, conv_w, conv_b)
    g, u = c[..., :D_FF], c[..., D_FF:]
    return (jax.nn.silu(g) * u) @ w_down, new_state


def setup_inputs(seed: int = 0) -> dict:
    key = jax.random.key(seed)
    ks = jax.random.split(key, 40)
    n_pages = PAST_LEN // PAGE_SIZE
    n_used = DEC_BATCH * n_pages
    n_phys = n_used + n_used // 4
    f32 = jnp.float32

    def nrm(k, shape, scale=1.0):
        return jax.random.normal(k, shape, f32) * scale

    page_table = jax.random.permutation(ks[0], n_phys)[:n_used].reshape(DEC_BATCH, n_pages).astype(jnp.int32)
    return {
        "x_prompt": nrm(ks[1], (BATCH, SEQ, D_MODEL)),
        "x_sample": nrm(ks[2], (DEC_BATCH, DEC_SEQ, D_MODEL)),
        "mem_prompt": nrm(ks[3], (BATCH, N_MEM, D_MODEL)),
        "cache_k": nrm(ks[4], (DEPTH, n_phys, PAGE_SIZE, N_HEADS, 2 * HEAD_DK)),
        "cache_v": nrm(ks[5], (DEPTH, n_phys, PAGE_SIZE, N_HEADS, HEAD_DV)),
        "page_table": page_table,
        "state_conv_mix": nrm(ks[6], (DEPTH, DEC_BATCH, CONV_W - 1, D_CONV)),
        "state_conv_ffn": nrm(ks[7], (DEPTH, DEC_BATCH, FFN_W - 1, 2 * D_FF)),
        "cache_mem_k": nrm(ks[8], (DEPTH, DEC_BATCH, N_MEM, MEM_HEADS, MEM_DH)),
        "cache_mem_v": nrm(ks[9], (DEPTH, DEC_BATCH, N_MEM, MEM_HEADS, MEM_DH)),
        "rel_bias": nrm(ks[10], (REL_BUCKETS, N_HEADS), 0.5),
        "norm_mix_w": 1.0 + nrm(ks[11], (DEPTH, D_MODEL), 0.02),
        "w_in": nrm(ks[12], (DEPTH, D_MODEL, D_IN), D_MODEL ** -0.5),
        "conv_mix_w": nrm(ks[13], (DEPTH, CONV_W, D_CONV), CONV_W ** -0.5),
        "conv_mix_b": nrm(ks[14], (DEPTH, D_CONV), 0.02),
        "lambda_q1": nrm(ks[15], (DEPTH, HEAD_DK), 0.1),
        "lambda_k1": nrm(ks[16], (DEPTH, HEAD_DK), 0.1),
        "lambda_q2": nrm(ks[17], (DEPTH, HEAD_DK), 0.1),
        "lambda_k2": nrm(ks[18], (DEPTH, HEAD_DK), 0.1),
        "subln_w": 1.0 + nrm(ks[19], (DEPTH, HEAD_DV), 0.02),
        "w_out": nrm(ks[20], (DEPTH, D_MIX, D_MODEL), D_MIX ** -0.5),
        "norm_cross_w": 1.0 + nrm(ks[21], (DEPTH, D_MODEL), 0.02),
        "norm_mem_w": 1.0 + nrm(ks[22], (DEPTH, D_MODEL), 0.02),
        "w_cq": nrm(ks[23], (DEPTH, D_MODEL, D_MODEL), D_MODEL ** -0.5),
        "w_ckv": nrm(ks[24], (DEPTH, D_MODEL, 2 * D_MODEL), D_MODEL ** -0.5),
        "w_co": nrm(ks[25], (DEPTH, D_MODEL, D_MODEL), D_MODEL ** -0.5),
        "norm_ffn_w": 1.0 + nrm(ks[26], (DEPTH, D_MODEL), 0.02),
        "w_up": nrm(ks[27], (DEPTH, D_MODEL, 2 * D_FF), D_MODEL ** -0.5),
        "conv_ffn_w": nrm(ks[28], (DEPTH, FFN_W, 2 * D_FF), FFN_W ** -0.5),
        "conv_ffn_b": nrm(ks[29], (DEPTH, 2 * D_FF), 0.02),
        "w_down": nrm(ks[30], (DEPTH, D_FF, D_MODEL), D_FF ** -0.5),
        "norm_final_w": 1.0 + nrm(ks[31], (D_MODEL,), 0.02),
    }


def reference(x_prompt, x_sample, mem_prompt, cache_k, cache_v, page_table, state_conv_mix,
              state_conv_ffn, cache_mem_k, cache_mem_v, rel_bias, norm_mix_w, w_in, conv_mix_w,
              conv_mix_b, lambda_q1, lambda_k1, lambda_q2, lambda_k2, subln_w, w_out,
              norm_cross_w, norm_mem_w, w_cq, w_ckv, w_co, norm_ffn_w, w_up, conv_ffn_w,
              conv_ffn_b, w_down, norm_final_w):
    n_pages = PAST_LEN // PAGE_SIZE
    bp, sp = x_prompt.shape[0], x_prompt.shape[1]
    bs, ts = x_sample.shape[0], x_sample.shape[1]
    xp, xs = x_prompt, x_sample
    kp_l, vp_l, ks_l, vs_l = [], [], [], []
    cmp_l, cms_l, cfp_l, cfs_l, mkp_l, mvp_l = [], [], [], [], [], []
    for l in range(DEPTH):
        lam_init = 0.8 - 0.6 * math.exp(-0.3 * l)
        lam = (jnp.exp(jnp.sum(lambda_q1[l].astype(jnp.float32) * lambda_k1[l].astype(jnp.float32)))
               - jnp.exp(jnp.sum(lambda_q2[l].astype(jnp.float32) * lambda_k2[l].astype(jnp.float32)))
               + lam_init)

        gbp, gcp, up_, qp, kp, vp = split_mix(rmsnorm(xp, norm_mix_w[l]) @ w_in[l])
        gbs, gcs, us, qs, kn, vn = split_mix(rmsnorm(xs, norm_mix_w[l]) @ w_in[l])

        pre_p = gcp * up_
        cp, conv_mix_p = causal_dwconv(pre_p, jnp.zeros((bp, CONV_W - 1, D_CONV), pre_p.dtype),
                                       conv_mix_w[l], conv_mix_b[l])
        yconv_p = gbp * cp
        cs, conv_mix_s = causal_dwconv(gcs * us, state_conv_mix[l], conv_mix_w[l], conv_mix_b[l])
        yconv_s = gbs * cs

        qp5 = qp.reshape(bp, sp, N_HEADS, 2, HEAD_DK)
        kp4 = kp.reshape(bp, sp, N_HEADS, 2 * HEAD_DK)
        vp4 = vp.reshape(bp, sp, N_HEADS, HEAD_DV)
        op = diff_attn_prompt(qp5, kp4.reshape(bp, sp, N_HEADS, 2, HEAD_DK), vp4, rel_bias, lam)
        yattn_p = head_norm(op, subln_w[l], lam_init)

        qs5 = qs.reshape(bs, ts, N_HEADS, 2, HEAD_DK)
        kn4 = kn.reshape(bs, ts, N_HEADS, 2 * HEAD_DK)
        vn4 = vn.reshape(bs, ts, N_HEADS, HEAD_DV)
        k_past = cache_k[l][page_table].reshape(bs, n_pages * PAGE_SIZE, N_HEADS, 2 * HEAD_DK)
        v_past = cache_v[l][page_table].reshape(bs, n_pages * PAGE_SIZE, N_HEADS, HEAD_DV)
        k_all = jnp.concatenate([k_past.astype(kn4.dtype), kn4], axis=1)
        v_all = jnp.concatenate([v_past.astype(vn4.dtype), vn4], axis=1)
        q_pos = PAST_LEN + jnp.arange(ts)
        k_pos = jnp.arange(PAST_LEN + ts)
        os_ = diff_attn_core(qs5, k_all.reshape(bs, PAST_LEN + ts, N_HEADS, 2, HEAD_DK), v_all,
                             q_pos, k_pos, rel_bias, lam)
        yattn_s = head_norm(os_, subln_w[l], lam_init)

        xp = xp + jnp.concatenate([yconv_p, yattn_p], axis=-1) @ w_out[l]
        xs = xs + jnp.concatenate([yconv_s, yattn_s], axis=-1) @ w_out[l]

        mkp, mvp = memory_kv(mem_prompt, norm_mem_w[l], w_ckv[l])
        xp = xp + cross_attn(rmsnorm(xp, norm_cross_w[l]), mkp, mvp, w_cq[l], w_co[l])
        xs = xs + cross_attn(rmsnorm(xs, norm_cross_w[l]), cache_mem_k[l].astype(xs.dtype),
                             cache_mem_v[l].astype(xs.dtype), w_cq[l], w_co[l])

        fp, conv_ffn_p = conv_ffn(rmsnorm(xp, norm_ffn_w[l]),
                                  jnp.zeros((bp, FFN_W - 1, 2 * D_FF), xp.dtype),
                                  w_up[l], conv_ffn_w[l], conv_ffn_b[l], w_down[l])
        fs, conv_ffn_s = conv_ffn(rmsnorm(xs, norm_ffn_w[l]), state_conv_ffn[l],
                                  w_up[l], conv_ffn_w[l], conv_ffn_b[l], w_down[l])
        xp = xp + fp
        xs = xs + fs

        kp_l.append(kp4); vp_l.append(vp4); ks_l.append(kn4); vs_l.append(vn4)
        cmp_l.append(conv_mix_p); cms_l.append(conv_mix_s)
        cfp_l.append(conv_ffn_p); cfs_l.append(conv_ffn_s)
        mkp_l.append(mkp); mvp_l.append(mvp)

    y_prompt = rmsnorm(xp, norm_final_w)
    y_sample = rmsnorm(xs, norm_final_w)
    return (y_prompt, y_sample, jnp.stack(kp_l), jnp.stack(vp_l), jnp.stack(ks_l), jnp.stack(vs_l),
            jnp.stack(cmp_l), jnp.stack(cms_l), jnp.stack(cfp_l), jnp.stack(cfs_l),
            jnp.stack(mkp_l), jnp.stack(mvp_l))
```

```cpp
#include <hip/hip_runtime.h>
#include <cstdio>
#include <cstdint>

#ifndef MK_PER_PHASE
#define MK_PER_PHASE 0
#endif

constexpr int DM = 1024, NB = 4, SEQ = 4096, MP = NB * SEQ;
constexpr int DB = 32, DS = 4, MS = DB * DS;
constexpr int MREAL = MP + MS, MT = 16640;
constexpr int PAST = 8192, PAGE = 128, NPAGES = PAST / PAGE;
constexpr int DCONV = 512, NH = 4, HDK = 64, HDV = 128, DATT = 512, DIN = 3072;
constexpr int NMEM = 256, MHEADS = 4, MDH = 256, DFF = 2816, DUP = 2 * DFF;
constexpr float EPS = 1e-6f, LOG2E = 1.4426950408889634f;
constexpr float QSC = 0.125f * LOG2E;
constexpr float CQSC = 0.0625f * LOG2E;
constexpr float LAM_INIT = 0.2f;
constexpr size_t O_Y = 0, O_YS = 16777216, O_KP = 16908288, O_VP = 25296896, O_KS = 33685504, O_VS = 33751040,
                 O_CMP = 33816576, O_CMS = 33820672, O_CFP = 33853440, O_CFS = 33898496, O_MK = 34258944, O_MV = 35307520, O_END = 36356096;
namespace pg8 {
#define PG8_LAS __attribute__((address_space(3)))
typedef unsigned short bf16_t;
typedef short bf16x8 __attribute__((ext_vector_type(8)));
typedef float f32x4 __attribute__((ext_vector_type(4)));
typedef unsigned u32x4 __attribute__((ext_vector_type(4)));
constexpr int BM = 256, BK = 64, HALF = 128, HTB = HALF * BK * 2  , STAGE_BYTES = 8 * HTB, NXCD = 8, WGM = 8;

__host__ __device__ __forceinline__ int lds_byte(int r, int c) { const int st = (r >> 4) * 2 + (c >> 5), rr = r & 15, cc = c & 31, ob = rr * 64 + cc * 2; return st * 1024 + (ob ^ (((ob >> 9) & 1) << 5)); }
__host__ __device__ __forceinline__ void stage_rc(int b, int& R, int& C) { const int st = b / 1024, sb = b % 1024, swz = sb ^ (((sb >> 9) & 1) << 5); R = (st >> 1) * 16 + swz / 64; C = (st & 1) * 32 + (swz % 64) / 2; }
__host__ __device__ __forceinline__ int perm32(int rho) { const int n = rho >> 4, i = rho & 15; return 8 * (i >> 2) + 4 * n + (i & 3); }

struct Unit { int pm, pn; };
struct Gemm { const bf16_t* A; const bf16_t* Bt; int M, N, K; };

struct StaticOrder {
    int nM, nN, nwg, G, c;
    __host__ __device__ void init(int M, int N, int G_, int c_) { nM = M / BM; nN = N / BM; nwg = nM * nN; G = G_; c = c_; }
    __host__ __device__ bool next(int i, Unit& u) const {
        const long L = (long)i * G + c; if (L >= nwg) return false;
        int wgid = (int)L; { const int q = nwg / NXCD, r = nwg % NXCD, xcd = wgid % NXCD, off = wgid / NXCD; wgid = (xcd < r ? xcd * (q + 1) : r * (q + 1) + (xcd - r) * q) + off; }
        const int nig = WGM * nN, gid = wgid / nig, fm = gid * WGM, gsz = (nM - fm) < WGM ? (nM - fm) : WGM;
        u.pm = fm + ((wgid % nig) % gsz); u.pn = (wgid % nig) / gsz; return true;
    }
    __device__ __forceinline__ void a_ready(const Unit&) const {}
    __device__ __forceinline__ void done(const Unit&) const {}
};

__device__ __forceinline__ unsigned cvt_pk_bf16(float lo, float hi) { unsigned r; asm volatile("v_cvt_pk_bf16_f32 %0, %1, %2" : "=v"(r) : "v"(lo), "v"(hi)); return r; }
__device__ __forceinline__ u32x4 pack8(const f32x4 a, const f32x4 b) { u32x4 w; w.x = cvt_pk_bf16(a[0], a[1]); w.y = cvt_pk_bf16(a[2], a[3]); w.z = cvt_pk_bf16(b[0], b[1]); w.w = cvt_pk_bf16(b[2], b[3]); return w; }
__device__ __forceinline__ float dot4(const f32x4 a) { return (a[0] * a[0] + a[1] * a[1]) + (a[2] * a[2] + a[3] * a[3]); }

struct EpiIn {
    static constexpr bool PERM = true, AFTER_DRAIN = false;
    const float* r0; bf16_t* zconv; bf16_t* qb; bf16_t* kb; bf16_t* vb; float* out;
    __device__ __forceinline__ void operator()(const f32x4 (&acc)[2][2][4][2], const Unit& u, int wr, int wc, int fr, int fq) const {
        const int pn = u.pn;
#pragma unroll
        for (int ai = 0; ai < 2; ++ai)
#pragma unroll
            for (int m = 0; m < 4; ++m) {
                const int row = u.pm * BM + ai * HALF + wr * 64 + m * 16 + fr;
                if (row < MREAL) {
                    const float rs = r0[row];
#pragma unroll
                    for (int bj = 0; bj < 2; ++bj) {
                        const int col = pn * BM + bj * HALF + wc * 32 + 8 * fq;
                        const f32x4 v0 = acc[ai][bj][m][0] * rs, v1 = acc[ai][bj][m][1] * rs;
                        if (pn < 6) { *(u32x4*)(zconv + (size_t)row * 1536 + col) = pack8(v0, v1); }
                        else if (pn < 8) { *(u32x4*)(qb + (size_t)row * 512 + (col - 1536)) = pack8(v0 * QSC, v1 * QSC); }
                        else { const bool isk = pn < 10; const int c = col - (isk ? 2048 : 2560);
                            *(u32x4*)((isk ? kb : vb) + (size_t)row * 512 + c) = pack8(v0, v1);
                            float* o = out + (row < MP ? (isk ? O_KP : O_VP) + (size_t)row * 512 : (isk ? O_KS : O_VS) + (size_t)(row - MP) * 512) + c;
                            *(f32x4*)o = v0; *(f32x4*)(o + 4) = v1; }
                    }
                }
            }
    }
};
struct EpiMem {
    static constexpr bool PERM = true, AFTER_DRAIN = false;
    const float* rmem; bf16_t* mkb; bf16_t* mvb; float* out;
    __device__ __forceinline__ void operator()(const f32x4 (&acc)[2][2][4][2], const Unit& u, int wr, int wc, int fr, int fq) const {
        const int pn = u.pn; const bool isk = pn < 4;
#pragma unroll
        for (int ai = 0; ai < 2; ++ai)
#pragma unroll
            for (int m = 0; m < 4; ++m) {
                const int row = u.pm * BM + ai * HALF + wr * 64 + m * 16 + fr;
                const float rs = rmem[row];
#pragma unroll
                for (int bj = 0; bj < 2; ++bj) {
                    const int col = (pn & 3) * BM + bj * HALF + wc * 32 + 8 * fq;
                    const f32x4 v0 = acc[ai][bj][m][0] * rs, v1 = acc[ai][bj][m][1] * rs;
                    *(u32x4*)((isk ? mkb : mvb) + (size_t)row * 1024 + col) = pack8(v0, v1);
                    float* o = out + (isk ? O_MK : O_MV) + (size_t)row * 1024 + col;
                    *(f32x4*)o = v0; *(f32x4*)(o + 4) = v1;
                }
            }
    }
};
struct EpiRes {
    static constexpr bool PERM = true, AFTER_DRAIN = false;
    const float* resP; const float* resS; float* xo; bf16_t* xob; float* ss;
    __device__ __forceinline__ void operator()(const f32x4 (&acc)[2][2][4][2], const Unit& u, int wr, int wc, int fr, int fq) const {
        const int pn = u.pn;
#pragma unroll
        for (int ai = 0; ai < 2; ++ai)
#pragma unroll
            for (int m = 0; m < 4; ++m) {
                const int row = u.pm * BM + ai * HALF + wr * 64 + m * 16 + fr;
                const bool valid = row < MREAL;
                const float* rp = row < MP ? resP + (size_t)row * 1024 : resS + (size_t)(row - MP) * 1024;
                float sq = 0.f;
#pragma unroll
                for (int bj = 0; bj < 2; ++bj) {
                    const int col = pn * BM + bj * HALF + wc * 32 + 8 * fq;
                    f32x4 a = (f32x4){0.f, 0.f, 0.f, 0.f}, b = a;
                    if (valid) { a = *(const f32x4*)(rp + col); b = *(const f32x4*)(rp + col + 4); }
                    const f32x4 o0 = a + acc[ai][bj][m][0], o1 = b + acc[ai][bj][m][1];
                    if (valid) { float* xp = xo + (size_t)row * 1024 + col; *(f32x4*)xp = o0; *(f32x4*)(xp + 4) = o1;
                        if (xob) *(u32x4*)(xob + (size_t)row * 1024 + col) = pack8(o0, o1); }
                    sq += dot4(o0) + dot4(o1);
                }
                sq += __shfl_xor(sq, 16); sq += __shfl_xor(sq, 32);
                if (valid && fq == 0) ss[(size_t)row * 16 + pn * 4 + wc] = sq;
            }
    }
};
struct EpiScale {
    static constexpr bool PERM = true, AFTER_DRAIN = false;
    const float* ss; bf16_t* O; int ldc; float cs;
    __device__ __forceinline__ void operator()(const f32x4 (&acc)[2][2][4][2], const Unit& u, int wr, int wc, int fr, int fq) const {
        const int pn = u.pn;
#pragma unroll
        for (int ai = 0; ai < 2; ++ai)
#pragma unroll
            for (int m = 0; m < 4; ++m) {
                const int row = u.pm * BM + ai * HALF + wr * 64 + m * 16 + fr;
                const f32x4* sp = (const f32x4*)(ss + (size_t)row * 16);
                const f32x4 s0 = sp[0], s1 = sp[1], s2 = sp[2], s3 = sp[3];
                const float tot = ((s0[0] + s0[1]) + (s0[2] + s0[3])) + ((s1[0] + s1[1]) + (s1[2] + s1[3])) + ((s2[0] + s2[1]) + (s2[2] + s2[3])) + ((s3[0] + s3[1]) + (s3[2] + s3[3]));
                const float rs = cs / sqrtf(fmaxf(tot, 0.f) * (1.0f / 1024.0f) + EPS);
#pragma unroll
                for (int bj = 0; bj < 2; ++bj) {
                    const int col = pn * BM + bj * HALF + wc * 32 + 8 * fq;
                    *(u32x4*)(O + (size_t)row * ldc + col) = pack8(acc[ai][bj][m][0] * rs, acc[ai][bj][m][1] * rs);
                }
            }
    }
};
template <class Epi, class Sched, bool ALIGN_EPI = false, bool SP2 = false>
__device__ __forceinline__ void gemm_phase(PG8_LAS unsigned char* lds, const Gemm g, const Sched& S, const Epi& E) {
    const int tid = threadIdx.x, wid = __builtin_amdgcn_readfirstlane(tid >> 6), lane = tid & 63, wr = wid >> 2, wc = wid & 3, fr = lane & 15, fq = lane >> 4;
    const int K = g.K, nt = K / BK;
    unsigned voffA[2], voffB[2];
#pragma unroll
    for (int i = 0; i < 2; ++i) { int R, C; stage_rc(tid * 16 + i * 8192, R, C); const int Rb = Epi::PERM ? ((R & ~31) + perm32(R & 31)) : R;
        voffA[i] = (unsigned)(R * K + C) * 2u; voffB[i] = (unsigned)(Rb * K + C) * 2u; }
    const size_t kstep = (size_t)(BK * 2);
    const size_t hstep = (size_t)HALF * K * 2;
    const size_t tstep = 2 * hstep;
    const unsigned ldsw = (unsigned)wid * 1024u;
    const int aoff = lds_byte(wr * 64 + fr, fq * 8), boff = lds_byte(wc * 32 + fr, fq * 8);
#define PG8_SA(b, h) (((b) * 2 + (h)) * HTB)
#define PG8_SB(b, h) ((4 + (b) * 2 + (h)) * HTB)
#define PG8_STAGE(bufoff, gbase, voff) do { _Pragma("unroll") for (int _i = 0; _i < 2; ++_i) \
        __builtin_amdgcn_global_load_lds((const unsigned*)((const char*)(gbase) + (voff)[_i]), (PG8_LAS unsigned*)(lds + (bufoff) + ldsw + _i * 8192), 16, 0, 0); } while (0)
#define PG8_LDA(dst, b, h) do { _Pragma("unroll") for (int m = 0; m < 4; ++m) _Pragma("unroll") for (int k = 0; k < 2; ++k) dst[m][k] = *(const PG8_LAS bf16x8*)(lds + PG8_SA(b, h) + aoff + m * 2048 + k * 1024); } while (0)
#define PG8_LDB(dst, b, h) do { _Pragma("unroll") for (int n = 0; n < 2; ++n) _Pragma("unroll") for (int k = 0; k < 2; ++k) dst[n][k] = *(const PG8_LAS bf16x8*)(lds + PG8_SB(b, h) + boff + n * 2048 + k * 1024); } while (0)
#define PG8_MMA(ai, bj, At, Bt) do { __builtin_amdgcn_s_setprio(1); _Pragma("unroll") for (int m = 0; m < 4; ++m) _Pragma("unroll") for (int n = 0; n < 2; ++n) _Pragma("unroll") for (int k = 0; k < 2; ++k) \
        acc[ai][bj][m][n] = __builtin_amdgcn_mfma_f32_16x16x32_bf16(Bt[n][k], At[m][k], acc[ai][bj][m][n], 0, 0, 0); __builtin_amdgcn_s_setprio(0); } while (0)
#define PG8_WAIT_V(n) asm volatile("s_waitcnt vmcnt(" #n ")" ::: "memory")
#define PG8_WAIT_L(n) asm volatile("s_waitcnt lgkmcnt(" #n ")" ::: "memory")
#define PG8_BAR __builtin_amdgcn_s_barrier()
#define PG8_SCHED __builtin_amdgcn_sched_barrier(0)
    Unit cur, nxt; int ui = 0;
    if (!S.next(0, cur)) return;
    f32x4 acc[2][2][4][2];
#pragma unroll
    for (int a = 0; a < 2; ++a)
#pragma unroll
        for (int b = 0; b < 2; ++b)
#pragma unroll
            for (int m = 0; m < 4; ++m)
#pragma unroll
                for (int n = 0; n < 2; ++n) acc[a][b][m][n] = (f32x4){0.f, 0.f, 0.f, 0.f};
    bf16x8 At[4][2], B0[2][2], B1[2][2];
    const char* cA = (const char*)g.A + (size_t)cur.pm * tstep; const char* cB = (const char*)g.Bt + (size_t)cur.pn * tstep;
    S.a_ready(cur);
    if constexpr (SP2) {
        PG8_STAGE(PG8_SB(0, 0), cB, voffB); PG8_STAGE(PG8_SB(0, 1), cB + hstep, voffB); PG8_STAGE(PG8_SA(0, 0), cA, voffA); PG8_STAGE(PG8_SA(0, 1), cA + hstep, voffA);
        if (wr == 1) PG8_BAR;
        PG8_WAIT_V(2); PG8_BAR;
        PG8_STAGE(PG8_SB(1, 0), cB + kstep, voffB); PG8_STAGE(PG8_SA(1, 0), cA + kstep, voffA); PG8_STAGE(PG8_SB(1, 1), cB + hstep + kstep, voffB);
        PG8_WAIT_V(6); PG8_BAR;
    } else {
        PG8_STAGE(PG8_SB(0, 0), cB, voffB); PG8_STAGE(PG8_SA(0, 0), cA, voffA); PG8_STAGE(PG8_SB(0, 1), cB + hstep, voffB); PG8_STAGE(PG8_SA(0, 1), cA + hstep, voffA);
        if (wr == 1) PG8_BAR;
        PG8_WAIT_V(4); PG8_BAR;
        PG8_STAGE(PG8_SB(1, 0), cB + kstep, voffB); PG8_STAGE(PG8_SA(1, 0), cA + kstep, voffA); PG8_STAGE(PG8_SB(1, 1), cB + hstep + kstep, voffB);
        PG8_WAIT_V(6); PG8_BAR;
    }
    for (;;) {
        const bool has_next = S.next(ui + 1, nxt);
        const char* nA = has_next ? (const char*)g.A + (size_t)nxt.pm * tstep : cA; const char* nB = has_next ? (const char*)g.Bt + (size_t)nxt.pn * tstep : cB;
        for (int t = 0; t < nt; t += 2) {
            const bool last = (t == nt - 2);
            const char* a1 = cA + (size_t)(t + 1) * kstep;
            const char* a2 = last ? nA : cA + (size_t)(t + 2) * kstep; const char* b2 = last ? nB : cB + (size_t)(t + 2) * kstep;
            const char* a3 = a2 + kstep; const char* b3 = b2 + kstep;
            if (last && has_next) S.a_ready(nxt);
            if constexpr (SP2) {
            PG8_LDB(B0, 0, 0); PG8_LDB(B1, 0, 1); PG8_SCHED; PG8_LDA(At, 0, 0); PG8_STAGE(PG8_SA(1, 1), a1 + hstep, voffA);
            PG8_WAIT_V(8); PG8_WAIT_L(0); PG8_BAR; PG8_MMA(0, 0, At, B0); PG8_MMA(0, 1, At, B1); PG8_BAR; PG8_SCHED;
            PG8_LDA(At, 0, 1); PG8_STAGE(PG8_SB(0, 0), b2, voffB); PG8_STAGE(PG8_SB(0, 1), b2 + hstep, voffB); PG8_STAGE(PG8_SA(0, 0), a2, voffA);
            PG8_WAIT_V(8); PG8_WAIT_L(0); PG8_BAR; PG8_MMA(1, 0, At, B0); PG8_MMA(1, 1, At, B1); PG8_BAR; PG8_SCHED;
            PG8_LDB(B0, 1, 0); PG8_LDB(B1, 1, 1); PG8_SCHED; PG8_LDA(At, 1, 0); PG8_STAGE(PG8_SA(0, 1), a2 + hstep, voffA);
            PG8_WAIT_V(8); PG8_WAIT_L(0); PG8_BAR; PG8_MMA(0, 0, At, B0); PG8_MMA(0, 1, At, B1); PG8_BAR; PG8_SCHED;
            PG8_LDA(At, 1, 1); PG8_STAGE(PG8_SB(1, 0), b3, voffB); PG8_STAGE(PG8_SB(1, 1), b3 + hstep, voffB); PG8_STAGE(PG8_SA(1, 0), a3, voffA);
            PG8_WAIT_V(8); PG8_WAIT_L(0); PG8_BAR; PG8_MMA(1, 0, At, B0); PG8_MMA(1, 1, At, B1); PG8_BAR; PG8_SCHED;
            } else {
            PG8_LDB(B0, 0, 0); PG8_SCHED; PG8_LDA(At, 0, 0); PG8_STAGE(PG8_SA(1, 1), a1 + hstep, voffA);
            PG8_WAIT_L(8); PG8_BAR; PG8_WAIT_L(0); PG8_MMA(0, 0, At, B0); PG8_BAR; PG8_SCHED;
            PG8_LDB(B1, 0, 1); PG8_STAGE(PG8_SB(0, 0), b2, voffB);
            PG8_BAR; PG8_WAIT_L(0); PG8_MMA(0, 1, At, B1); PG8_BAR;
            PG8_LDA(At, 0, 1); PG8_STAGE(PG8_SA(0, 0), a2, voffA);
            PG8_BAR; PG8_WAIT_L(0); PG8_MMA(1, 0, At, B0); PG8_BAR; PG8_SCHED;
            PG8_STAGE(PG8_SB(0, 1), b2 + hstep, voffB);
            PG8_WAIT_V(6); PG8_BAR; PG8_MMA(1, 1, At, B1); PG8_BAR;
            PG8_LDB(B0, 1, 0); PG8_SCHED; PG8_LDA(At, 1, 0); PG8_STAGE(PG8_SA(0, 1), a2 + hstep, voffA);
            PG8_WAIT_L(8); PG8_BAR; PG8_WAIT_L(0); PG8_MMA(0, 0, At, B0); PG8_BAR; PG8_SCHED;
            PG8_LDB(B1, 1, 1); PG8_STAGE(PG8_SB(1, 0), b3, voffB);
            PG8_BAR; PG8_WAIT_L(0); PG8_MMA(0, 1, At, B1); PG8_BAR;
            PG8_LDA(At, 1, 1); PG8_STAGE(PG8_SA(1, 0), a3, voffA);
            PG8_BAR; PG8_WAIT_L(0); PG8_MMA(1, 0, At, B0); PG8_BAR; PG8_SCHED;
            PG8_STAGE(PG8_SB(1, 1), b3 + hstep, voffB);
            PG8_WAIT_V(6); PG8_BAR; PG8_MMA(1, 1, At, B1); PG8_BAR;
            }
        }
        if constexpr (ALIGN_EPI) { if (wr == 0) PG8_BAR; }
        if constexpr (!Epi::AFTER_DRAIN) { E(acc, cur, wr, wc, fr, fq); S.done(cur); }
        if (!has_next) break;
#pragma unroll
        for (int a = 0; a < 2; ++a)
#pragma unroll
            for (int b = 0; b < 2; ++b)
#pragma unroll
                for (int m = 0; m < 4; ++m)
#pragma unroll
                    for (int n = 0; n < 2; ++n) acc[a][b][m][n] = (f32x4){0.f, 0.f, 0.f, 0.f};
        cur = nxt; cA = nA; cB = nB; ++ui;
        if constexpr (ALIGN_EPI) { if (wr == 1) PG8_BAR; }
    }
    PG8_WAIT_V(0);
    if constexpr (!ALIGN_EPI) { if (wr == 0) PG8_BAR; }
    PG8_BAR;
    if constexpr (Epi::AFTER_DRAIN) { E.fused(acc, cur, wr, wc, fr, fq, lds, wid, lane); S.done(cur); }
#undef PG8_SA
#undef PG8_SB
#undef PG8_STAGE
#undef PG8_LDA
#undef PG8_LDB
#undef PG8_MMA
#undef PG8_WAIT_V
#undef PG8_WAIT_L
#undef PG8_BAR
#undef PG8_SCHED
}
}
#define GAS __attribute__((address_space(1)))
#define LAS __attribute__((address_space(3)))
typedef unsigned short bf16;
typedef unsigned v4u __attribute__((ext_vector_type(4)));
typedef float f32x4 __attribute__((ext_vector_type(4)));
typedef short bf16x8 __attribute__((ext_vector_type(8)));
typedef GAS unsigned gu32;
typedef GAS unsigned long long gu64;
#define RLX_AGENT __ATOMIC_RELAXED, __HIP_MEMORY_SCOPE_AGENT
#define LDS_WAIT() asm volatile("s_waitcnt lgkmcnt(0)" ::: "memory")
#define VM_WAIT() asm volatile("s_waitcnt vmcnt(0)" ::: "memory")
__device__ __forceinline__ unsigned long long rt() { return __builtin_amdgcn_s_memrealtime(); }
__device__ __forceinline__ unsigned f2bf(float f) { unsigned u = __builtin_bit_cast(unsigned, f); return (u + 0x7fffu + ((u >> 16) & 1u)) >> 16; }
__device__ __forceinline__ unsigned pk2(float lo, float hi) { return f2bf(lo) | (f2bf(hi) << 16); }

#define XB_TMO      128
#define XB_XCNT(j)  (256  + 64 * (j))
#define XB_XSUB(j)  (1280 + 64 * (j))
#define XB_XGEN(j)  (2304 + 64 * (j))
#define XB_TOP      3328
#define XB_TOPGEN   3392
#define XCD_BAR_WORDS 3456
#define XB_SPIN_CAP (1u << 18)

__device__ __forceinline__ unsigned xb_ld(unsigned* p)              { return __hip_atomic_load(p, __ATOMIC_RELAXED, __HIP_MEMORY_SCOPE_AGENT); }
__device__ __forceinline__ unsigned xb_add(unsigned* p, unsigned v) { return __hip_atomic_fetch_add(p, v, __ATOMIC_RELAXED, __HIP_MEMORY_SCOPE_AGENT); }
__device__ __forceinline__ unsigned xb_xcc_id() { return (unsigned)__builtin_amdgcn_s_getreg((3 << 11) | 20) & 0xFu; }
#define XB_SPIN(cond, bar) do { unsigned _sp = 0; while (cond) { __builtin_amdgcn_s_sleep(1); \
    if ((++_sp & 255u) == 0u) { if (xb_ld(&(bar)[XB_TMO])) break; if (_sp > XB_SPIN_CAP) { atomicAdd(&(bar)[XB_TMO], 1u); break; } } } } while (0)

struct XcdBarrier {
    unsigned* bar; unsigned x;
    volatile LAS unsigned* st;
};

__device__ __forceinline__ XcdBarrier xcd_barrier_post(unsigned* bar, volatile LAS unsigned* st) {
    XcdBarrier b; b.bar = bar; b.x = xb_xcc_id(); b.st = st;
    if (threadIdx.x == 0) (void)xb_add(&bar[XB_XCNT(b.x)], 1u);
    return b;
}
__device__ __forceinline__ void xcd_barrier_complete(unsigned* bar, unsigned x, unsigned& nloc, unsigned& nx) {
    const unsigned G = gridDim.x * gridDim.y * gridDim.z;
    unsigned sum, cnt, mine, sp = 0u;
    for (;;) {
        sum = 0u; cnt = 0u; mine = 0u;
#pragma unroll
        for (unsigned j = 0; j < 16; ++j) { const unsigned c = xb_ld(&bar[XB_XCNT(j)]); sum += c; cnt += (c > 0u) ? 1u : 0u; mine = (j == x) ? c : mine; }
        if (sum == G) break;
        __builtin_amdgcn_s_sleep(1);
        if ((++sp & 255u) == 0u) { if (xb_ld(&bar[XB_TMO])) break; if (sp > XB_SPIN_CAP) { atomicAdd(&bar[XB_TMO], 1u); break; } }
    }
    nloc = mine > 0u ? mine : 1u; nx = cnt > 0u ? cnt : 1u;
}

__device__ __forceinline__ void xcd_barrier(const XcdBarrier& b) {
    asm volatile("s_waitcnt vmcnt(0)" ::: "memory");
    __syncthreads();
    if (threadIdx.x == 0) {
        unsigned* bar = b.bar;
        __builtin_amdgcn_s_waitcnt(0);
        unsigned nloc = b.st[0], nx = b.st[1];
        if (nloc == 0u) { xcd_barrier_complete(bar, b.x, nloc, nx); b.st[0] = nloc; b.st[1] = nx; }
        const unsigned old = xb_add(&bar[XB_XSUB(b.x)], 1u);
        const unsigned gen = old / nloc;
        if (old + 1u == (gen + 1u) * nloc) {
            __builtin_amdgcn_fence(__ATOMIC_RELEASE, "agent");
            asm volatile("s_waitcnt vmcnt(0)" ::: "memory");
            const unsigned og = xb_add(&bar[XB_TOP], 1u);
            const unsigned tg = og / nx;
            if (og + 1u == (tg + 1u) * nx) xb_add(&bar[XB_TOPGEN], 1u);
            else XB_SPIN(xb_ld(&bar[XB_TOPGEN]) == tg, bar);
            __builtin_amdgcn_fence(__ATOMIC_ACQUIRE, "agent");
            xb_add(&bar[XB_XGEN(b.x)], 1u);
            asm volatile("s_waitcnt vmcnt(0)" ::: "memory");
        } else {
            XB_SPIN(xb_ld(&bar[XB_XGEN(b.x)]) == gen, bar);
            __builtin_amdgcn_fence(__ATOMIC_ACQUIRE, "agent");
            asm volatile("s_waitcnt vmcnt(0)" ::: "memory");
        }
    }
    __syncthreads();
}


constexpr size_t MiB = 1u << 20;
constexpr size_t WS_CTL = 0, CTL_ZERO_BYTES = 1 * MiB;
constexpr size_t WS_BIAS = 1 * MiB, WS_LAM = 1 * MiB + 4096, WS_RMEM = 1 * MiB + 8192, WS_R0 = 1 * MiB + 65536;
constexpr size_t WS_SS1 = 2 * MiB, WS_SS2 = 4 * MiB, WS_SS3 = 6 * MiB;
constexpr size_t WS_WIN = 8 * MiB, WS_WOUT = 14 * MiB, WS_WCQ = 16 * MiB, WS_WCKV = 18 * MiB, WS_WCO = 22 * MiB, WS_WUP = 24 * MiB, WS_WDOWN = 36 * MiB;
constexpr size_t WS_MEMB = 42 * MiB, WS_MKB = 44 * MiB, WS_MVB = 46 * MiB;
constexpr size_t WS_XB = 48 * MiB, WS_ZCONV = 82 * MiB, WS_QB = 132 * MiB, WS_KB = 149 * MiB, WS_VB = 166 * MiB, WS_MIX = 184 * MiB;
constexpr size_t WS_X1 = 218 * MiB, WS_X1B = 284 * MiB, WS_QC = 317 * MiB, WS_OC = 350 * MiB, WS_X2 = 383 * MiB, WS_X2B = 449 * MiB;
constexpr size_t WS_UPB = 482 * MiB, WS_ACT = 661 * MiB, WS_X3 = 751 * MiB, WS_DPART = 817 * MiB, WS_END = 826 * MiB;
constexpr int CW_BAR = 4096;
constexpr int DP_STRIDE = 132;

constexpr int RING_OFF = 0, RING_BYTES = 131072;
constexpr int LDSCTL_OFF = RING_BYTES, MISC_OFF = LDSCTL_OFF + 320;
constexpr int LDS_BYTES = 147456;
constexpr int NWAVES = 8;

__device__ __forceinline__ float wave_sum(float v) {
#pragma unroll
    for (int o = 1; o < 64; o <<= 1) v += __shfl_xor(v, o);
    return v;
}
__device__ __forceinline__ float wave_max(float v) {
#pragma unroll
    for (int o = 1; o < 64; o <<= 1) v = fmaxf(v, __shfl_xor(v, o));
    return v;
}
__device__ __forceinline__ float bf_lo(unsigned w) { return __uint_as_float(w << 16); }
__device__ __forceinline__ float bf_hi(unsigned w) { return __uint_as_float(w & 0xffff0000u); }
__device__ __forceinline__ void unpack8(const v4u w, float (&f)[8]) { f[0] = bf_lo(w.x); f[1] = bf_hi(w.x); f[2] = bf_lo(w.y); f[3] = bf_hi(w.y); f[4] = bf_lo(w.z); f[5] = bf_hi(w.z); f[6] = bf_lo(w.w); f[7] = bf_hi(w.w); }
__device__ __forceinline__ v4u pack8f(const float (&f)[8]) { v4u o; o.x = pk2(f[0], f[1]); o.y = pk2(f[2], f[3]); o.z = pk2(f[4], f[5]); o.w = pk2(f[6], f[7]); return o; }
template <int CTRL> __device__ __forceinline__ float dppf(float x) { return __int_as_float(__builtin_amdgcn_update_dpp(0, __float_as_int(x), CTRL, 0xF, 0xF, true)); }
__device__ __forceinline__ float ex2(float x) { return __builtin_amdgcn_exp2f(x); }
__device__ __forceinline__ int t5_bucket(int n) {
    if (n < 16) return n;
    const int b = 16 + (int)(__log2f((float)n * 0.0625f) * (16.0f / 3.0f));
    return b < 31 ? b : 31;
}

__device__ __forceinline__ void transpose_item(const float* W, int K, int N, bf16* WT, const float* ksc, LAS float* scr, int item, int lane) {
    const int nblk = N / 32, kb = item / nblk, nb = item % nblk, k0 = 64 * kb, n0 = 32 * nb;
#pragma unroll 8
    for (int i = 0; i < 32; ++i) { const int kk = 2 * i + (lane >> 5); const float sc = ksc ? ksc[k0 + kk] : 1.0f; scr[kk * 33 + (lane & 31)] = W[(size_t)(k0 + kk) * N + n0 + (lane & 31)] * sc; }
    LDS_WAIT(); asm volatile("" ::: "memory");
    const int c = lane & 7;
#pragma unroll
    for (int j = 0; j < 4; ++j) { const int n = (lane >> 3) + 8 * j; const LAS float* s = scr + (8 * c) * 33 + n;
        v4u o; o.x = pk2(s[0 * 33], s[1 * 33]); o.y = pk2(s[2 * 33], s[3 * 33]); o.z = pk2(s[4 * 33], s[5 * 33]); o.w = pk2(s[6 * 33], s[7 * 33]);
        *(GAS v4u*)(WT + (size_t)(n0 + n) * K + k0 + 8 * c) = o; }
    LDS_WAIT(); asm volatile("" ::: "memory");
}
__device__ __forceinline__ void rms_row(const float* xrow, bf16* orow, float* rout, int lane) {
    const GAS f32x4* xr = (const GAS f32x4*)xrow + lane;
    f32x4 v[4]; float s = 0.f;
#pragma unroll
    for (int j = 0; j < 4; ++j) { v[j] = xr[64 * j]; s += (v[j].x * v[j].x + v[j].y * v[j].y) + (v[j].z * v[j].z + v[j].w * v[j].w); }
    s = wave_sum(s);
    if (lane == 0) *rout = 1.0f / sqrtf(s * (1.0f / 1024.0f) + EPS);
    GAS unsigned long long* o8 = (GAS unsigned long long*)orow + lane;
#pragma unroll
    for (int j = 0; j < 4; ++j) o8[64 * j] = (unsigned long long)pk2(v[j].x, v[j].y) | ((unsigned long long)pk2(v[j].z, v[j].w) << 32);
}
struct Ptrs {
    const float* in[32]; float* out; unsigned char* ws;
};
#define WSP(T, off) ((T*)(P.ws + (off)))

__device__ __forceinline__ void p0_prologue(const Ptrs& P, LAS unsigned char* lds, int wave, int lane, int G) {
    LAS float* scr = (LAS float*)(lds + RING_OFF + wave * 16384);
    const int gw = blockIdx.x * NWAVES + wave, NGW = G * NWAVES;
    constexpr int I_IN = 16 * 96, I_OUT = 16 * 32, I_CQ = 16 * 32, I_CKV = 16 * 64, I_CO = 16 * 32, I_UP = 16 * 176, I_DOWN = 44 * 32;
    constexpr int NITEMS = I_IN + I_OUT + I_CQ + I_CKV + I_CO + I_UP + I_DOWN;
    for (int it = gw; it < NITEMS; it += NGW) {
        int r = it;
        if (r < I_IN) { transpose_item(P.in[12], 1024, 3072, WSP(bf16, WS_WIN), P.in[11], scr, r, lane); continue; } r -= I_IN;
        if (r < I_OUT) { transpose_item(P.in[20], 1024, 1024, WSP(bf16, WS_WOUT), nullptr, scr, r, lane); continue; } r -= I_OUT;
        if (r < I_CQ) { transpose_item(P.in[23], 1024, 1024, WSP(bf16, WS_WCQ), P.in[21], scr, r, lane); continue; } r -= I_CQ;
        if (r < I_CKV) { transpose_item(P.in[24], 1024, 2048, WSP(bf16, WS_WCKV), P.in[22], scr, r, lane); continue; } r -= I_CKV;
        if (r < I_CO) { transpose_item(P.in[25], 1024, 1024, WSP(bf16, WS_WCO), nullptr, scr, r, lane); continue; } r -= I_CO;
        if (r < I_UP) { transpose_item(P.in[27], 1024, 5632, WSP(bf16, WS_WUP), P.in[26], scr, r, lane); continue; } r -= I_UP;
        transpose_item(P.in[30], 2816, 1024, WSP(bf16, WS_WDOWN), nullptr, scr, r, lane);
    }
    bf16* xb = WSP(bf16, WS_XB); float* r0 = WSP(float, WS_R0);
    for (int m = gw; m < MT; m += NGW) {
        if (m < MREAL) { const float* src = m < MP ? P.in[0] + (size_t)m * DM : P.in[1] + (size_t)(m - MP) * DM; rms_row(src, xb + (size_t)m * DM, r0 + m, lane); }
        else { GAS unsigned long long* o8 = (GAS unsigned long long*)(xb + (size_t)m * DM) + lane;
#pragma unroll
            for (int j = 0; j < 4; ++j) o8[64 * j] = 0ull;
            if (lane == 0) r0[m] = 0.f; }
    }
    bf16* memb = WSP(bf16, WS_MEMB); float* rmem = WSP(float, WS_RMEM);
    for (int m = gw; m < NB * NMEM; m += NGW) rms_row(P.in[2] + (size_t)m * DM, memb + (size_t)m * DM, rmem + m, lane);
    if (blockIdx.x == 0) {
        float* bt = WSP(float, WS_BIAS);
        for (int idx = threadIdx.x; idx < 4 * DP_STRIDE; idx += NWAVES * 64) { const int h = idx / DP_STRIDE, n = idx % DP_STRIDE; const int bk = n < 128 ? t5_bucket(n) : 31; bt[idx] = P.in[10][bk * 4 + h] * LOG2E; }
        if (wave == 0) { const float a = wave_sum(P.in[15][lane] * P.in[16][lane]), b = wave_sum(P.in[17][lane] * P.in[18][lane]);
            if (lane == 0) *WSP(float, WS_LAM) = expf(a) - expf(b) + LAM_INIT; }
    }
}

__device__ __forceinline__ void p_convmix(const Ptrs& P, int wave, int lane, int G) {
    const int gw = blockIdx.x * NWAVES + wave, NGW = G * NWAVES;
    const bf16* zc = WSP(const bf16, WS_ZCONV); bf16* mix = WSP(bf16, WS_MIX);
    const int ch = lane * 8;
    float w0[8], w1[8], w2[8], bb[8];
#pragma unroll
    for (int i = 0; i < 8; ++i) { w0[i] = P.in[13][ch + i]; w1[i] = P.in[13][512 + ch + i]; w2[i] = P.in[13][1024 + ch + i]; bb[i] = P.in[14][ch + i]; }
    constexpr int NPI = MP / 16;
    for (int it = gw; it < NPI + DB; it += NGW) {
        float p2[8], p1[8];
        int row0, nrow, t0, bidx; const bool prompt = it < NPI;
        if (prompt) { row0 = it * 16; nrow = 16; t0 = row0 % SEQ; bidx = row0 / SEQ;
            if (t0 == 0) {
#pragma unroll
                for (int i = 0; i < 8; ++i) { p2[i] = 0.f; p1[i] = 0.f; } }
            else { float c[8], u[8];
                unpack8(*(const GAS v4u*)(zc + (size_t)(row0 - 2) * 1536 + 512 + ch), c); unpack8(*(const GAS v4u*)(zc + (size_t)(row0 - 2) * 1536 + 1024 + ch), u);
#pragma unroll
                for (int i = 0; i < 8; ++i) p2[i] = c[i] * u[i];
                unpack8(*(const GAS v4u*)(zc + (size_t)(row0 - 1) * 1536 + 512 + ch), c); unpack8(*(const GAS v4u*)(zc + (size_t)(row0 - 1) * 1536 + 1024 + ch), u);
#pragma unroll
                for (int i = 0; i < 8; ++i) p1[i] = c[i] * u[i]; } }
        else { bidx = it - NPI; row0 = MP + bidx * DS; nrow = DS; t0 = 0;
            const float* st = P.in[6] + (size_t)bidx * 2 * DCONV;
#pragma unroll
            for (int i = 0; i < 8; ++i) { p2[i] = st[ch + i]; p1[i] = st[DCONV + ch + i]; } }
        for (int r = 0; r < nrow; ++r) {
            const size_t row = (size_t)(row0 + r);
            float bv[8], c[8], u[8], pre[8], y[8];
            unpack8(*(const GAS v4u*)(zc + row * 1536 + ch), bv); unpack8(*(const GAS v4u*)(zc + row * 1536 + 512 + ch), c); unpack8(*(const GAS v4u*)(zc + row * 1536 + 1024 + ch), u);
#pragma unroll
            for (int i = 0; i < 8; ++i) { pre[i] = c[i] * u[i]; y[i] = bv[i] * (bb[i] + w0[i] * p2[i] + w1[i] * p1[i] + w2[i] * pre[i]); }
            *(GAS v4u*)(mix + row * 1024 + ch) = pack8f(y);
            const int t = t0 + r;
            if (prompt) { if (t >= SEQ - 2) { float* o = P.out + O_CMP + (size_t)(bidx * 2 + (t - (SEQ - 2))) * DCONV + ch; *(f32x4*)o = (f32x4){pre[0], pre[1], pre[2], pre[3]}; *(f32x4*)(o + 4) = (f32x4){pre[4], pre[5], pre[6], pre[7]}; } }
            else { if (t >= DS - 2) { float* o = P.out + O_CMS + (size_t)(bidx * 2 + (t - (DS - 2))) * DCONV + ch; *(f32x4*)o = (f32x4){pre[0], pre[1], pre[2], pre[3]}; *(f32x4*)(o + 4) = (f32x4){pre[4], pre[5], pre[6], pre[7]}; } }
#pragma unroll
            for (int i = 0; i < 8; ++i) { p2[i] = p1[i]; p1[i] = pre[i]; }
        }
    }
}

__device__ __forceinline__ void p_convffn(const Ptrs& P, int wave, int lane, int G) {
    const int gw = blockIdx.x * NWAVES + wave, NGW = G * NWAVES;
    const bf16* up = WSP(const bf16, WS_UPB); bf16* act = WSP(bf16, WS_ACT);
    constexpr int NPI = MP / 16, NCH = 6;
    for (int it = gw; it < (NPI + DB) * NCH; it += NGW) {
        const int rb = it / NCH, cc = it % NCH; const int cg = cc * 64 + lane;
        if (cg < DFF / 8) {
            const int ch = cg * 8;
            float wg0[8], wg1[8], wg2[8], bg[8], wu0[8], wu1[8], wu2[8], bu[8];
#pragma unroll
            for (int i = 0; i < 8; ++i) { wg0[i] = P.in[28][ch + i]; wg1[i] = P.in[28][DUP + ch + i]; wg2[i] = P.in[28][2 * DUP + ch + i]; bg[i] = P.in[29][ch + i];
                wu0[i] = P.in[28][DFF + ch + i]; wu1[i] = P.in[28][DUP + DFF + ch + i]; wu2[i] = P.in[28][2 * DUP + DFF + ch + i]; bu[i] = P.in[29][DFF + ch + i]; }
            float g2[8], g1[8], u2[8], u1[8];
            int row0, nrow, t0, bidx; const bool prompt = rb < NPI;
            if (prompt) { row0 = rb * 16; nrow = 16; t0 = row0 % SEQ; bidx = row0 / SEQ;
                if (t0 == 0) {
#pragma unroll
                    for (int i = 0; i < 8; ++i) { g2[i] = 0.f; g1[i] = 0.f; u2[i] = 0.f; u1[i] = 0.f; } }
                else { unpack8(*(const GAS v4u*)(up + (size_t)(row0 - 2) * DUP + ch), g2); unpack8(*(const GAS v4u*)(up + (size_t)(row0 - 2) * DUP + DFF + ch), u2);
                    unpack8(*(const GAS v4u*)(up + (size_t)(row0 - 1) * DUP + ch), g1); unpack8(*(const GAS v4u*)(up + (size_t)(row0 - 1) * DUP + DFF + ch), u1); } }
            else { bidx = rb - NPI; row0 = MP + bidx * DS; nrow = DS; t0 = 0;
                const float* st = P.in[7] + (size_t)bidx * 2 * DUP;
#pragma unroll
                for (int i = 0; i < 8; ++i) { g2[i] = st[ch + i]; u2[i] = st[DFF + ch + i]; g1[i] = st[DUP + ch + i]; u1[i] = st[DUP + DFF + ch + i]; } }
            for (int r = 0; r < nrow; ++r) {
                const size_t row = (size_t)(row0 + r);
                float g0[8], u0[8], a[8];
                unpack8(*(const GAS v4u*)(up + row * DUP + ch), g0); unpack8(*(const GAS v4u*)(up + row * DUP + DFF + ch), u0);
#pragma unroll
                for (int i = 0; i < 8; ++i) { const float gc = bg[i] + wg0[i] * g2[i] + wg1[i] * g1[i] + wg2[i] * g0[i]; const float uc = bu[i] + wu0[i] * u2[i] + wu1[i] * u1[i] + wu2[i] * u0[i];
                    a[i] = gc / (1.0f + __expf(-gc)) * uc; }
                *(GAS v4u*)(act + row * DFF + ch) = pack8f(a);
                const int t = t0 + r; const int tl = prompt ? SEQ - 2 : DS - 2;
                if (t >= tl) { float* o = P.out + (prompt ? O_CFP : O_CFS) + (size_t)(bidx * 2 + (t - tl)) * DUP + ch;
                    *(f32x4*)o = (f32x4){g0[0], g0[1], g0[2], g0[3]}; *(f32x4*)(o + 4) = (f32x4){g0[4], g0[5], g0[6], g0[7]};
                    *(f32x4*)(o + DFF) = (f32x4){u0[0], u0[1], u0[2], u0[3]}; *(f32x4*)(o + DFF + 4) = (f32x4){u0[4], u0[5], u0[6], u0[7]}; }
#pragma unroll
                for (int i = 0; i < 8; ++i) { g2[i] = g1[i]; g1[i] = g0[i]; u2[i] = u1[i]; u1[i] = u0[i]; }
            }
        }
    }
}

__device__ __forceinline__ void p_final(const Ptrs& P, int wave, int lane, int G) {
    const int gw = blockIdx.x * NWAVES + wave, NGW = G * NWAVES;
    const float* x3 = WSP(const float, WS_X3); const float* ss = WSP(const float, WS_SS3); const float* w = P.in[31];
    f32x4 wv[4];
#pragma unroll
    for (int j = 0; j < 4; ++j) wv[j] = *((const f32x4*)w + lane + 64 * j);
    for (int m = gw; m < MREAL; m += NGW) {
        const float tot = wave_sum(lane < 16 ? ss[(size_t)m * 16 + lane] : 0.f);
        const float rs = 1.0f / sqrtf(tot * (1.0f / 1024.0f) + EPS);
        const GAS f32x4* xr = (const GAS f32x4*)(x3 + (size_t)m * DM) + lane;
        GAS f32x4* o = (GAS f32x4*)(P.out + (m < MP ? O_Y + (size_t)m * DM : O_YS + (size_t)(m - MP) * DM)) + lane;
#pragma unroll
        for (int j = 0; j < 4; ++j) o[64 * j] = xr[64 * j] * rs * wv[j];
    }
}

__device__ __forceinline__ void p_dattn_naive(const Ptrs& P, LAS unsigned char* lds, int wave, int lane, int G) {
    const int gw = blockIdx.x * NWAVES + wave, NGW = G * NWAVES;
    const bf16* qb = WSP(const bf16, WS_QB); const bf16* kb = WSP(const bf16, WS_KB); const bf16* vb = WSP(const bf16, WS_VB); bf16* mix = WSP(bf16, WS_MIX);
    const float* bt = WSP(const float, WS_BIAS); const float lam = *WSP(const float, WS_LAM);
    LAS float* qs = (LAS float*)(lds + wave * 1024); LAS float* ps = qs + 128;
    for (int it = gw; it < MP * NH; it += NGW) {
        const int m = it >> 2, h = it & 3, b = m / SEQ, t = m % SEQ;
        { const unsigned w = *(const GAS unsigned*)(qb + (size_t)m * 512 + h * 128 + 2 * lane); qs[2 * lane] = bf_lo(w); qs[2 * lane + 1] = bf_hi(w); }
        LDS_WAIT(); asm volatile("" ::: "memory");
        float m1 = -1e30f, m2 = -1e30f, l1 = 0.f, l2 = 0.f, o1x = 0.f, o1y = 0.f, o2x = 0.f, o2y = 0.f;
        for (int k0 = 0; k0 <= t; k0 += 64) {
            const int key = k0 + lane; const bool valid = key <= t; const int kc = valid ? key : t;
            const bf16* kr = kb + (size_t)(b * SEQ + kc) * 512 + h * 128;
            float s1 = 0.f, s2 = 0.f;
#pragma unroll
            for (int c = 0; c < 16; ++c) { float kf[8]; unpack8(*(const GAS v4u*)(kr + c * 8), kf);
#pragma unroll
                for (int i = 0; i < 8; ++i) { if (c < 8) s1 += kf[i] * qs[c * 8 + i]; else s2 += kf[i] * qs[c * 8 + i]; } }
            const int rel = t - kc; const float bias = bt[h * DP_STRIDE + (rel < 128 ? rel : 128)];
            s1 = valid ? s1 + bias : -1e30f; s2 = valid ? s2 + bias : -1e30f;
            const float mn1 = fmaxf(m1, wave_max(s1)), mn2 = fmaxf(m2, wave_max(s2));
            const float a1 = ex2(m1 - mn1), a2 = ex2(m2 - mn2);
            const float p1 = valid ? ex2(s1 - mn1) : 0.f, p2 = valid ? ex2(s2 - mn2) : 0.f;
            l1 = l1 * a1 + wave_sum(p1); l2 = l2 * a2 + wave_sum(p2); m1 = mn1; m2 = mn2;
            o1x *= a1; o1y *= a1; o2x *= a2; o2y *= a2;
            ps[lane] = p1; ps[64 + lane] = p2;
            LDS_WAIT(); asm volatile("" ::: "memory");
            const int nk = (t - k0 + 1) < 64 ? (t - k0 + 1) : 64;
            const bf16* vr = vb + (size_t)(b * SEQ + k0) * 512 + h * 128 + 2 * lane;
            for (int kk = 0; kk < nk; ++kk) { const float pa = ps[kk], pb = ps[64 + kk]; const unsigned w = *(const GAS unsigned*)(vr + (size_t)kk * 512); const float vx = bf_lo(w), vy = bf_hi(w);
                o1x += pa * vx; o1y += pa * vy; o2x += pb * vx; o2y += pb * vy; }
            LDS_WAIT(); asm volatile("" ::: "memory");
        }
        const float ax = o1x / l1 - lam * (o2x / l2), ay = o1y / l1 - lam * (o2y / l2);
        const float ssq = wave_sum(ax * ax + ay * ay);
        const float rn = (1.0f - LAM_INIT) / sqrtf(ssq * (1.0f / 128.0f) + EPS);
        const float wx = P.in[19][2 * lane], wy = P.in[19][2 * lane + 1];
        *(GAS unsigned*)(mix + (size_t)m * 1024 + 512 + h * 128 + 2 * lane) = pk2(ax * rn * wx, ay * rn * wy);
    }
}

template <bool SAMPLE> __device__ __forceinline__ void p_xattn_naive(const Ptrs& P, LAS unsigned char* lds, int wave, int lane, int G) {
    const int gw = blockIdx.x * NWAVES + wave, NGW = G * NWAVES;
    const bf16* qc = WSP(const bf16, WS_QC); bf16* oc = WSP(bf16, WS_OC);
    const bf16* mkb = WSP(const bf16, WS_MKB); const bf16* mvb = WSP(const bf16, WS_MVB);
    LAS float* qs = (LAS float*)(lds + wave * 2048); LAS float* ps = qs + 256;
    const int nit = (SAMPLE ? MS : MP) * MHEADS;
    for (int it = gw; it < nit; it += NGW) {
        const int mr = it >> 2, h = it & 3; const int m = SAMPLE ? MP + mr : mr; const int b = SAMPLE ? mr / DS : mr / SEQ;
        { const unsigned long long w = *(const GAS unsigned long long*)(qc + (size_t)m * 1024 + h * 256 + 4 * lane);
          qs[4 * lane] = bf_lo((unsigned)w); qs[4 * lane + 1] = bf_hi((unsigned)w); qs[4 * lane + 2] = bf_lo((unsigned)(w >> 32)); qs[4 * lane + 3] = bf_hi((unsigned)(w >> 32)); }
        LDS_WAIT(); asm volatile("" ::: "memory");
        float s[4];
#pragma unroll
        for (int c = 0; c < 4; ++c) {
            const int key = c * 64 + lane; float acc = 0.f;
            if (SAMPLE) { const float* kr = P.in[8] + ((size_t)(b * NMEM + key) * MHEADS + h) * MDH;
#pragma unroll 8
                for (int d = 0; d < 64; ++d) { const f32x4 kv = *(const GAS f32x4*)(kr + 4 * d); acc += kv.x * qs[4 * d] + kv.y * qs[4 * d + 1] + kv.z * qs[4 * d + 2] + kv.w * qs[4 * d + 3]; } }
            else { const bf16* kr = mkb + (size_t)(b * NMEM + key) * 1024 + h * 256;
#pragma unroll 8
                for (int d = 0; d < 32; ++d) { float kf[8]; unpack8(*(const GAS v4u*)(kr + 8 * d), kf);
#pragma unroll
                    for (int i = 0; i < 8; ++i) acc += kf[i] * qs[8 * d + i]; } }
            s[c] = acc;
        }
        const float mx = wave_max(fmaxf(fmaxf(s[0], s[1]), fmaxf(s[2], s[3])));
        float lsum = 0.f;
#pragma unroll
        for (int c = 0; c < 4; ++c) { const float p = ex2(s[c] - mx); ps[c * 64 + lane] = p; lsum += p; }
        lsum = wave_sum(lsum);
        LDS_WAIT(); asm volatile("" ::: "memory");
        float o[4] = {0.f, 0.f, 0.f, 0.f};
        for (int key = 0; key < NMEM; ++key) {
            const float p = ps[key];
            if (SAMPLE) { const f32x4 v = *(const GAS f32x4*)(P.in[9] + ((size_t)(b * NMEM + key) * MHEADS + h) * MDH + 4 * lane); o[0] += p * v.x; o[1] += p * v.y; o[2] += p * v.z; o[3] += p * v.w; }
            else { const unsigned long long w = *(const GAS unsigned long long*)(mvb + (size_t)(b * NMEM + key) * 1024 + h * 256 + 4 * lane);
                o[0] += p * bf_lo((unsigned)w); o[1] += p * bf_hi((unsigned)w); o[2] += p * bf_lo((unsigned)(w >> 32)); o[3] += p * bf_hi((unsigned)(w >> 32)); }
        }
        const float il = 1.0f / lsum;
        *(GAS unsigned long long*)(oc + (size_t)m * 1024 + h * 256 + 4 * lane) = (unsigned long long)pk2(o[0] * il, o[1] * il) | ((unsigned long long)pk2(o[2] * il, o[3] * il) << 32);
        LDS_WAIT(); asm volatile("" ::: "memory");
    }
}

__device__ __forceinline__ void p_decode_split(const Ptrs& P, int wave, int lane, int G) {
    const int gw = blockIdx.x * NWAVES + wave, NGW = G * NWAVES;
    const bf16* qb = WSP(const bf16, WS_QB); const float* bt = WSP(const float, WS_BIAS); float* dpart = WSP(float, WS_DPART);
    const float* ck = P.in[3]; const float* cv = P.in[4]; const int* ptab = (const int*)P.in[5];
    const int r = lane >> 4, cl = lane & 15, d0 = cl * 8;
    for (int it = gw; it < DB * NH * 16; it += NGW) {
        const int bh = it >> 4, chunk = it & 15, bs = bh >> 2, h = bh & 3;
        float qv[4][8];
#pragma unroll
        for (int t = 0; t < 4; ++t) unpack8(*(const GAS v4u*)(qb + (size_t)(MP + bs * DS + t) * 512 + h * 128 + d0), qv[t]);
        const float b31 = bt[h * DP_STRIDE + 128];
        const int j0 = chunk * 512;
        float mm[4], ll[4], accA[4][8], accB[4][8];
#pragma unroll
        for (int t = 0; t < 4; ++t) { mm[t] = -1e30f; ll[t] = 0.f;
#pragma unroll
            for (int d = 0; d < 8; ++d) { accA[t][d] = 0.f; accB[t][d] = 0.f; } }
        f32x4 Ka[2][2], Va[2][2], Kb[2][2], Vb[2][2];
#define DEC_ISSUE(blk, K_, V_) do { const int jb_ = j0 + (blk) * 8; const int page_ = __builtin_amdgcn_readfirstlane(ptab[bs * NPAGES + (jb_ >> 7)]); \
        _Pragma("unroll") for (int i_ = 0; i_ < 2; ++i_) { const size_t off_ = ((size_t)(page_ * PAGE + (jb_ & 127) + r + 4 * i_) * NH + h) * 128 + d0; \
            K_[i_][0] = *(const GAS f32x4*)(ck + off_); K_[i_][1] = *(const GAS f32x4*)(ck + off_ + 4); V_[i_][0] = *(const GAS f32x4*)(cv + off_); V_[i_][1] = *(const GAS f32x4*)(cv + off_ + 4); } } while (0)
#define DEC_COMPUTE(blk, K_, V_) do { \
        float s_[2][4]; \
        _Pragma("unroll") for (int i_ = 0; i_ < 2; ++i_) _Pragma("unroll") for (int t_ = 0; t_ < 4; ++t_) { \
            float a_ = K_[i_][0].x * qv[t_][0] + K_[i_][0].y * qv[t_][1] + K_[i_][0].z * qv[t_][2] + K_[i_][0].w * qv[t_][3] + K_[i_][1].x * qv[t_][4] + K_[i_][1].y * qv[t_][5] + K_[i_][1].z * qv[t_][6] + K_[i_][1].w * qv[t_][7]; \
            a_ += dppf<0xB1>(a_); a_ += dppf<0x4E>(a_); a_ += dppf<0x141>(a_); s_[i_][t_] = a_; } \
        const int jb_ = j0 + (blk) * 8; \
        if (jb_ + 7 + 128 <= PAST) { _Pragma("unroll") for (int i_ = 0; i_ < 2; ++i_) _Pragma("unroll") for (int t_ = 0; t_ < 4; ++t_) s_[i_][t_] += b31; } \
        else { _Pragma("unroll") for (int i_ = 0; i_ < 2; ++i_) _Pragma("unroll") for (int t_ = 0; t_ < 4; ++t_) { const int rel_ = PAST + t_ - (jb_ + r + 4 * i_); s_[i_][t_] += bt[h * DP_STRIDE + (rel_ < 128 ? rel_ : 128)]; } } \
        float mn_[4]; bool grow_ = false; \
        _Pragma("unroll") for (int t_ = 0; t_ < 4; ++t_) { mn_[t_] = fmaxf(mm[t_], fmaxf(s_[0][t_], s_[1][t_])); grow_ = grow_ || (mn_[t_] > mm[t_]); } \
        if (__any(grow_)) { _Pragma("unroll") for (int t_ = 0; t_ < 4; ++t_) { const float al_ = ex2(mm[t_] - mn_[t_]); const float alo_ = dppf<0x128>(al_); ll[t_] *= al_; mm[t_] = mn_[t_]; \
            _Pragma("unroll") for (int d_ = 0; d_ < 8; ++d_) { accA[t_][d_] *= al_; accB[t_][d_] *= alo_; } } } \
        _Pragma("unroll") for (int i_ = 0; i_ < 2; ++i_) _Pragma("unroll") for (int t_ = 0; t_ < 4; ++t_) { \
            const float p_ = ex2(s_[i_][t_] - mm[t_]); const float po_ = dppf<0x128>(p_); ll[t_] += p_; \
            accA[t_][0] += p_ * V_[i_][0].x; accA[t_][1] += p_ * V_[i_][0].y; accA[t_][2] += p_ * V_[i_][0].z; accA[t_][3] += p_ * V_[i_][0].w; \
            accA[t_][4] += p_ * V_[i_][1].x; accA[t_][5] += p_ * V_[i_][1].y; accA[t_][6] += p_ * V_[i_][1].z; accA[t_][7] += p_ * V_[i_][1].w; \
            accB[t_][0] += po_ * V_[i_][0].x; accB[t_][1] += po_ * V_[i_][0].y; accB[t_][2] += po_ * V_[i_][0].z; accB[t_][3] += po_ * V_[i_][0].w; \
            accB[t_][4] += po_ * V_[i_][1].x; accB[t_][5] += po_ * V_[i_][1].y; accB[t_][6] += po_ * V_[i_][1].z; accB[t_][7] += po_ * V_[i_][1].w; } } while (0)
        DEC_ISSUE(0, Ka, Va);
        for (int blk = 0; blk < 64; blk += 2) {
            DEC_ISSUE(blk + 1, Kb, Vb);
            DEC_COMPUTE(blk, Ka, Va);
            if (blk + 2 < 64) DEC_ISSUE(blk + 2, Ka, Va);
            DEC_COMPUTE(blk + 1, Kb, Vb);
        }
#undef DEC_ISSUE
#undef DEC_COMPUTE
        float Mx[4], fo[4];
#pragma unroll
        for (int t = 0; t < 4; ++t) { float M = fmaxf(mm[t], __shfl_xor(mm[t], 16)); M = fmaxf(M, __shfl_xor(M, 32)); const float f = ex2(mm[t] - M); Mx[t] = M;
            float l = ll[t] * f; l += __shfl_xor(l, 16); l += __shfl_xor(l, 32); ll[t] = l; fo[t] = dppf<0x128>(f);
#pragma unroll
            for (int d = 0; d < 8; ++d) { float a = accA[t][d] * f; a += __shfl_xor(a, 16); a += __shfl_xor(a, 32); accA[t][d] = a; float bq = accB[t][d] * fo[t]; bq += __shfl_xor(bq, 16); bq += __shfl_xor(bq, 32); accB[t][d] = bq; } }
        if (r == 0) {
            const int map = cl >> 3;
#pragma unroll
            for (int t = 0; t < 4; ++t) {
                float* pa = dpart + ((size_t)it * 8 + map * 4 + t) * DP_STRIDE; float* pb = dpart + ((size_t)it * 8 + (1 - map) * 4 + t) * DP_STRIDE;
                *(f32x4*)(pa + d0) = (f32x4){accA[t][0], accA[t][1], accA[t][2], accA[t][3]}; *(f32x4*)(pa + d0 + 4) = (f32x4){accA[t][4], accA[t][5], accA[t][6], accA[t][7]};
                *(f32x4*)(pb + d0) = (f32x4){accB[t][0], accB[t][1], accB[t][2], accB[t][3]}; *(f32x4*)(pb + d0 + 4) = (f32x4){accB[t][4], accB[t][5], accB[t][6], accB[t][7]};
                if ((cl & 7) == 0) { pa[128] = Mx[t]; pa[129] = ll[t]; }
            }
        }
    }
}
__device__ __forceinline__ void p_decode_combine(const Ptrs& P, int wave, int lane, int G) {
    const int gw = blockIdx.x * NWAVES + wave, NGW = G * NWAVES;
    const bf16* qb = WSP(const bf16, WS_QB); const float* bt = WSP(const float, WS_BIAS); const float* dpart = WSP(const float, WS_DPART); bf16* mix = WSP(bf16, WS_MIX);
    const float lam = *WSP(const float, WS_LAM);
    for (int it = gw; it < DB * NH * DS; it += NGW) {
        const int t = it & 3, bh = it >> 2, bs = bh >> 2, h = bh & 3; const int row = MP + bs * DS + t;
        float res[2][2];
#pragma unroll
        for (int map = 0; map < 2; ++map) {
            const float* pbase = dpart + ((size_t)bh * 16 * 8 + map * 4 + t) * DP_STRIDE;
            float mc = -1e30f, lc = 0.f;
            if (lane < 16) { mc = pbase[(size_t)lane * 8 * DP_STRIDE + 128]; lc = pbase[(size_t)lane * 8 * DP_STRIDE + 129]; }
            const float qd = __uint_as_float((unsigned)qb[(size_t)row * 512 + h * 128 + map * 64 + lane] << 16);
            float sn[4];
#pragma unroll
            for (int i = 0; i < 4; ++i) { const float kd = P.out[O_KS + (size_t)(bs * DS + i) * 512 + h * 128 + map * 64 + lane]; const float s = wave_sum(qd * kd);
                sn[i] = (i <= t) ? s + bt[h * DP_STRIDE + (t - i >= 0 ? t - i : 0)] : -1e30f; }
            float M = wave_max(mc); M = fmaxf(fmaxf(M, sn[0]), fmaxf(fmaxf(sn[1], sn[2]), sn[3]));
            const float wc = ex2(mc - M);
            float L = wave_sum(wc * lc); float pn[4];
#pragma unroll
            for (int i = 0; i < 4; ++i) { pn[i] = (i <= t) ? ex2(sn[i] - M) : 0.f; L += pn[i]; }
            float ox = 0.f, oy = 0.f;
            for (int c = 0; c < 16; ++c) { const float w = __shfl(wc, c); ox += w * pbase[(size_t)c * 8 * DP_STRIDE + lane]; oy += w * pbase[(size_t)c * 8 * DP_STRIDE + 64 + lane]; }
#pragma unroll
            for (int i = 0; i < 4; ++i) { const float* vr = P.out + O_VS + (size_t)(bs * DS + i) * 512 + h * 128; ox += pn[i] * vr[lane]; oy += pn[i] * vr[64 + lane]; }
            res[map][0] = ox / L; res[map][1] = oy / L;
        }
        const float ax = res[0][0] - lam * res[1][0], ay = res[0][1] - lam * res[1][1];
        const float ssq = wave_sum(ax * ax + ay * ay);
        const float rn = (1.0f - LAM_INIT) / sqrtf(ssq * (1.0f / 128.0f) + EPS);
        bf16* o = mix + (size_t)row * 1024 + 512 + h * 128;
        o[lane] = (bf16)f2bf(ax * rn * P.in[19][lane]); o[64 + lane] = (bf16)f2bf(ay * rn * P.in[19][64 + lane]);
    }
}

constexpr int N_PHASES = 12;
struct Args { const float* in[32]; float* out; unsigned char* ws; int ph_lo, ph_hi; };
__global__ void __launch_bounds__(NWAVES * 64, 2) mega_fwd(Args args) {
    extern __shared__ __attribute__((aligned(16))) unsigned char lds[];
    LAS unsigned char* L = (LAS unsigned char*)lds;
    volatile LAS unsigned* MISC = (volatile LAS unsigned*)(L + MISC_OFF);
    const int tid = threadIdx.x, lane = tid & 63, wave = __builtin_amdgcn_readfirstlane(tid >> 6);
    const int G = gridDim.x;
    Ptrs P;
#pragma unroll
    for (int i = 0; i < 32; ++i) P.in[i] = args.in[i];
    P.out = args.out; P.ws = args.ws;
    for (int u = tid; u < (LDS_BYTES - LDSCTL_OFF) / 4; u += NWAVES * 64) ((LAS unsigned*)(L + LDSCTL_OFF))[u] = 0u;
    __syncthreads();
    gu32* ctl = (gu32*)(P.ws + WS_CTL);
    XcdBarrier bar; bar.bar = (unsigned*)(ctl + CW_BAR); bar.x = 0; bar.st = nullptr;
#if !MK_PER_PHASE
    bar = xcd_barrier_post((unsigned*)(ctl + CW_BAR), MISC + 8);
#endif
    const int lo = args.ph_lo, hi = args.ph_hi;
#define IN(k) (lo <= (k) && (k) < hi)
#define SEAM(k) do { if (IN(k) && IN((k) + 1)) xcd_barrier(bar); } while (0)

    if (IN(0)) { p0_prologue(P, L, wave, lane, G); }
    SEAM(0);
    if (IN(1)) {
        { pg8::Gemm g{WSP(const bf16, WS_XB), WSP(const bf16, WS_WIN), MT, DIN, DM}; pg8::StaticOrder S; S.init(MT, DIN, G, (int)blockIdx.x);
          pg8::EpiIn E{WSP(const float, WS_R0), WSP(bf16, WS_ZCONV), WSP(bf16, WS_QB), WSP(bf16, WS_KB), WSP(bf16, WS_VB), P.out};
          pg8::gemm_phase<pg8::EpiIn, pg8::StaticOrder, true, true>(L + RING_OFF, g, S, E); }
        { pg8::Gemm g{WSP(const bf16, WS_MEMB), WSP(const bf16, WS_WCKV), NB * NMEM, 2 * DM, DM}; pg8::StaticOrder S; S.init(NB * NMEM, 2 * DM, G, (int)blockIdx.x);
          pg8::EpiMem E{WSP(const float, WS_RMEM), WSP(bf16, WS_MKB), WSP(bf16, WS_MVB), P.out};
          pg8::gemm_phase<pg8::EpiMem, pg8::StaticOrder, true, true>(L + RING_OFF, g, S, E); }
    }
    SEAM(1);
    if (IN(2)) { p_convmix(P, wave, lane, G); p_dattn_naive(P, L, wave, lane, G); p_decode_split(P, wave, lane, G); }
    SEAM(2);
    if (IN(3)) { p_decode_combine(P, wave, lane, G); }
    SEAM(3);
    if (IN(4)) { pg8::Gemm g{WSP(const bf16, WS_MIX), WSP(const bf16, WS_WOUT), MT, DM, DM}; pg8::StaticOrder S; S.init(MT, DM, G, (int)blockIdx.x);
        pg8::EpiRes E{P.in[0], P.in[1], WSP(float, WS_X1), WSP(bf16, WS_X1B), WSP(float, WS_SS1)};
        pg8::gemm_phase<pg8::EpiRes, pg8::StaticOrder, true, true>(L + RING_OFF, g, S, E); }
    SEAM(4);
    if (IN(5)) { pg8::Gemm g{WSP(const bf16, WS_X1B), WSP(const bf16, WS_WCQ), MT, DM, DM}; pg8::StaticOrder S; S.init(MT, DM, G, (int)blockIdx.x);
        pg8::EpiScale E{WSP(const float, WS_SS1), WSP(bf16, WS_QC), DM, CQSC};
        pg8::gemm_phase<pg8::EpiScale, pg8::StaticOrder, true, true>(L + RING_OFF, g, S, E); }
    SEAM(5);
    if (IN(6)) { p_xattn_naive<false>(P, L, wave, lane, G); p_xattn_naive<true>(P, L, wave, lane, G); }
    SEAM(6);
    if (IN(7)) { pg8::Gemm g{WSP(const bf16, WS_OC), WSP(const bf16, WS_WCO), MT, DM, DM}; pg8::StaticOrder S; S.init(MT, DM, G, (int)blockIdx.x);
        pg8::EpiRes E{WSP(const float, WS_X1), WSP(const float, WS_X1) + (size_t)MP * DM, WSP(float, WS_X2), WSP(bf16, WS_X2B), WSP(float, WS_SS2)};
        pg8::gemm_phase<pg8::EpiRes, pg8::StaticOrder, true, true>(L + RING_OFF, g, S, E); }
    SEAM(7);
    if (IN(8)) { pg8::Gemm g{WSP(const bf16, WS_X2B), WSP(const bf16, WS_WUP), MT, DUP, DM}; pg8::StaticOrder S; S.init(MT, DUP, G, (int)blockIdx.x);
        pg8::EpiScale E{WSP(const float, WS_SS2), WSP(bf16, WS_UPB), DUP, 1.0f};
        pg8::gemm_phase<pg8::EpiScale, pg8::StaticOrder, true, true>(L + RING_OFF, g, S, E); }
    SEAM(8);
    if (IN(9)) { p_convffn(P, wave, lane, G); }
    SEAM(9);
    if (IN(10)) { pg8::Gemm g{WSP(const bf16, WS_ACT), WSP(const bf16, WS_WDOWN), MT, DM, DFF}; pg8::StaticOrder S; S.init(MT, DM, G, (int)blockIdx.x);
        pg8::EpiRes E{WSP(const float, WS_X2), WSP(const float, WS_X2) + (size_t)MP * DM, WSP(float, WS_X3), nullptr, WSP(float, WS_SS3)};
        pg8::gemm_phase<pg8::EpiRes, pg8::StaticOrder, true, true>(L + RING_OFF, g, S, E); }
    SEAM(10);
    if (IN(11)) { p_final(P, wave, lane, G); }
#undef IN
#undef SEAM
}

extern "C" void kernel_launch(void* const* d_in, const int* in_sizes, int n_in, void* d_out, int out_size, void* d_ws, size_t ws_size, hipStream_t stream) {
    static int grid = 0;
    if (grid == 0) {
        if (n_in != 32 || out_size != (int)O_END || ws_size < WS_END) { fprintf(stderr, "kernel_launch: unexpected shapes: n_in %d out %d ws %zu\n", n_in, out_size, ws_size); grid = -1; return; }
        int dev = 0, cus = 0, per_cu = 0;
        if (hipGetDevice(&dev) != hipSuccess || hipDeviceGetAttribute(&cus, hipDeviceAttributeMultiprocessorCount, dev) != hipSuccess) { grid = -1; return; }
        if (hipFuncSetAttribute((const void*)mega_fwd, hipFuncAttributeMaxDynamicSharedMemorySize, LDS_BYTES) != hipSuccess) { fprintf(stderr, "kernel_launch: hipFuncSetAttribute failed\n"); grid = -1; return; }
        if (hipOccupancyMaxActiveBlocksPerMultiprocessor(&per_cu, (const void*)mega_fwd, NWAVES * 64, LDS_BYTES) != hipSuccess || per_cu < 1) fprintf(stderr, "kernel_launch: occupancy query reports %d\n", per_cu);
        (void)hipGetLastError();
        grid = cus;
    }
    if (grid < 0) return;
    if (hipMemsetAsync((char*)d_ws + WS_CTL, 0, CTL_ZERO_BYTES, stream) != hipSuccess) return;
    Args a{};
    for (int i = 0; i < 32; ++i) a.in[i] = (const float*)d_in[i];
    a.out = (float*)d_out; a.ws = (unsigned char*)d_ws;
#if MK_PER_PHASE
    for (int p = 0; p < N_PHASES; ++p) { a.ph_lo = p; a.ph_hi = p + 1; hipLaunchKernelGGL(mega_fwd, dim3(grid), dim3(NWAVES * 64), LDS_BYTES, stream, a); }
#else
    a.ph_lo = 0; a.ph_hi = N_PHASES; hipLaunchKernelGGL(mega_fwd, dim3(grid), dim3(NWAVES * 64), LDS_BYTES, stream, a);
#endif
}
```

```cpp
#include <hip/hip_runtime.h>
#include <cstdio>
#include <cstdint>

#ifndef MK_PER_PHASE
#define MK_PER_PHASE 0
#endif

constexpr int DM = 1024, NB = 4, SEQ = 4096, MP = NB * SEQ;
constexpr int DB = 32, DS = 4, MS = DB * DS;
constexpr int MREAL = MP + MS, MT = 16640;
constexpr int PAST = 8192, PAGE = 128, NPAGES = PAST / PAGE;
constexpr int DCONV = 512, NH = 4, HDK = 64, HDV = 128, DATT = 512, DIN = 3072;
constexpr int NMEM = 256, MHEADS = 4, MDH = 256, DFF = 2816, DUP = 2 * DFF;
constexpr float EPS = 1e-6f, LOG2E = 1.4426950408889634f;
constexpr float QSC = 0.125f * LOG2E;
constexpr float CQSC = 0.0625f * LOG2E;
constexpr float LAM_INIT = 0.2f;
constexpr size_t O_Y = 0, O_YS = 16777216, O_KP = 16908288, O_VP = 25296896, O_KS = 33685504, O_VS = 33751040,
                 O_CMP = 33816576, O_CMS = 33820672, O_CFP = 33853440, O_CFS = 33898496, O_MK = 34258944, O_MV = 35307520, O_END = 36356096;
namespace pg8 {
#define PG8_LAS __attribute__((address_space(3)))
typedef unsigned short bf16_t;
typedef short bf16x8 __attribute__((ext_vector_type(8)));
typedef float f32x4 __attribute__((ext_vector_type(4)));
typedef unsigned u32x4 __attribute__((ext_vector_type(4)));
constexpr int BM = 256, BK = 64, HALF = 128, HTB = HALF * BK * 2  , STAGE_BYTES = 8 * HTB, NXCD = 8, WGM = 8;

__host__ __device__ __forceinline__ int lds_byte(int r, int c) { const int st = (r >> 4) * 2 + (c >> 5), rr = r & 15, cc = c & 31, ob = rr * 64 + cc * 2; return st * 1024 + (ob ^ (((ob >> 9) & 1) << 5)); }
__host__ __device__ __forceinline__ void stage_rc(int b, int& R, int& C) { const int st = b / 1024, sb = b % 1024, swz = sb ^ (((sb >> 9) & 1) << 5); R = (st >> 1) * 16 + swz / 64; C = (st & 1) * 32 + (swz % 64) / 2; }
__host__ __device__ __forceinline__ int perm32(int rho) { const int n = rho >> 4, i = rho & 15; return 8 * (i >> 2) + 4 * n + (i & 3); }

struct Unit { int pm, pn; };
struct Gemm { const bf16_t* A; const bf16_t* Bt; int M, N, K; };

struct StaticOrder {
    int nM, nN, nwg, G, c;
    __host__ __device__ void init(int M, int N, int G_, int c_) { nM = M / BM; nN = N / BM; nwg = nM * nN; G = G_; c = c_; }
    __host__ __device__ bool next(int i, Unit& u) const {
        const long L = (long)i * G + c; if (L >= nwg) return false;
        int wgid = (int)L; { const int q = nwg / NXCD, r = nwg % NXCD, xcd = wgid % NXCD, off = wgid / NXCD; wgid = (xcd < r ? xcd * (q + 1) : r * (q + 1) + (xcd - r) * q) + off; }
        const int nig = WGM * nN, gid = wgid / nig, fm = gid * WGM, gsz = (nM - fm) < WGM ? (nM - fm) : WGM;
        u.pm = fm + ((wgid % nig) % gsz); u.pn = (wgid % nig) / gsz; return true;
    }
    __device__ __forceinline__ void a_ready(const Unit&) const {}
    __device__ __forceinline__ void done(const Unit&) const {}
};

__device__ __forceinline__ unsigned cvt_pk_bf16(float lo, float hi) { unsigned r; asm volatile("v_cvt_pk_bf16_f32 %0, %1, %2" : "=v"(r) : "v"(lo), "v"(hi)); return r; }
__device__ __forceinline__ u32x4 pack8(const f32x4 a, const f32x4 b) { u32x4 w; w.x = cvt_pk_bf16(a[0], a[1]); w.y = cvt_pk_bf16(a[2], a[3]); w.z = cvt_pk_bf16(b[0], b[1]); w.w = cvt_pk_bf16(b[2], b[3]); return w; }
__device__ __forceinline__ float dot4(const f32x4 a) { return (a[0] * a[0] + a[1] * a[1]) + (a[2] * a[2] + a[3] * a[3]); }

struct EpiIn {
    static constexpr bool PERM = true, AFTER_DRAIN = false;
    const float* r0; bf16_t* zconv; bf16_t* qb; bf16_t* kb; bf16_t* vb; float* out;
    __device__ __forceinline__ void operator()(const f32x4 (&acc)[2][2][4][2], const Unit& u, int wr, int wc, int fr, int fq) const {
        const int pn = u.pn;
#pragma unroll
        for (int ai = 0; ai < 2; ++ai)
#pragma unroll
            for (int m = 0; m < 4; ++m) {
                const int row = u.pm * BM + ai * HALF + wr * 64 + m * 16 + fr;
                if (row < MREAL) {
                    const float rs = r0[row];
#pragma unroll
                    for (int bj = 0; bj < 2; ++bj) {
                        const int col = pn * BM + bj * HALF + wc * 32 + 8 * fq;
                        const f32x4 v0 = acc[ai][bj][m][0] * rs, v1 = acc[ai][bj][m][1] * rs;
                        if (pn < 6) { *(u32x4*)(zconv + (size_t)row * 1536 + col) = pack8(v0, v1); }
                        else if (pn < 8) { *(u32x4*)(qb + (size_t)row * 512 + (col - 1536)) = pack8(v0 * QSC, v1 * QSC); }
                        else { const bool isk = pn < 10; const int c = col - (isk ? 2048 : 2560);
                            *(u32x4*)((isk ? kb : vb) + (size_t)row * 512 + c) = pack8(v0, v1);
                            float* o = out + (row < MP ? (isk ? O_KP : O_VP) + (size_t)row * 512 : (isk ? O_KS : O_VS) + (size_t)(row - MP) * 512) + c;
                            *(f32x4*)o = v0; *(f32x4*)(o + 4) = v1; }
                    }
                }
            }
    }
};
struct EpiMem {
    static constexpr bool PERM = true, AFTER_DRAIN = false;
    const float* rmem; bf16_t* mkb; bf16_t* mvb; float* out;
    __device__ __forceinline__ void operator()(const f32x4 (&acc)[2][2][4][2], const Unit& u, int wr, int wc, int fr, int fq) const {
        const int pn = u.pn; const bool isk = pn < 4;
#pragma unroll
        for (int ai = 0; ai < 2; ++ai)
#pragma unroll
            for (int m = 0; m < 4; ++m) {
                const int row = u.pm * BM + ai * HALF + wr * 64 + m * 16 + fr;
                const float rs = rmem[row];
#pragma unroll
                for (int bj = 0; bj < 2; ++bj) {
                    const int col = (pn & 3) * BM + bj * HALF + wc * 32 + 8 * fq;
                    const f32x4 v0 = acc[ai][bj][m][0] * rs, v1 = acc[ai][bj][m][1] * rs;
                    *(u32x4*)((isk ? mkb : mvb) + (size_t)row * 1024 + col) = pack8(v0, v1);
                    float* o = out + (isk ? O_MK : O_MV) + (size_t)row * 1024 + col;
                    *(f32x4*)o = v0; *(f32x4*)(o + 4) = v1;
                }
            }
    }
};
struct EpiRes {
    static constexpr bool PERM = true, AFTER_DRAIN = false;
    const float* resP; const float* resS; float* xo; bf16_t* xob; float* ss;
    __device__ __forceinline__ void operator()(const f32x4 (&acc)[2][2][4][2], const Unit& u, int wr, int wc, int fr, int fq) const {
        const int pn = u.pn;
#pragma unroll
        for (int ai = 0; ai < 2; ++ai)
#pragma unroll
            for (int m = 0; m < 4; ++m) {
                const int row = u.pm * BM + ai * HALF + wr * 64 + m * 16 + fr;
                const bool valid = row < MREAL;
                const float* rp = row < MP ? resP + (size_t)row * 1024 : resS + (size_t)(row - MP) * 1024;
                float sq = 0.f;
#pragma unroll
                for (int bj = 0; bj < 2; ++bj) {
                    const int col = pn * BM + bj * HALF + wc * 32 + 8 * fq;
                    f32x4 a = (f32x4){0.f, 0.f, 0.f, 0.f}, b = a;
                    if (valid) { a = *(const f32x4*)(rp + col); b = *(const f32x4*)(rp + col + 4); }
                    const f32x4 o0 = a + acc[ai][bj][m][0], o1 = b + acc[ai][bj][m][1];
                    if (valid) { float* xp = xo + (size_t)row * 1024 + col; *(f32x4*)xp = o0; *(f32x4*)(xp + 4) = o1;
                        if (xob) *(u32x4*)(xob + (size_t)row * 1024 + col) = pack8(o0, o1); }
                    sq += dot4(o0) + dot4(o1);
                }
                sq += __shfl_xor(sq, 16); sq += __shfl_xor(sq, 32);
                if (valid && fq == 0) ss[(size_t)row * 16 + pn * 4 + wc] = sq;
            }
    }
};
struct EpiScale {
    static constexpr bool PERM = true, AFTER_DRAIN = false;
    const float* ss; bf16_t* O; int ldc; float cs;
    __device__ __forceinline__ void operator()(const f32x4 (&acc)[2][2][4][2], const Unit& u, int wr, int wc, int fr, int fq) const {
        const int pn = u.pn;
#pragma unroll
        for (int ai = 0; ai < 2; ++ai)
#pragma unroll
            for (int m = 0; m < 4; ++m) {
                const int row = u.pm * BM + ai * HALF + wr * 64 + m * 16 + fr;
                const f32x4* sp = (const f32x4*)(ss + (size_t)row * 16);
                const f32x4 s0 = sp[0], s1 = sp[1], s2 = sp[2], s3 = sp[3];
                const float tot = ((s0[0] + s0[1]) + (s0[2] + s0[3])) + ((s1[0] + s1[1]) + (s1[2] + s1[3])) + ((s2[0] + s2[1]) + (s2[2] + s2[3])) + ((s3[0] + s3[1]) + (s3[2] + s3[3]));
                const float rs = cs / sqrtf(fmaxf(tot, 0.f) * (1.0f / 1024.0f) + EPS);
#pragma unroll
                for (int bj = 0; bj < 2; ++bj) {
                    const int col = pn * BM + bj * HALF + wc * 32 + 8 * fq;
                    *(u32x4*)(O + (size_t)row * ldc + col) = pack8(acc[ai][bj][m][0] * rs, acc[ai][bj][m][1] * rs);
                }
            }
    }
};
template <class Epi, class Sched, bool ALIGN_EPI = false, bool SP2 = false>
__device__ __forceinline__ void gemm_phase(PG8_LAS unsigned char* lds, const Gemm g, const Sched& S, const Epi& E) {
    const int tid = threadIdx.x, wid = __builtin_amdgcn_readfirstlane(tid >> 6), lane = tid & 63, wr = wid >> 2, wc = wid & 3, fr = lane & 15, fq = lane >> 4;
    const int K = g.K, nt = K / BK;
    unsigned voffA[2], voffB[2];
#pragma unroll
    for (int i = 0; i < 2; ++i) { int R, C; stage_rc(tid * 16 + i * 8192, R, C); const int Rb = Epi::PERM ? ((R & ~31) + perm32(R & 31)) : R;
        voffA[i] = (unsigned)(R * K + C) * 2u; voffB[i] = (unsigned)(Rb * K + C) * 2u; }
    const size_t kstep = (size_t)(BK * 2);
    const size_t hstep = (size_t)HALF * K * 2;
    const size_t tstep = 2 * hstep;
    const unsigned ldsw = (unsigned)wid * 1024u;
    const int aoff = lds_byte(wr * 64 + fr, fq * 8), boff = lds_byte(wc * 32 + fr, fq * 8);
#define PG8_SA(b, h) (((b) * 2 + (h)) * HTB)
#define PG8_SB(b, h) ((4 + (b) * 2 + (h)) * HTB)
#define PG8_STAGE(bufoff, gbase, voff) do { _Pragma("unroll") for (int _i = 0; _i < 2; ++_i) \
        __builtin_amdgcn_global_load_lds((const unsigned*)((const char*)(gbase) + (voff)[_i]), (PG8_LAS unsigned*)(lds + (bufoff) + ldsw + _i * 8192), 16, 0, 0); } while (0)
#define PG8_LDA(dst, b, h) do { _Pragma("unroll") for (int m = 0; m < 4; ++m) _Pragma("unroll") for (int k = 0; k < 2; ++k) dst[m][k] = *(const PG8_LAS bf16x8*)(lds + PG8_SA(b, h) + aoff + m * 2048 + k * 1024); } while (0)
#define PG8_LDB(dst, b, h) do { _Pragma("unroll") for (int n = 0; n < 2; ++n) _Pragma("unroll") for (int k = 0; k < 2; ++k) dst[n][k] = *(const PG8_LAS bf16x8*)(lds + PG8_SB(b, h) + boff + n * 2048 + k * 1024); } while (0)
#define PG8_MMA(ai, bj, At, Bt) do { __builtin_amdgcn_s_setprio(1); _Pragma("unroll") for (int m = 0; m < 4; ++m) _Pragma("unroll") for (int n = 0; n < 2; ++n) _Pragma("unroll") for (int k = 0; k < 2; ++k) \
        acc[ai][bj][m][n] = __builtin_amdgcn_mfma_f32_16x16x32_bf16(Bt[n][k], At[m][k], acc[ai][bj][m][n], 0, 0, 0); __builtin_amdgcn_s_setprio(0); } while (0)
#define PG8_WAIT_V(n) asm volatile("s_waitcnt vmcnt(" #n ")" ::: "memory")
#define PG8_WAIT_L(n) asm volatile("s_waitcnt lgkmcnt(" #n ")" ::: "memory")
#define PG8_BAR __builtin_amdgcn_s_barrier()
#define PG8_SCHED __builtin_amdgcn_sched_barrier(0)
    Unit cur, nxt; int ui = 0;
    if (!S.next(0, cur)) return;
    f32x4 acc[2][2][4][2];
#pragma unroll
    for (int a = 0; a < 2; ++a)
#pragma unroll
        for (int b = 0; b < 2; ++b)
#pragma unroll
            for (int m = 0; m < 4; ++m)
#pragma unroll
                for (int n = 0; n < 2; ++n) acc[a][b][m][n] = (f32x4){0.f, 0.f, 0.f, 0.f};
    bf16x8 At[4][2], B0[2][2], B1[2][2];
    const char* cA = (const char*)g.A + (size_t)cur.pm * tstep; const char* cB = (const char*)g.Bt + (size_t)cur.pn * tstep;
    S.a_ready(cur);
    if constexpr (SP2) {
        PG8_STAGE(PG8_SB(0, 0), cB, voffB); PG8_STAGE(PG8_SB(0, 1), cB + hstep, voffB); PG8_STAGE(PG8_SA(0, 0), cA, voffA); PG8_STAGE(PG8_SA(0, 1), cA + hstep, voffA);
        if (wr == 1) PG8_BAR;
        PG8_WAIT_V(2); PG8_BAR;
        PG8_STAGE(PG8_SB(1, 0), cB + kstep, voffB); PG8_STAGE(PG8_SA(1, 0), cA + kstep, voffA); PG8_STAGE(PG8_SB(1, 1), cB + hstep + kstep, voffB);
        PG8_WAIT_V(6); PG8_BAR;
    } else {
        PG8_STAGE(PG8_SB(0, 0), cB, voffB); PG8_STAGE(PG8_SA(0, 0), cA, voffA); PG8_STAGE(PG8_SB(0, 1), cB + hstep, voffB); PG8_STAGE(PG8_SA(0, 1), cA + hstep, voffA);
        if (wr == 1) PG8_BAR;
        PG8_WAIT_V(4); PG8_BAR;
        PG8_STAGE(PG8_SB(1, 0), cB + kstep, voffB); PG8_STAGE(PG8_SA(1, 0), cA + kstep, voffA); PG8_STAGE(PG8_SB(1, 1), cB + hstep + kstep, voffB);
        PG8_WAIT_V(6); PG8_BAR;
    }
    for (;;) {
        const bool has_next = S.next(ui + 1, nxt);
        const char* nA = has_next ? (const char*)g.A + (size_t)nxt.pm * tstep : cA; const char* nB = has_next ? (const char*)g.Bt + (size_t)nxt.pn * tstep : cB;
        for (int t = 0; t < nt; t += 2) {
            const bool last = (t == nt - 2);
            const char* a1 = cA + (size_t)(t + 1) * kstep;
            const char* a2 = last ? nA : cA + (size_t)(t + 2) * kstep; const char* b2 = last ? nB : cB + (size_t)(t + 2) * kstep;
            const char* a3 = a2 + kstep; const char* b3 = b2 + kstep;
            if (last && has_next) S.a_ready(nxt);
            if constexpr (SP2) {
            PG8_LDB(B0, 0, 0); PG8_LDB(B1, 0, 1); PG8_SCHED; PG8_LDA(At, 0, 0); PG8_STAGE(PG8_SA(1, 1), a1 + hstep, voffA);
            PG8_WAIT_V(8); PG8_WAIT_L(0); PG8_BAR; PG8_MMA(0, 0, At, B0); PG8_MMA(0, 1, At, B1); PG8_BAR; PG8_SCHED;
            PG8_LDA(At, 0, 1); PG8_STAGE(PG8_SB(0, 0), b2, voffB); PG8_STAGE(PG8_SB(0, 1), b2 + hstep, voffB); PG8_STAGE(PG8_SA(0, 0), a2, voffA);
            PG8_WAIT_V(8); PG8_WAIT_L(0); PG8_BAR; PG8_MMA(1, 0, At, B0); PG8_MMA(1, 1, At, B1); PG8_BAR; PG8_SCHED;
            PG8_LDB(B0, 1, 0); PG8_LDB(B1, 1, 1); PG8_SCHED; PG8_LDA(At, 1, 0); PG8_STAGE(PG8_SA(0, 1), a2 + hstep, voffA);
            PG8_WAIT_V(8); PG8_WAIT_L(0); PG8_BAR; PG8_MMA(0, 0, At, B0); PG8_MMA(0, 1, At, B1); PG8_BAR; PG8_SCHED;
            PG8_LDA(At, 1, 1); PG8_STAGE(PG8_SB(1, 0), b3, voffB); PG8_STAGE(PG8_SB(1, 1), b3 + hstep, voffB); PG8_STAGE(PG8_SA(1, 0), a3, voffA);
            PG8_WAIT_V(8); PG8_WAIT_L(0); PG8_BAR; PG8_MMA(1, 0, At, B0); PG8_MMA(1, 1, At, B1); PG8_BAR; PG8_SCHED;
            } else {
            PG8_LDB(B0, 0, 0); PG8_SCHED; PG8_LDA(At, 0, 0); PG8_STAGE(PG8_SA(1, 1), a1 + hstep, voffA);
            PG8_WAIT_L(8); PG8_BAR; PG8_WAIT_L(0); PG8_MMA(0, 0, At, B0); PG8_BAR; PG8_SCHED;
            PG8_LDB(B1, 0, 1); PG8_STAGE(PG8_SB(0, 0), b2, voffB);
            PG8_BAR; PG8_WAIT_L(0); PG8_MMA(0, 1, At, B1); PG8_BAR;
            PG8_LDA(At, 0, 1); PG8_STAGE(PG8_SA(0, 0), a2, voffA);
            PG8_BAR; PG8_WAIT_L(0); PG8_MMA(1, 0, At, B0); PG8_BAR; PG8_SCHED;
            PG8_STAGE(PG8_SB(0, 1), b2 + hstep, voffB);
            PG8_WAIT_V(6); PG8_BAR; PG8_MMA(1, 1, At, B1); PG8_BAR;
            PG8_LDB(B0, 1, 0); PG8_SCHED; PG8_LDA(At, 1, 0); PG8_STAGE(PG8_SA(0, 1), a2 + hstep, voffA);
            PG8_WAIT_L(8); PG8_BAR; PG8_WAIT_L(0); PG8_MMA(0, 0, At, B0); PG8_BAR; PG8_SCHED;
            PG8_LDB(B1, 1, 1); PG8_STAGE(PG8_SB(1, 0), b3, voffB);
            PG8_BAR; PG8_WAIT_L(0); PG8_MMA(0, 1, At, B1); PG8_BAR;
            PG8_LDA(At, 1, 1); PG8_STAGE(PG8_SA(1, 0), a3, voffA);
            PG8_BAR; PG8_WAIT_L(0); PG8_MMA(1, 0, At, B0); PG8_BAR; PG8_SCHED;
            PG8_STAGE(PG8_SB(1, 1), b3 + hstep, voffB);
            PG8_WAIT_V(6); PG8_BAR; PG8_MMA(1, 1, At, B1); PG8_BAR;
            }
        }
        if constexpr (ALIGN_EPI) { if (wr == 0) PG8_BAR; }
        if constexpr (!Epi::AFTER_DRAIN) { E(acc, cur, wr, wc, fr, fq); S.done(cur); }
        if (!has_next) break;
#pragma unroll
        for (int a = 0; a < 2; ++a)
#pragma unroll
            for (int b = 0; b < 2; ++b)
#pragma unroll
                for (int m = 0; m < 4; ++m)
#pragma unroll
                    for (int n = 0; n < 2; ++n) acc[a][b][m][n] = (f32x4){0.f, 0.f, 0.f, 0.f};
        cur = nxt; cA = nA; cB = nB; ++ui;
        if constexpr (ALIGN_EPI) { if (wr == 1) PG8_BAR; }
    }
    PG8_WAIT_V(0);
    if constexpr (!ALIGN_EPI) { if (wr == 0) PG8_BAR; }
    PG8_BAR;
    if constexpr (Epi::AFTER_DRAIN) { E.fused(acc, cur, wr, wc, fr, fq, lds, wid, lane); S.done(cur); }
#undef PG8_SA
#undef PG8_SB
#undef PG8_STAGE
#undef PG8_LDA
#undef PG8_LDB
#undef PG8_MMA
#undef PG8_WAIT_V
#undef PG8_WAIT_L
#undef PG8_BAR
#undef PG8_SCHED
}
}
#define GAS __attribute__((address_space(1)))
#define LAS __attribute__((address_space(3)))
typedef unsigned short bf16;
typedef unsigned v4u __attribute__((ext_vector_type(4)));
typedef float f32x4 __attribute__((ext_vector_type(4)));
typedef short bf16x8 __attribute__((ext_vector_type(8)));
typedef GAS unsigned gu32;
typedef GAS unsigned long long gu64;
#define RLX_AGENT __ATOMIC_RELAXED, __HIP_MEMORY_SCOPE_AGENT
#define LDS_WAIT() asm volatile("s_waitcnt lgkmcnt(0)" ::: "memory")
#define VM_WAIT() asm volatile("s_waitcnt vmcnt(0)" ::: "memory")
__device__ __forceinline__ unsigned long long rt() { return __builtin_amdgcn_s_memrealtime(); }
__device__ __forceinline__ unsigned f2bf(float f) { unsigned u = __builtin_bit_cast(unsigned, f); return (u + 0x7fffu + ((u >> 16) & 1u)) >> 16; }
__device__ __forceinline__ unsigned pk2(float lo, float hi) { return f2bf(lo) | (f2bf(hi) << 16); }

#define XB_TMO      128
#define XB_XCNT(j)  (256  + 64 * (j))
#define XB_XSUB(j)  (1280 + 64 * (j))
#define XB_XGEN(j)  (2304 + 64 * (j))
#define XB_TOP      3328
#define XB_TOPGEN   3392
#define XCD_BAR_WORDS 3456
#define XB_SPIN_CAP (1u << 18)

__device__ __forceinline__ unsigned xb_ld(unsigned* p)              { return __hip_atomic_load(p, __ATOMIC_RELAXED, __HIP_MEMORY_SCOPE_AGENT); }
__device__ __forceinline__ unsigned xb_add(unsigned* p, unsigned v) { return __hip_atomic_fetch_add(p, v, __ATOMIC_RELAXED, __HIP_MEMORY_SCOPE_AGENT); }
__device__ __forceinline__ unsigned xb_xcc_id() { return (unsigned)__builtin_amdgcn_s_getreg((3 << 11) | 20) & 0xFu; }
#define XB_SPIN(cond, bar) do { unsigned _sp = 0; while (cond) { __builtin_amdgcn_s_sleep(1); \
    if ((++_sp & 255u) == 0u) { if (xb_ld(&(bar)[XB_TMO])) break; if (_sp > XB_SPIN_CAP) { atomicAdd(&(bar)[XB_TMO], 1u); break; } } } } while (0)

struct XcdBarrier {
    unsigned* bar; unsigned x;
    volatile LAS unsigned* st;
};

__device__ __forceinline__ XcdBarrier xcd_barrier_post(unsigned* bar, volatile LAS unsigned* st) {
    XcdBarrier b; b.bar = bar; b.x = xb_xcc_id(); b.st = st;
    if (threadIdx.x == 0) (void)xb_add(&bar[XB_XCNT(b.x)], 1u);
    return b;
}
__device__ __forceinline__ void xcd_barrier_complete(unsigned* bar, unsigned x, unsigned& nloc, unsigned& nx) {
    const unsigned G = gridDim.x * gridDim.y * gridDim.z;
    unsigned sum, cnt, mine, sp = 0u;
    for (;;) {
        sum = 0u; cnt = 0u; mine = 0u;
#pragma unroll
        for (unsigned j = 0; j < 16; ++j) { const unsigned c = xb_ld(&bar[XB_XCNT(j)]); sum += c; cnt += (c > 0u) ? 1u : 0u; mine = (j == x) ? c : mine; }
        if (sum == G) break;
        __builtin_amdgcn_s_sleep(1);
        if ((++sp & 255u) == 0u) { if (xb_ld(&bar[XB_TMO])) break; if (sp > XB_SPIN_CAP) { atomicAdd(&bar[XB_TMO], 1u); break; } }
    }
    nloc = mine > 0u ? mine : 1u; nx = cnt > 0u ? cnt : 1u;
}

__device__ __forceinline__ void xcd_barrier(const XcdBarrier& b) {
    asm volatile("s_waitcnt vmcnt(0)" ::: "memory");
    __syncthreads();
    if (threadIdx.x == 0) {
        unsigned* bar = b.bar;
        __builtin_amdgcn_s_waitcnt(0);
        unsigned nloc = b.st[0], nx = b.st[1];
        if (nloc == 0u) { xcd_barrier_complete(bar, b.x, nloc, nx); b.st[0] = nloc; b.st[1] = nx; }
        const unsigned old = xb_add(&bar[XB_XSUB(b.x)], 1u);
        const unsigned gen = old / nloc;
        if (old + 1u == (gen + 1u) * nloc) {
            __builtin_amdgcn_fence(__ATOMIC_RELEASE, "agent");
            asm volatile("s_waitcnt vmcnt(0)" ::: "memory");
            const unsigned og = xb_add(&bar[XB_TOP], 1u);
            const unsigned tg = og / nx;
            if (og + 1u == (tg + 1u) * nx) xb_add(&bar[XB_TOPGEN], 1u);
            else XB_SPIN(xb_ld(&bar[XB_TOPGEN]) == tg, bar);
            __builtin_amdgcn_fence(__ATOMIC_ACQUIRE, "agent");
            xb_add(&bar[XB_XGEN(b.x)], 1u);
            asm volatile("s_waitcnt vmcnt(0)" ::: "memory");
        } else {
            XB_SPIN(xb_ld(&bar[XB_XGEN(b.x)]) == gen, bar);
            __builtin_amdgcn_fence(__ATOMIC_ACQUIRE, "agent");
            asm volatile("s_waitcnt vmcnt(0)" ::: "memory");
        }
    }
    __syncthreads();
}


constexpr size_t MiB = 1u << 20;
constexpr size_t WS_CTL = 0, CTL_ZERO_BYTES = 1 * MiB;
constexpr size_t WS_BIAS = 1 * MiB, WS_LAM = 1 * MiB + 4096, WS_RMEM = 1 * MiB + 8192, WS_R0 = 1 * MiB + 65536;
constexpr size_t WS_SS1 = 2 * MiB, WS_SS2 = 4 * MiB, WS_SS3 = 6 * MiB;
constexpr size_t WS_WIN = 8 * MiB, WS_WOUT = 14 * MiB, WS_WCQ = 16 * MiB, WS_WCKV = 18 * MiB, WS_WCO = 22 * MiB, WS_WUP = 24 * MiB, WS_WDOWN = 36 * MiB;
constexpr size_t WS_MEMB = 42 * MiB, WS_MKB = 44 * MiB, WS_MVB = 46 * MiB;
constexpr size_t WS_XB = 48 * MiB, WS_ZCONV = 82 * MiB, WS_QB = 132 * MiB, WS_KB = 149 * MiB, WS_VB = 166 * MiB, WS_MIX = 184 * MiB;
constexpr size_t WS_X1 = 218 * MiB, WS_X1B = 284 * MiB, WS_QC = 317 * MiB, WS_OC = 350 * MiB, WS_X2 = 383 * MiB, WS_X2B = 449 * MiB;
constexpr size_t WS_UPB = 482 * MiB, WS_ACT = 661 * MiB, WS_X3 = 751 * MiB, WS_DPART = 817 * MiB, WS_END = 826 * MiB;
constexpr int CW_BAR = 4096;
constexpr int DP_STRIDE = 132;

constexpr int RING_OFF = 0, RING_BYTES = 131072;
constexpr int LDSCTL_OFF = RING_BYTES, MISC_OFF = LDSCTL_OFF + 320;
constexpr int LDS_BYTES = 147456;
constexpr int NWAVES = 8;

__device__ __forceinline__ float wave_sum(float v) {
#pragma unroll
    for (int o = 1; o < 64; o <<= 1) v += __shfl_xor(v, o);
    return v;
}
__device__ __forceinline__ float wave_max(float v) {
#pragma unroll
    for (int o = 1; o < 64; o <<= 1) v = fmaxf(v, __shfl_xor(v, o));
    return v;
}
__device__ __forceinline__ float bf_lo(unsigned w) { return __uint_as_float(w << 16); }
__device__ __forceinline__ float bf_hi(unsigned w) { return __uint_as_float(w & 0xffff0000u); }
__device__ __forceinline__ void unpack8(const v4u w, float (&f)[8]) { f[0] = bf_lo(w.x); f[1] = bf_hi(w.x); f[2] = bf_lo(w.y); f[3] = bf_hi(w.y); f[4] = bf_lo(w.z); f[5] = bf_hi(w.z); f[6] = bf_lo(w.w); f[7] = bf_hi(w.w); }
__device__ __forceinline__ v4u pack8f(const float (&f)[8]) { v4u o; o.x = pk2(f[0], f[1]); o.y = pk2(f[2], f[3]); o.z = pk2(f[4], f[5]); o.w = pk2(f[6], f[7]); return o; }
template <int CTRL> __device__ __forceinline__ float dppf(float x) { return __int_as_float(__builtin_amdgcn_update_dpp(0, __float_as_int(x), CTRL, 0xF, 0xF, true)); }
__device__ __forceinline__ float ex2(float x) { return __builtin_amdgcn_exp2f(x); }
__device__ __forceinline__ int t5_bucket(int n) {
    if (n < 16) return n;
    const int b = 16 + (int)(__log2f((float)n * 0.0625f) * (16.0f / 3.0f));
    return b < 31 ? b : 31;
}

__device__ __forceinline__ void transpose_item(const float* W, int K, int N, bf16* WT, const float* ksc, LAS float* scr, int item, int lane) {
    const int nblk = N / 32, kb = item / nblk, nb = item % nblk, k0 = 64 * kb, n0 = 32 * nb;
#pragma unroll 8
    for (int i = 0; i < 32; ++i) { const int kk = 2 * i + (lane >> 5); const float sc = ksc ? ksc[k0 + kk] : 1.0f; scr[kk * 33 + (lane & 31)] = W[(size_t)(k0 + kk) * N + n0 + (lane & 31)] * sc; }
    LDS_WAIT(); asm volatile("" ::: "memory");
    const int c = lane & 7;
#pragma unroll
    for (int j = 0; j < 4; ++j) { const int n = (lane >> 3) + 8 * j; const LAS float* s = scr + (8 * c) * 33 + n;
        v4u o; o.x = pk2(s[0 * 33], s[1 * 33]); o.y = pk2(s[2 * 33], s[3 * 33]); o.z = pk2(s[4 * 33], s[5 * 33]); o.w = pk2(s[6 * 33], s[7 * 33]);
        *(GAS v4u*)(WT + (size_t)(n0 + n) * K + k0 + 8 * c) = o; }
    LDS_WAIT(); asm volatile("" ::: "memory");
}
__device__ __forceinline__ void rms_row(const float* xrow, bf16* orow, float* rout, int lane) {
    const GAS f32x4* xr = (const GAS f32x4*)xrow + lane;
    f32x4 v[4]; float s = 0.f;
#pragma unroll
    for (int j = 0; j < 4; ++j) { v[j] = xr[64 * j]; s += (v[j].x * v[j].x + v[j].y * v[j].y) + (v[j].z * v[j].z + v[j].w * v[j].w); }
    s = wave_sum(s);
    if (lane == 0) *rout = 1.0f / sqrtf(s * (1.0f / 1024.0f) + EPS);
    GAS unsigned long long* o8 = (GAS unsigned long long*)orow + lane;
#pragma unroll
    for (int j = 0; j < 4; ++j) o8[64 * j] = (unsigned long long)pk2(v[j].x, v[j].y) | ((unsigned long long)pk2(v[j].z, v[j].w) << 32);
}
struct Ptrs {
    const float* in[32]; float* out; unsigned char* ws;
};
#define WSP(T, off) ((T*)(P.ws + (off)))

__device__ __forceinline__ void p0_prologue(const Ptrs& P, LAS unsigned char* lds, int wave, int lane, int G) {
    LAS float* scr = (LAS float*)(lds + RING_OFF + wave * 16384);
    const int gw = blockIdx.x * NWAVES + wave, NGW = G * NWAVES;
    constexpr int I_IN = 16 * 96, I_OUT = 16 * 32, I_CQ = 16 * 32, I_CKV = 16 * 64, I_CO = 16 * 32, I_UP = 16 * 176, I_DOWN = 44 * 32;
    constexpr int NITEMS = I_IN + I_OUT + I_CQ + I_CKV + I_CO + I_UP + I_DOWN;
    for (int it = gw; it < NITEMS; it += NGW) {
        int r = it;
        if (r < I_IN) { transpose_item(P.in[12], 1024, 3072, WSP(bf16, WS_WIN), P.in[11], scr, r, lane); continue; } r -= I_IN;
        if (r < I_OUT) { transpose_item(P.in[20], 1024, 1024, WSP(bf16, WS_WOUT), nullptr, scr, r, lane); continue; } r -= I_OUT;
        if (r < I_CQ) { transpose_item(P.in[23], 1024, 1024, WSP(bf16, WS_WCQ), P.in[21], scr, r, lane); continue; } r -= I_CQ;
        if (r < I_CKV) { transpose_item(P.in[24], 1024, 2048, WSP(bf16, WS_WCKV), P.in[22], scr, r, lane); continue; } r -= I_CKV;
        if (r < I_CO) { transpose_item(P.in[25], 1024, 1024, WSP(bf16, WS_WCO), nullptr, scr, r, lane); continue; } r -= I_CO;
        if (r < I_UP) { transpose_item(P.in[27], 1024, 5632, WSP(bf16, WS_WUP), P.in[26], scr, r, lane); continue; } r -= I_UP;
        transpose_item(P.in[30], 2816, 1024, WSP(bf16, WS_WDOWN), nullptr, scr, r, lane);
    }
    bf16* xb = WSP(bf16, WS_XB); float* r0 = WSP(float, WS_R0);
    for (int m = gw; m < MT; m += NGW) {
        if (m < MREAL) { const float* src = m < MP ? P.in[0] + (size_t)m * DM : P.in[1] + (size_t)(m - MP) * DM; rms_row(src, xb + (size_t)m * DM, r0 + m, lane); }
        else { GAS unsigned long long* o8 = (GAS unsigned long long*)(xb + (size_t)m * DM) + lane;
#pragma unroll
            for (int j = 0; j < 4; ++j) o8[64 * j] = 0ull;
            if (lane == 0) r0[m] = 0.f; }
    }
    bf16* memb = WSP(bf16, WS_MEMB); float* rmem = WSP(float, WS_RMEM);
    for (int m = gw; m < NB * NMEM; m += NGW) rms_row(P.in[2] + (size_t)m * DM, memb + (size_t)m * DM, rmem + m, lane);
    if (blockIdx.x == 0) {
        float* bt = WSP(float, WS_BIAS);
        for (int idx = threadIdx.x; idx < 4 * DP_STRIDE; idx += NWAVES * 64) { const int h = idx / DP_STRIDE, n = idx % DP_STRIDE; const int bk = n < 128 ? t5_bucket(n) : 31; bt[idx] = P.in[10][bk * 4 + h] * LOG2E; }
        if (wave == 0) { const float a = wave_sum(P.in[15][lane] * P.in[16][lane]), b = wave_sum(P.in[17][lane] * P.in[18][lane]);
            if (lane == 0) *WSP(float, WS_LAM) = expf(a) - expf(b) + LAM_INIT; }
    }
}

__device__ __forceinline__ void p_convmix(const Ptrs& P, int wave, int lane, int G) {
    const int gw = blockIdx.x * NWAVES + wave, NGW = G * NWAVES;
    const bf16* zc = WSP(const bf16, WS_ZCONV); bf16* mix = WSP(bf16, WS_MIX);
    const int ch = lane * 8;
    float w0[8], w1[8], w2[8], bb[8];
#pragma unroll
    for (int i = 0; i < 8; ++i) { w0[i] = P.in[13][ch + i]; w1[i] = P.in[13][512 + ch + i]; w2[i] = P.in[13][1024 + ch + i]; bb[i] = P.in[14][ch + i]; }
    constexpr int NPI = MP / 16;
    for (int it = gw; it < NPI + DB; it += NGW) {
        float p2[8], p1[8];
        int row0, nrow, t0, bidx; const bool prompt = it < NPI;
        if (prompt) { row0 = it * 16; nrow = 16; t0 = row0 % SEQ; bidx = row0 / SEQ;
            if (t0 == 0) {
#pragma unroll
                for (int i = 0; i < 8; ++i) { p2[i] = 0.f; p1[i] = 0.f; } }
            else { float c[8], u[8];
                unpack8(*(const GAS v4u*)(zc + (size_t)(row0 - 2) * 1536 + 512 + ch), c); unpack8(*(const GAS v4u*)(zc + (size_t)(row0 - 2) * 1536 + 1024 + ch), u);
#pragma unroll
                for (int i = 0; i < 8; ++i) p2[i] = c[i] * u[i];
                unpack8(*(const GAS v4u*)(zc + (size_t)(row0 - 1) * 1536 + 512 + ch), c); unpack8(*(const GAS v4u*)(zc + (size_t)(row0 - 1) * 1536 + 1024 + ch), u);
#pragma unroll
                for (int i = 0; i < 8; ++i) p1[i] = c[i] * u[i]; } }
        else { bidx = it - NPI; row0 = MP + bidx * DS; nrow = DS; t0 = 0;
            const float* st = P.in[6] + (size_t)bidx * 2 * DCONV;
#pragma unroll
            for (int i = 0; i < 8; ++i) { p2[i] = st[ch + i]; p1[i] = st[DCONV + ch + i]; } }
        for (int r = 0; r < nrow; ++r) {
            const size_t row = (size_t)(row0 + r);
            float bv[8], c[8], u[8], pre[8], y[8];
            unpack8(*(const GAS v4u*)(zc + row * 1536 + ch), bv); unpack8(*(const GAS v4u*)(zc + row * 1536 + 512 + ch), c); unpack8(*(const GAS v4u*)(zc + row * 1536 + 1024 + ch), u);
#pragma unroll
            for (int i = 0; i < 8; ++i) { pre[i] = c[i] * u[i]; y[i] = bv[i] * (bb[i] + w0[i] * p2[i] + w1[i] * p1[i] + w2[i] * pre[i]); }
            *(GAS v4u*)(mix + row * 1024 + ch) = pack8f(y);
            const int t = t0 + r;
            if (prompt) { if (t >= SEQ - 2) { float* o = P.out + O_CMP + (size_t)(bidx * 2 + (t - (SEQ - 2))) * DCONV + ch; *(f32x4*)o = (f32x4){pre[0], pre[1], pre[2], pre[3]}; *(f32x4*)(o + 4) = (f32x4){pre[4], pre[5], pre[6], pre[7]}; } }
            else { if (t >= DS - 2) { float* o = P.out + O_CMS + (size_t)(bidx * 2 + (t - (DS - 2))) * DCONV + ch; *(f32x4*)o = (f32x4){pre[0], pre[1], pre[2], pre[3]}; *(f32x4*)(o + 4) = (f32x4){pre[4], pre[5], pre[6], pre[7]}; } }
#pragma unroll
            for (int i = 0; i < 8; ++i) { p2[i] = p1[i]; p1[i] = pre[i]; }
        }
    }
}

__device__ __forceinline__ void p_convffn(const Ptrs& P, int wave, int lane, int G) {
    const int gw = blockIdx.x * NWAVES + wave, NGW = G * NWAVES;
    const bf16* up = WSP(const bf16, WS_UPB); bf16* act = WSP(bf16, WS_ACT);
    constexpr int NPI = MP / 16, NCH = 6;
    for (int it = gw; it < (NPI + DB) * NCH; it += NGW) {
        const int rb = it / NCH, cc = it % NCH; const int cg = cc * 64 + lane;
        if (cg < DFF / 8) {
            const int ch = cg * 8;
            float wg0[8], wg1[8], wg2[8], bg[8], wu0[8], wu1[8], wu2[8], bu[8];
#pragma unroll
            for (int i = 0; i < 8; ++i) { wg0[i] = P.in[28][ch + i]; wg1[i] = P.in[28][DUP + ch + i]; wg2[i] = P.in[28][2 * DUP + ch + i]; bg[i] = P.in[29][ch + i];
                wu0[i] = P.in[28][DFF + ch + i]; wu1[i] = P.in[28][DUP + DFF + ch + i]; wu2[i] = P.in[28][2 * DUP + DFF + ch + i]; bu[i] = P.in[29][DFF + ch + i]; }
            float g2[8], g1[8], u2[8], u1[8];
            int row0, nrow, t0, bidx; const bool prompt = rb < NPI;
            if (prompt) { row0 = rb * 16; nrow = 16; t0 = row0 % SEQ; bidx = row0 / SEQ;
                if (t0 == 0) {
#pragma unroll
                    for (int i = 0; i < 8; ++i) { g2[i] = 0.f; g1[i] = 0.f; u2[i] = 0.f; u1[i] = 0.f; } }
                else { unpack8(*(const GAS v4u*)(up + (size_t)(row0 - 2) * DUP + ch), g2); unpack8(*(const GAS v4u*)(up + (size_t)(row0 - 2) * DUP + DFF + ch), u2);
                    unpack8(*(const GAS v4u*)(up + (size_t)(row0 - 1) * DUP + ch), g1); unpack8(*(const GAS v4u*)(up + (size_t)(row0 - 1) * DUP + DFF + ch), u1); } }
            else { bidx = rb - NPI; row0 = MP + bidx * DS; nrow = DS; t0 = 0;
                const float* st = P.in[7] + (size_t)bidx * 2 * DUP;
#pragma unroll
                for (int i = 0; i < 8; ++i) { g2[i] = st[ch + i]; u2[i] = st[DFF + ch + i]; g1[i] = st[DUP + ch + i]; u1[i] = st[DUP + DFF + ch + i]; } }
            for (int r = 0; r < nrow; ++r) {
                const size_t row = (size_t)(row0 + r);
                float g0[8], u0[8], a[8];
                unpack8(*(const GAS v4u*)(up + row * DUP + ch), g0); unpack8(*(const GAS v4u*)(up + row * DUP + DFF + ch), u0);
#pragma unroll
                for (int i = 0; i < 8; ++i) { const float gc = bg[i] + wg0[i] * g2[i] + wg1[i] * g1[i] + wg2[i] * g0[i]; const float uc = bu[i] + wu0[i] * u2[i] + wu1[i] * u1[i] + wu2[i] * u0[i];
                    a[i] = gc / (1.0f + __expf(-gc)) * uc; }
                *(GAS v4u*)(act + row * DFF + ch) = pack8f(a);
                const int t = t0 + r; const int tl = prompt ? SEQ - 2 : DS - 2;
                if (t >= tl) { float* o = P.out + (prompt ? O_CFP : O_CFS) + (size_t)(bidx * 2 + (t - tl)) * DUP + ch;
                    *(f32x4*)o = (f32x4){g0[0], g0[1], g0[2], g0[3]}; *(f32x4*)(o + 4) = (f32x4){g0[4], g0[5], g0[6], g0[7]};
                    *(f32x4*)(o + DFF) = (f32x4){u0[0], u0[1], u0[2], u0[3]}; *(f32x4*)(o + DFF + 4) = (f32x4){u0[4], u0[5], u0[6], u0[7]}; }
#pragma unroll
                for (int i = 0; i < 8; ++i) { g2[i] = g1[i]; g1[i] = g0[i]; u2[i] = u1[i]; u1[i] = u0[i]; }
            }
        }
    }
}

__device__ __forceinline__ void p_final(const Ptrs& P, int wave, int lane, int G) {
    const int gw = blockIdx.x * NWAVES + wave, NGW = G * NWAVES;
    const float* x3 = WSP(const float, WS_X3); const float* ss = WSP(const float, WS_SS3); const float* w = P.in[31];
    f32x4 wv[4];
#pragma unroll
    for (int j = 0; j < 4; ++j) wv[j] = *((const f32x4*)w + lane + 64 * j);
    for (int m = gw; m < MREAL; m += NGW) {
        const float tot = wave_sum(lane < 16 ? ss[(size_t)m * 16 + lane] : 0.f);
        const float rs = 1.0f / sqrtf(tot * (1.0f / 1024.0f) + EPS);
        const GAS f32x4* xr = (const GAS f32x4*)(x3 + (size_t)m * DM) + lane;
        GAS f32x4* o = (GAS f32x4*)(P.out + (m < MP ? O_Y + (size_t)m * DM : O_YS + (size_t)(m - MP) * DM)) + lane;
#pragma unroll
        for (int j = 0; j < 4; ++j) o[64 * j] = xr[64 * j] * rs * wv[j];
    }
}

__device__ __forceinline__ void p_dattn_naive(const Ptrs& P, LAS unsigned char* lds, int wave, int lane, int G) {
    const int gw = blockIdx.x * NWAVES + wave, NGW = G * NWAVES;
    const bf16* qb = WSP(const bf16, WS_QB); const bf16* kb = WSP(const bf16, WS_KB); const bf16* vb = WSP(const bf16, WS_VB); bf16* mix = WSP(bf16, WS_MIX);
    const float* bt = WSP(const float, WS_BIAS); const float lam = *WSP(const float, WS_LAM);
    LAS float* qs = (LAS float*)(lds + wave * 1024); LAS float* ps = qs + 128;
    for (int it = gw; it < MP * NH; it += NGW) {
        const int m = it >> 2, h = it & 3, b = m / SEQ, t = m % SEQ;
        { const unsigned w = *(const GAS unsigned*)(qb + (size_t)m * 512 + h * 128 + 2 * lane); qs[2 * lane] = bf_lo(w); qs[2 * lane + 1] = bf_hi(w); }
        LDS_WAIT(); asm volatile("" ::: "memory");
        float m1 = -1e30f, m2 = -1e30f, l1 = 0.f, l2 = 0.f, o1x = 0.f, o1y = 0.f, o2x = 0.f, o2y = 0.f;
        for (int k0 = 0; k0 <= t; k0 += 64) {
            const int key = k0 + lane; const bool valid = key <= t; const int kc = valid ? key : t;
            const bf16* kr = kb + (size_t)(b * SEQ + kc) * 512 + h * 128;
            float s1 = 0.f, s2 = 0.f;
#pragma unroll
            for (int c = 0; c < 16; ++c) { float kf[8]; unpack8(*(const GAS v4u*)(kr + c * 8), kf);
#pragma unroll
                for (int i = 0; i < 8; ++i) { if (c < 8) s1 += kf[i] * qs[c * 8 + i]; else s2 += kf[i] * qs[c * 8 + i]; } }
            const int rel = t - kc; const float bias = bt[h * DP_STRIDE + (rel < 128 ? rel : 128)];
            s1 = valid ? s1 + bias : -1e30f; s2 = valid ? s2 + bias : -1e30f;
            const float mn1 = fmaxf(m1, wave_max(s1)), mn2 = fmaxf(m2, wave_max(s2));
            const float a1 = ex2(m1 - mn1), a2 = ex2(m2 - mn2);
            const float p1 = valid ? ex2(s1 - mn1) : 0.f, p2 = valid ? ex2(s2 - mn2) : 0.f;
            l1 = l1 * a1 + wave_sum(p1); l2 = l2 * a2 + wave_sum(p2); m1 = mn1; m2 = mn2;
            o1x *= a1; o1y *= a1; o2x *= a2; o2y *= a2;
            ps[lane] = p1; ps[64 + lane] = p2;
            LDS_WAIT(); asm volatile("" ::: "memory");
            const int nk = (t - k0 + 1) < 64 ? (t - k0 + 1) : 64;
            const bf16* vr = vb + (size_t)(b * SEQ + k0) * 512 + h * 128 + 2 * lane;
            for (int kk = 0; kk < nk; ++kk) { const float pa = ps[kk], pb = ps[64 + kk]; const unsigned w = *(const GAS unsigned*)(vr + (size_t)kk * 512); const float vx = bf_lo(w), vy = bf_hi(w);
                o1x += pa * vx; o1y += pa * vy; o2x += pb * vx; o2y += pb * vy; }
            LDS_WAIT(); asm volatile("" ::: "memory");
        }
        const float ax = o1x / l1 - lam * (o2x / l2), ay = o1y / l1 - lam * (o2y / l2);
        const float ssq = wave_sum(ax * ax + ay * ay);
        const float rn = (1.0f - LAM_INIT) / sqrtf(ssq * (1.0f / 128.0f) + EPS);
        const float wx = P.in[19][2 * lane], wy = P.in[19][2 * lane + 1];
        *(GAS unsigned*)(mix + (size_t)m * 1024 + 512 + h * 128 + 2 * lane) = pk2(ax * rn * wx, ay * rn * wy);
    }
}

template <bool SAMPLE> __device__ __forceinline__ void p_xattn_naive(const Ptrs& P, LAS unsigned char* lds, int wave, int lane, int G) {
    const int gw = blockIdx.x * NWAVES + wave, NGW = G * NWAVES;
    const bf16* qc = WSP(const bf16, WS_QC); bf16* oc = WSP(bf16, WS_OC);
    const bf16* mkb = WSP(const bf16, WS_MKB); const bf16* mvb = WSP(const bf16, WS_MVB);
    LAS float* qs = (LAS float*)(lds + wave * 2048); LAS float* ps = qs + 256;
    const int nit = (SAMPLE ? MS : MP) * MHEADS;
    for (int it = gw; it < nit; it += NGW) {
        const int mr = it >> 2, h = it & 3; const int m = SAMPLE ? MP + mr : mr; const int b = SAMPLE ? mr / DS : mr / SEQ;
        { const unsigned long long w = *(const GAS unsigned long long*)(qc + (size_t)m * 1024 + h * 256 + 4 * lane);
          qs[4 * lane] = bf_lo((unsigned)w); qs[4 * lane + 1] = bf_hi((unsigned)w); qs[4 * lane + 2] = bf_lo((unsigned)(w >> 32)); qs[4 * lane + 3] = bf_hi((unsigned)(w >> 32)); }
        LDS_WAIT(); asm volatile("" ::: "memory");
        float s[4];
#pragma unroll
        for (int c = 0; c < 4; ++c) {
            const int key = c * 64 + lane; float acc = 0.f;
            if (SAMPLE) { const float* kr = P.in[8] + ((size_t)(b * NMEM + key) * MHEADS + h) * MDH;
#pragma unroll 8
                for (int d = 0; d < 64; ++d) { const f32x4 kv = *(const GAS f32x4*)(kr + 4 * d); acc += kv.x * qs[4 * d] + kv.y * qs[4 * d + 1] + kv.z * qs[4 * d + 2] + kv.w * qs[4 * d + 3]; } }
            else { const bf16* kr = mkb + (size_t)(b * NMEM + key) * 1024 + h * 256;
#pragma unroll 8
                for (int d = 0; d < 32; ++d) { float kf[8]; unpack8(*(const GAS v4u*)(kr + 8 * d), kf);
#pragma unroll
                    for (int i = 0; i < 8; ++i) acc += kf[i] * qs[8 * d + i]; } }
            s[c] = acc;
        }
        const float mx = wave_max(fmaxf(fmaxf(s[0], s[1]), fmaxf(s[2], s[3])));
        float lsum = 0.f;
#pragma unroll
        for (int c = 0; c < 4; ++c) { const float p = ex2(s[c] - mx); ps[c * 64 + lane] = p; lsum += p; }
        lsum = wave_sum(lsum);
        LDS_WAIT(); asm volatile("" ::: "memory");
        float o[4] = {0.f, 0.f, 0.f, 0.f};
        for (int key = 0; key < NMEM; ++key) {
            const float p = ps[key];
            if (SAMPLE) { const f32x4 v = *(const GAS f32x4*)(P.in[9] + ((size_t)(b * NMEM + key) * MHEADS + h) * MDH + 4 * lane); o[0] += p * v.x; o[1] += p * v.y; o[2] += p * v.z; o[3] += p * v.w; }
            else { const unsigned long long w = *(const GAS unsigned long long*)(mvb + (size_t)(b * NMEM + key) * 1024 + h * 256 + 4 * lane);
                o[0] += p * bf_lo((unsigned)w); o[1] += p * bf_hi((unsigned)w); o[2] += p * bf_lo((unsigned)(w >> 32)); o[3] += p * bf_hi((unsigned)(w >> 32)); }
        }
        const float il = 1.0f / lsum;
        *(GAS unsigned long long*)(oc + (size_t)m * 1024 + h * 256 + 4 * lane) = (unsigned long long)pk2(o[0] * il, o[1] * il) | ((unsigned long long)pk2(o[2] * il, o[3] * il) << 32);
        LDS_WAIT(); asm volatile("" ::: "memory");
    }
}

__device__ __forceinline__ void p_decode_split(const Ptrs& P, int wave, int lane, int G) {
    const int gw = blockIdx.x * NWAVES + wave, NGW = G * NWAVES;
    const bf16* qb = WSP(const bf16, WS_QB); const float* bt = WSP(const float, WS_BIAS); float* dpart = WSP(float, WS_DPART);
    const float* ck = P.in[3]; const float* cv = P.in[4]; const int* ptab = (const int*)P.in[5];
    const int r = lane >> 4, cl = lane & 15, d0 = cl * 8;
    for (int it = gw; it < DB * NH * 16; it += NGW) {
        const int bh = it >> 4, chunk = it & 15, bs = bh >> 2, h = bh & 3;
        float qv[4][8];
#pragma unroll
        for (int t = 0; t < 4; ++t) unpack8(*(const GAS v4u*)(qb + (size_t)(MP + bs * DS + t) * 512 + h * 128 + d0), qv[t]);
        const float b31 = bt[h * DP_STRIDE + 128];
        const int j0 = chunk * 512;
        float mm[4], ll[4], accA[4][8], accB[4][8];
#pragma unroll
        for (int t = 0; t < 4; ++t) { mm[t] = -1e30f; ll[t] = 0.f;
#pragma unroll
            for (int d = 0; d < 8; ++d) { accA[t][d] = 0.f; accB[t][d] = 0.f; } }
        f32x4 Ka[2][2], Va[2][2], Kb[2][2], Vb[2][2];
#define DEC_ISSUE(blk, K_, V_) do { const int jb_ = j0 + (blk) * 8; const int page_ = __builtin_amdgcn_readfirstlane(ptab[bs * NPAGES + (jb_ >> 7)]); \
        _Pragma("unroll") for (int i_ = 0; i_ < 2; ++i_) { const size_t off_ = ((size_t)(page_ * PAGE + (jb_ & 127) + r + 4 * i_) * NH + h) * 128 + d0; \
            K_[i_][0] = *(const GAS f32x4*)(ck + off_); K_[i_][1] = *(const GAS f32x4*)(ck + off_ + 4); V_[i_][0] = *(const GAS f32x4*)(cv + off_); V_[i_][1] = *(const GAS f32x4*)(cv + off_ + 4); } } while (0)
#define DEC_COMPUTE(blk, K_, V_) do { \
        float s_[2][4]; \
        _Pragma("unroll") for (int i_ = 0; i_ < 2; ++i_) _Pragma("unroll") for (int t_ = 0; t_ < 4; ++t_) { \
            float a_ = K_[i_][0].x * qv[t_][0] + K_[i_][0].y * qv[t_][1] + K_[i_][0].z * qv[t_][2] + K_[i_][0].w * qv[t_][3] + K_[i_][1].x * qv[t_][4] + K_[i_][1].y * qv[t_][5] + K_[i_][1].z * qv[t_][6] + K_[i_][1].w * qv[t_][7]; \
            a_ += dppf<0xB1>(a_); a_ += dppf<0x4E>(a_); a_ += dppf<0x141>(a_); s_[i_][t_] = a_; } \
        const int jb_ = j0 + (blk) * 8; \
        if (jb_ + 7 + 128 <= PAST) { _Pragma("unroll") for (int i_ = 0; i_ < 2; ++i_) _Pragma("unroll") for (int t_ = 0; t_ < 4; ++t_) s_[i_][t_] += b31; } \
        else { _Pragma("unroll") for (int i_ = 0; i_ < 2; ++i_) _Pragma("unroll") for (int t_ = 0; t_ < 4; ++t_) { const int rel_ = PAST + t_ - (jb_ + r + 4 * i_); s_[i_][t_] += bt[h * DP_STRIDE + (rel_ < 128 ? rel_ : 128)]; } } \
        float mn_[4]; bool grow_ = false; \
        _Pragma("unroll") for (int t_ = 0; t_ < 4; ++t_) { mn_[t_] = fmaxf(mm[t_], fmaxf(s_[0][t_], s_[1][t_])); grow_ = grow_ || (mn_[t_] > mm[t_]); } \
        if (__any(grow_)) { _Pragma("unroll") for (int t_ = 0; t_ < 4; ++t_) { const float al_ = ex2(mm[t_] - mn_[t_]); const float alo_ = dppf<0x128>(al_); ll[t_] *= al_; mm[t_] = mn_[t_]; \
            _Pragma("unroll") for (int d_ = 0; d_ < 8; ++d_) { accA[t_][d_] *= al_; accB[t_][d_] *= alo_; } } } \
        _Pragma("unroll") for (int i_ = 0; i_ < 2; ++i_) _Pragma("unroll") for (int t_ = 0; t_ < 4; ++t_) { \
            const float p_ = ex2(s_[i_][t_] - mm[t_]); const float po_ = dppf<0x128>(p_); ll[t_] += p_; \
            accA[t_][0] += p_ * V_[i_][0].x; accA[t_][1] += p_ * V_[i_][0].y; accA[t_][2] += p_ * V_[i_][0].z; accA[t_][3] += p_ * V_[i_][0].w; \
            accA[t_][4] += p_ * V_[i_][1].x; accA[t_][5] += p_ * V_[i_][1].y; accA[t_][6] += p_ * V_[i_][1].z; accA[t_][7] += p_ * V_[i_][1].w; \
            accB[t_][0] += po_ * V_[i_][0].x; accB[t_][1] += po_ * V_[i_][0].y; accB[t_][2] += po_ * V_[i_][0].z; accB[t_][3] += po_ * V_[i_][0].w; \
            accB[t_][4] += po_ * V_[i_][1].x; accB[t_][5] += po_ * V_[i_][1].y; accB[t_][6] += po_ * V_[i_][1].z; accB[t_][7] += po_ * V_[i_][1].w; } } while (0)
        DEC_ISSUE(0, Ka, Va);
        for (int blk = 0; blk < 64; blk += 2) {
            DEC_ISSUE(blk + 1, Kb, Vb);
            DEC_COMPUTE(blk, Ka, Va);
            if (blk + 2 < 64) DEC_ISSUE(blk + 2, Ka, Va);
            DEC_COMPUTE(blk + 1, Kb, Vb);
        }
#undef DEC_ISSUE
#undef DEC_COMPUTE
        float Mx[4], fo[4];
#pragma unroll
        for (int t = 0; t < 4; ++t) { float M = fmaxf(mm[t], __shfl_xor(mm[t], 16)); M = fmaxf(M, __shfl_xor(M, 32)); const float f = ex2(mm[t] - M); Mx[t] = M;
            float l = ll[t] * f; l += __shfl_xor(l, 16); l += __shfl_xor(l, 32); ll[t] = l; fo[t] = dppf<0x128>(f);
#pragma unroll
            for (int d = 0; d < 8; ++d) { float a = accA[t][d] * f; a += __shfl_xor(a, 16); a += __shfl_xor(a, 32); accA[t][d] = a; float bq = accB[t][d] * fo[t]; bq += __shfl_xor(bq, 16); bq += __shfl_xor(bq, 32); accB[t][d] = bq; } }
        if (r == 0) {
            const int map = cl >> 3;
#pragma unroll
            for (int t = 0; t < 4; ++t) {
                float* pa = dpart + ((size_t)it * 8 + map * 4 + t) * DP_STRIDE; float* pb = dpart + ((size_t)it * 8 + (1 - map) * 4 + t) * DP_STRIDE;
                *(f32x4*)(pa + d0) = (f32x4){accA[t][0], accA[t][1], accA[t][2], accA[t][3]}; *(f32x4*)(pa + d0 + 4) = (f32x4){accA[t][4], accA[t][5], accA[t][6], accA[t][7]};
                *(f32x4*)(pb + d0) = (f32x4){accB[t][0], accB[t][1], accB[t][2], accB[t][3]}; *(f32x4*)(pb + d0 + 4) = (f32x4){accB[t][4], accB[t][5], accB[t][6], accB[t][7]};
                if ((cl & 7) == 0) { pa[128] = Mx[t]; pa[129] = ll[t]; }
            }
        }
    }
}
__device__ __forceinline__ void p_decode_combine(const Ptrs& P, int wave, int lane, int G) {
    const int gw = blockIdx.x * NWAVES + wave, NGW = G * NWAVES;
    const bf16* qb = WSP(const bf16, WS_QB); const float* bt = WSP(const float, WS_BIAS); const float* dpart = WSP(const float, WS_DPART); bf16* mix = WSP(bf16, WS_MIX);
    const float lam = *WSP(const float, WS_LAM);
    for (int it = gw; it < DB * NH * DS; it += NGW) {
        const int t = it & 3, bh = it >> 2, bs = bh >> 2, h = bh & 3; const int row = MP + bs * DS + t;
        float res[2][2];
#pragma unroll
        for (int map = 0; map < 2; ++map) {
            const float* pbase = dpart + ((size_t)bh * 16 * 8 + map * 4 + t) * DP_STRIDE;
            float mc = -1e30f, lc = 0.f;
            if (lane < 16) { mc = pbase[(size_t)lane * 8 * DP_STRIDE + 128]; lc = pbase[(size_t)lane * 8 * DP_STRIDE + 129]; }
            const float qd = __uint_as_float((unsigned)qb[(size_t)row * 512 + h * 128 + map * 64 + lane] << 16);
            float sn[4];
#pragma unroll
            for (int i = 0; i < 4; ++i) { const float kd = P.out[O_KS + (size_t)(bs * DS + i) * 512 + h * 128 + map * 64 + lane]; const float s = wave_sum(qd * kd);
                sn[i] = (i <= t) ? s + bt[h * DP_STRIDE + (t - i >= 0 ? t - i : 0)] : -1e30f; }
            float M = wave_max(mc); M = fmaxf(fmaxf(M, sn[0]), fmaxf(fmaxf(sn[1], sn[2]), sn[3]));
            const float wc = ex2(mc - M);
            float L = wave_sum(wc * lc); float pn[4];
#pragma unroll
            for (int i = 0; i < 4; ++i) { pn[i] = (i <= t) ? ex2(sn[i] - M) : 0.f; L += pn[i]; }
            float ox = 0.f, oy = 0.f;
            for (int c = 0; c < 16; ++c) { const float w = __shfl(wc, c); ox += w * pbase[(size_t)c * 8 * DP_STRIDE + lane]; oy += w * pbase[(size_t)c * 8 * DP_STRIDE + 64 + lane]; }
#pragma unroll
            for (int i = 0; i < 4; ++i) { const float* vr = P.out + O_VS + (size_t)(bs * DS + i) * 512 + h * 128; ox += pn[i] * vr[lane]; oy += pn[i] * vr[64 + lane]; }
            res[map][0] = ox / L; res[map][1] = oy / L;
        }
        const float ax = res[0][0] - lam * res[1][0], ay = res[0][1] - lam * res[1][1];
        const float ssq = wave_sum(ax * ax + ay * ay);
        const float rn = (1.0f - LAM_INIT) / sqrtf(ssq * (1.0f / 128.0f) + EPS);
        bf16* o = mix + (size_t)row * 1024 + 512 + h * 128;
        o[lane] = (bf16)f2bf(ax * rn * P.in[19][lane]); o[64 + lane] = (bf16)f2bf(ay * rn * P.in[19][64 + lane]);
    }
}


namespace fa {
typedef short bf16x8 __attribute__((ext_vector_type(8)));
typedef float f32x16 __attribute__((ext_vector_type(16)));
typedef short v4i16_t __attribute__((ext_vector_type(4)));
constexpr int KS = 272, VS = 320, KT_BYTES = 64 * KS, VT_BYTES = 64 * VS, STAGE = KT_BYTES + VT_BYTES;
constexpr int TBL_OFF = 2 * STAGE;
constexpr float THR = 8.0f;
static_assert(TBL_OFF + 132 * 4 <= RING_BYTES && 65536 <= TBL_OFF, "fa LDS map");
__device__ __forceinline__ float swap_max(float x) { auto rr = __builtin_amdgcn_permlane32_swap(__float_as_uint(x), __float_as_uint(x), false, false); return fmaxf(__uint_as_float(rr[0]), __uint_as_float(rr[1])); }
__device__ __forceinline__ float swap_sum(float x) { auto rr = __builtin_amdgcn_permlane32_swap(__float_as_uint(x), __float_as_uint(x), false, false); return __uint_as_float(rr[0]) + __uint_as_float(rr[1]); }
__device__ __forceinline__ unsigned cvtpk(float lo, float hi) { unsigned r; asm volatile("v_cvt_pk_bf16_f32 %0, %1, %2" : "=v"(r) : "v"(lo), "v"(hi)); return r; }
__device__ __forceinline__ bf16x8 pack_p(const f32x16& p, int base) { v4u w; w.x = cvtpk(p[base], p[base + 1]); w.y = cvtpk(p[base + 2], p[base + 3]); w.z = cvtpk(p[base + 4], p[base + 5]); w.w = cvtpk(p[base + 6], p[base + 7]); return __builtin_bit_cast(bf16x8, w); }
__device__ __forceinline__ bf16x8 vfrag(const LAS unsigned char* p) {
    const v4i16_t lo = __builtin_amdgcn_ds_read_tr16_b64_v4i16((LAS v4i16_t*)p), hi = __builtin_amdgcn_ds_read_tr16_b64_v4i16((LAS v4i16_t*)(p + 8 * VS));
    return (bf16x8){lo[0], lo[1], lo[2], lo[3], hi[0], hi[1], hi[2], hi[3]};
}

__device__ __forceinline__ void dattn_flash(const Ptrs& P, LAS unsigned char* lds, int wave, int lane, int G) {
    const int tid = threadIdx.x;
    const bf16* qb = WSP(const bf16, WS_QB); const bf16* kb = WSP(const bf16, WS_KB); const bf16* vb = WSP(const bf16, WS_VB); bf16* mix = WSP(bf16, WS_MIX);
    const float* bt = WSP(const float, WS_BIAS); const float lam = *WSP(const float, WS_LAM);
    const int r32 = lane & 31, hi = lane >> 5, c = wave & 1, rg = wave >> 1;
    const int bx = blockIdx.x; const int vcu = (G % 8 == 0) ? (bx % 8) * (G / 8) + bx / 8 : bx;
    LAS float* tbl = (LAS float*)(lds + TBL_OFF);
    LAS float* ex = (LAS float*)lds;
    const int srow = tid >> 4, sch = tid & 15;
    const unsigned kl = srow * KS + sch * 16, vl = KT_BYTES + srow * VS + sch * 16;
    const unsigned kfo = r32 * KS + (c * 64 + hi * 8) * 2;
    const unsigned vfo = KT_BYTES + (4 * hi + ((lane & 15) >> 2)) * VS + (16 * ((lane >> 4) & 1) + 4 * (lane & 3)) * 2;
    for (int item = vcu; item < 256; item += G) {
        const int bh = item >> 4, pi = item & 15, b = bh >> 2, h = bh & 3;
        const size_t rowbase = (size_t)b * SEQ;
        __syncthreads();
        if (tid < 132) tbl[tid] = bt[h * DP_STRIDE + tid];
        for (int half = 0; half < 2; ++half) {
            const int qblk = half == 0 ? pi : 31 - pi;
            const int q0 = qblk * 128, NT = (q0 + 128) >> 6, tnear = (q0 >> 6) - 2;
            const int qpos = q0 + 32 * rg + r32;
            bf16x8 qr[4];
            { const bf16* qp = qb + (rowbase + qpos) * 512 + h * 128 + c * 64 + hi * 8;
#pragma unroll
              for (int dc = 0; dc < 4; ++dc) qr[dc] = *(const GAS bf16x8*)(qp + dc * 16); }
            const bf16* kg = kb + (rowbase + srow) * 512 + h * 128 + sch * 8; const bf16* vg = vb + (rowbase + srow) * 512 + h * 128 + sch * 8;
            v4u kst[2], vst[2];
#define FA_LOADG(t_) do { _Pragma("unroll") for (int i_ = 0; i_ < 2; ++i_) { kst[i_] = *(const GAS v4u*)(kg + ((size_t)(t_) * 64 + 32 * i_) * 512); vst[i_] = *(const GAS v4u*)(vg + ((size_t)(t_) * 64 + 32 * i_) * 512); } } while (0)
#define FA_STORE(so_) do { _Pragma("unroll") for (int i_ = 0; i_ < 2; ++i_) { *(LAS v4u*)(lds + (so_) + kl + i_ * 32 * KS) = kst[i_]; *(LAS v4u*)(lds + (so_) + vl + i_ * 32 * VS) = vst[i_]; } } while (0)
            FA_LOADG(0); FA_STORE(0);
            __syncthreads();
            const float b31 = tbl[128];
            float m = -1e30f, l = 0.f;
            f32x16 o[4];
#pragma unroll
            for (int k = 0; k < 4; ++k)
#pragma unroll
                for (int r = 0; r < 16; ++r) o[k][r] = 0.f;
            for (int t = 0; t < NT; ++t) {
                const int st = (t & 1) * STAGE;
                if (t + 1 < NT) FA_LOADG(t + 1);
                f32x16 p0, p1;
#pragma unroll
                for (int r = 0; r < 16; ++r) { p0[r] = 0.f; p1[r] = 0.f; }
                const LAS unsigned char* kbp = lds + st + kfo;
#pragma unroll
                for (int dc = 0; dc < 4; ++dc) {
                    const bf16x8 a0 = *(const LAS bf16x8*)(kbp + dc * 32), a1 = *(const LAS bf16x8*)(kbp + 32 * KS + dc * 32);
                    p0 = __builtin_amdgcn_mfma_f32_32x32x16_bf16(a0, qr[dc], p0, 0, 0, 0);
                    p1 = __builtin_amdgcn_mfma_f32_32x32x16_bf16(a1, qr[dc], p1, 0, 0, 0);
                }
                if (t < tnear) {
#pragma unroll
                    for (int r = 0; r < 16; ++r) { p0[r] += b31; p1[r] += b31; }
                } else {
                    const int rb = qpos - t * 64 - 4 * hi;
#pragma unroll
                    for (int r = 0; r < 16; ++r) {
                        const int rel0 = rb - ((r & 3) + 8 * (r >> 2)), rel1 = rel0 - 32;
                        const float b0 = tbl[rel0 < 0 ? 0 : (rel0 < 128 ? rel0 : 128)], b1 = tbl[rel1 < 0 ? 0 : (rel1 < 128 ? rel1 : 128)];
                        p0[r] = rel0 < 0 ? -1e30f : p0[r] + b0; p1[r] = rel1 < 0 ? -1e30f : p1[r] + b1;
                    }
                }
                float mx = fmaxf(p0[0], p1[0]);
#pragma unroll
                for (int r = 1; r < 16; ++r) mx = fmaxf(mx, fmaxf(p0[r], p1[r]));
                mx = swap_max(mx);
                if (__any(mx > m + THR)) {
                    const float mn = fmaxf(m, mx); const float al = ex2(m - mn); l *= al; m = mn;
#pragma unroll
                    for (int k = 0; k < 4; ++k)
#pragma unroll
                        for (int r = 0; r < 16; ++r) o[k][r] *= al;
                }
                float ls = 0.f;
#pragma unroll
                for (int r = 0; r < 16; ++r) { p0[r] = ex2(p0[r] - m); p1[r] = ex2(p1[r] - m); ls += p0[r] + p1[r]; }
                l += ls;
                bf16x8 pa[4]; pa[0] = pack_p(p0, 0); pa[1] = pack_p(p0, 8); pa[2] = pack_p(p1, 0); pa[3] = pack_p(p1, 8);
                const LAS unsigned char* vbp = lds + st + vfo;
#pragma unroll
                for (int s = 0; s < 4; ++s)
#pragma unroll
                    for (int k = 0; k < 4; ++k) {
                        const bf16x8 vf = vfrag(vbp + (16 * s) * VS + k * 64);
                        o[k] = __builtin_amdgcn_mfma_f32_32x32x16_bf16(vf, pa[s], o[k], 0, 0, 0);
                    }
                if (t + 1 < NT) FA_STORE(((t + 1) & 1) * STAGE);
                __syncthreads();
            }
#undef FA_LOADG
#undef FA_STORE
            l = swap_sum(l);
            const float il = 1.0f / l;
            if (c == 1) {
#pragma unroll
                for (int k = 0; k < 4; ++k)
#pragma unroll
                    for (int r = 0; r < 16; ++r) ex[(rg * 64 + k * 16 + r) * 64 + lane] = o[k][r] * il;
            }
            __syncthreads();
            if (c == 0) {
                float ssq = 0.f;
#pragma unroll
                for (int k = 0; k < 4; ++k)
#pragma unroll
                    for (int r = 0; r < 16; ++r) { const float a = o[k][r] * il - lam * ex[(rg * 64 + k * 16 + r) * 64 + lane]; o[k][r] = a; ssq += a * a; }
                ssq = swap_sum(ssq);
                const float rn = (1.0f - LAM_INIT) / sqrtf(ssq * (1.0f / 128.0f) + EPS);
                bf16* orow = mix + (rowbase + qpos) * 1024 + 512 + h * 128;
#pragma unroll
                for (int k = 0; k < 4; ++k)
#pragma unroll
                    for (int g = 0; g < 4; ++g) {
                        const int dv0 = 32 * k + 8 * g + 4 * hi;
                        const f32x4 w = *(const GAS f32x4*)(P.in[19] + dv0);
                        const unsigned long long pk = (unsigned long long)pk2(o[k][4 * g] * rn * w.x, o[k][4 * g + 1] * rn * w.y) | ((unsigned long long)pk2(o[k][4 * g + 2] * rn * w.z, o[k][4 * g + 3] * rn * w.w) << 32);
                        *(GAS unsigned long long*)(orow + dv0) = pk;
                    }
            }
            __syncthreads();
        }
    }
}
}


namespace fx {
using fa::bf16x8; using fa::f32x16; using fa::v4i16_t;
constexpr int KS = 528, VS = 576, TK = 32, KT_BYTES = TK * KS, VT_BYTES = TK * VS, STAGE = KT_BYTES + VT_BYTES;
static_assert(2 * STAGE <= RING_BYTES, "fx LDS map");
__device__ __forceinline__ bf16x8 vfrag(const LAS unsigned char* p) {
    const v4i16_t lo = __builtin_amdgcn_ds_read_tr16_b64_v4i16((LAS v4i16_t*)p), hi = __builtin_amdgcn_ds_read_tr16_b64_v4i16((LAS v4i16_t*)(p + 8 * VS));
    return (bf16x8){lo[0], lo[1], lo[2], lo[3], hi[0], hi[1], hi[2], hi[3]};
}
__device__ __forceinline__ void xattn_flash(const Ptrs& P, LAS unsigned char* lds, int wave, int lane, int G) {
    const int tid = threadIdx.x;
    const bf16* qc = WSP(const bf16, WS_QC); const bf16* mkb = WSP(const bf16, WS_MKB); const bf16* mvb = WSP(const bf16, WS_MVB); bf16* oc = WSP(bf16, WS_OC);
    const int r32 = lane & 31, hi = lane >> 5, dvh = wave & 1, rg = wave >> 1;
    const int bx = blockIdx.x; const int vcu = (G % 8 == 0) ? (bx % 8) * (G / 8) + bx / 8 : bx;
    const int srow = tid >> 5, sch = tid & 31;
    const unsigned kl = srow * KS + sch * 16, vl = KT_BYTES + srow * VS + sch * 16;
    const unsigned kfo = r32 * KS + (hi * 8) * 2;
    const unsigned vfo = KT_BYTES + (4 * hi + ((lane & 15) >> 2)) * VS + (128 * dvh + 16 * ((lane >> 4) & 1) + 4 * (lane & 3)) * 2;
    for (int unit = vcu; unit < 512; unit += G) {
        const int bh = unit >> 5, qblk = unit & 31, b = bh >> 2, h = bh & 3;
        const size_t row = (size_t)b * SEQ + qblk * 128 + 32 * rg + r32;
        bf16x8 qr[16];
        { const bf16* qp = qc + row * 1024 + h * 256 + hi * 8;
#pragma unroll
          for (int dc = 0; dc < 16; ++dc) qr[dc] = *(const GAS bf16x8*)(qp + dc * 16); }
        const bf16* kg = mkb + ((size_t)b * NMEM + srow) * 1024 + h * 256 + sch * 8; const bf16* vg = mvb + ((size_t)b * NMEM + srow) * 1024 + h * 256 + sch * 8;
        v4u kst[2], vst[2];
#define FX_LOADG(t_) do { _Pragma("unroll") for (int i_ = 0; i_ < 2; ++i_) { kst[i_] = *(const GAS v4u*)(kg + ((size_t)(t_) * TK + 16 * i_) * 1024); vst[i_] = *(const GAS v4u*)(vg + ((size_t)(t_) * TK + 16 * i_) * 1024); } } while (0)
#define FX_STORE(so_) do { _Pragma("unroll") for (int i_ = 0; i_ < 2; ++i_) { *(LAS v4u*)(lds + (so_) + kl + i_ * 16 * KS) = kst[i_]; *(LAS v4u*)(lds + (so_) + vl + i_ * 16 * VS) = vst[i_]; } } while (0)
        __syncthreads();
        FX_LOADG(0); FX_STORE(0);
        __syncthreads();
        float m = -1e30f, l = 0.f;
        f32x16 o[4];
#pragma unroll
        for (int k = 0; k < 4; ++k)
#pragma unroll
            for (int r = 0; r < 16; ++r) o[k][r] = 0.f;
        constexpr int NT = NMEM / TK;
        for (int t = 0; t < NT; ++t) {
            const int st = (t & 1) * STAGE;
            if (t + 1 < NT) FX_LOADG(t + 1);
            f32x16 p0;
#pragma unroll
            for (int r = 0; r < 16; ++r) p0[r] = 0.f;
            const LAS unsigned char* kbp = lds + st + kfo;
#pragma unroll
            for (int dc = 0; dc < 16; ++dc) {
                const bf16x8 a0 = *(const LAS bf16x8*)(kbp + dc * 32);
                p0 = __builtin_amdgcn_mfma_f32_32x32x16_bf16(a0, qr[dc], p0, 0, 0, 0);
            }
            float mx = p0[0];
#pragma unroll
            for (int r = 1; r < 16; ++r) mx = fmaxf(mx, p0[r]);
            mx = fa::swap_max(mx);
            if (__any(mx > m + fa::THR)) {
                const float mn = fmaxf(m, mx); const float al = ex2(m - mn); l *= al; m = mn;
#pragma unroll
                for (int k = 0; k < 4; ++k)
#pragma unroll
                    for (int r = 0; r < 16; ++r) o[k][r] *= al;
            }
            float ls = 0.f;
#pragma unroll
            for (int r = 0; r < 16; ++r) { p0[r] = ex2(p0[r] - m); ls += p0[r]; }
            l += ls;
            bf16x8 pa[2]; pa[0] = fa::pack_p(p0, 0); pa[1] = fa::pack_p(p0, 8);
            const LAS unsigned char* vbp = lds + st + vfo;
#pragma unroll
            for (int s = 0; s < 2; ++s)
#pragma unroll
                for (int k = 0; k < 4; ++k) {
                    const bf16x8 vf = vfrag(vbp + (16 * s) * VS + k * 64);
                    o[k] = __builtin_amdgcn_mfma_f32_32x32x16_bf16(vf, pa[s], o[k], 0, 0, 0);
                }
            if (t + 1 < NT) FX_STORE(((t + 1) & 1) * STAGE);
            __syncthreads();
        }
#undef FX_LOADG
#undef FX_STORE
        l = fa::swap_sum(l);
        const float il = 1.0f / l;
        bf16* orow = oc + row * 1024 + h * 256 + 128 * dvh;
#pragma unroll
        for (int k = 0; k < 4; ++k)
#pragma unroll
            for (int g = 0; g < 4; ++g) {
                const int dv0 = 32 * k + 8 * g + 4 * hi;
                const unsigned long long pk = (unsigned long long)pk2(o[k][4 * g] * il, o[k][4 * g + 1] * il) | ((unsigned long long)pk2(o[k][4 * g + 2] * il, o[k][4 * g + 3] * il) << 32);
                *(GAS unsigned long long*)(orow + dv0) = pk;
            }
    }
}
}

constexpr int N_PHASES = 12;
struct Args { const float* in[32]; float* out; unsigned char* ws; int ph_lo, ph_hi; };
__global__ void __launch_bounds__(NWAVES * 64, 2) mega_fwd(Args args) {
    extern __shared__ __attribute__((aligned(16))) unsigned char lds[];
    LAS unsigned char* L = (LAS unsigned char*)lds;
    volatile LAS unsigned* MISC = (volatile LAS unsigned*)(L + MISC_OFF);
    const int tid = threadIdx.x, lane = tid & 63, wave = __builtin_amdgcn_readfirstlane(tid >> 6);
    const int G = gridDim.x;
    Ptrs P;
#pragma unroll
    for (int i = 0; i < 32; ++i) P.in[i] = args.in[i];
    P.out = args.out; P.ws = args.ws;
    for (int u = tid; u < (LDS_BYTES - LDSCTL_OFF) / 4; u += NWAVES * 64) ((LAS unsigned*)(L + LDSCTL_OFF))[u] = 0u;
    __syncthreads();
    gu32* ctl = (gu32*)(P.ws + WS_CTL);
    XcdBarrier bar; bar.bar = (unsigned*)(ctl + CW_BAR); bar.x = 0; bar.st = nullptr;
#if !MK_PER_PHASE
    bar = xcd_barrier_post((unsigned*)(ctl + CW_BAR), MISC + 8);
#endif
    const int lo = args.ph_lo, hi = args.ph_hi;
#define IN(k) (lo <= (k) && (k) < hi)
#define SEAM(k) do { if (IN(k) && IN((k) + 1)) xcd_barrier(bar); } while (0)

    if (IN(0)) { p0_prologue(P, L, wave, lane, G); }
    SEAM(0);
    if (IN(1)) {
        { pg8::Gemm g{WSP(const bf16, WS_XB), WSP(const bf16, WS_WIN), MT, DIN, DM}; pg8::StaticOrder S; S.init(MT, DIN, G, (int)blockIdx.x);
          pg8::EpiIn E{WSP(const float, WS_R0), WSP(bf16, WS_ZCONV), WSP(bf16, WS_QB), WSP(bf16, WS_KB), WSP(bf16, WS_VB), P.out};
          pg8::gemm_phase<pg8::EpiIn, pg8::StaticOrder, true, true>(L + RING_OFF, g, S, E); }
        { pg8::Gemm g{WSP(const bf16, WS_MEMB), WSP(const bf16, WS_WCKV), NB * NMEM, 2 * DM, DM}; pg8::StaticOrder S; S.init(NB * NMEM, 2 * DM, G, (int)blockIdx.x);
          pg8::EpiMem E{WSP(const float, WS_RMEM), WSP(bf16, WS_MKB), WSP(bf16, WS_MVB), P.out};
          pg8::gemm_phase<pg8::EpiMem, pg8::StaticOrder, true, true>(L + RING_OFF, g, S, E); }
    }
    SEAM(1);
    if (IN(2)) { p_convmix(P, wave, lane, G); fa::dattn_flash(P, L, wave, lane, G); p_decode_split(P, wave, lane, G); }
    SEAM(2);
    if (IN(3)) { p_decode_combine(P, wave, lane, G); }
    SEAM(3);
    if (IN(4)) { pg8::Gemm g{WSP(const bf16, WS_MIX), WSP(const bf16, WS_WOUT), MT, DM, DM}; pg8::StaticOrder S; S.init(MT, DM, G, (int)blockIdx.x);
        pg8::EpiRes E{P.in[0], P.in[1], WSP(float, WS_X1), WSP(bf16, WS_X1B), WSP(float, WS_SS1)};
        pg8::gemm_phase<pg8::EpiRes, pg8::StaticOrder, true, true>(L + RING_OFF, g, S, E); }
    SEAM(4);
    if (IN(5)) { pg8::Gemm g{WSP(const bf16, WS_X1B), WSP(const bf16, WS_WCQ), MT, DM, DM}; pg8::StaticOrder S; S.init(MT, DM, G, (int)blockIdx.x);
        pg8::EpiScale E{WSP(const float, WS_SS1), WSP(bf16, WS_QC), DM, CQSC};
        pg8::gemm_phase<pg8::EpiScale, pg8::StaticOrder, true, true>(L + RING_OFF, g, S, E); }
    SEAM(5);
    if (IN(6)) { fx::xattn_flash(P, L, wave, lane, G); p_xattn_naive<true>(P, L, wave, lane, G); }
    SEAM(6);
    if (IN(7)) { pg8::Gemm g{WSP(const bf16, WS_OC), WSP(const bf16, WS_WCO), MT, DM, DM}; pg8::StaticOrder S; S.init(MT, DM, G, (int)blockIdx.x);
        pg8::EpiRes E{WSP(const float, WS_X1), WSP(const float, WS_X1) + (size_t)MP * DM, WSP(float, WS_X2), WSP(bf16, WS_X2B), WSP(float, WS_SS2)};
        pg8::gemm_phase<pg8::EpiRes, pg8::StaticOrder, true, true>(L + RING_OFF, g, S, E); }
    SEAM(7);
    if (IN(8)) { pg8::Gemm g{WSP(const bf16, WS_X2B), WSP(const bf16, WS_WUP), MT, DUP, DM}; pg8::StaticOrder S; S.init(MT, DUP, G, (int)blockIdx.x);
        pg8::EpiScale E{WSP(const float, WS_SS2), WSP(bf16, WS_UPB), DUP, 1.0f};
        pg8::gemm_phase<pg8::EpiScale, pg8::StaticOrder, true, true>(L + RING_OFF, g, S, E); }
    SEAM(8);
    if (IN(9)) { p_convffn(P, wave, lane, G); }
    SEAM(9);
    if (IN(10)) { pg8::Gemm g{WSP(const bf16, WS_ACT), WSP(const bf16, WS_WDOWN), MT, DM, DFF}; pg8::StaticOrder S; S.init(MT, DM, G, (int)blockIdx.x);
        pg8::EpiRes E{WSP(const float, WS_X2), WSP(const float, WS_X2) + (size_t)MP * DM, WSP(float, WS_X3), nullptr, WSP(float, WS_SS3)};
        pg8::gemm_phase<pg8::EpiRes, pg8::StaticOrder, true, true>(L + RING_OFF, g, S, E); }
    SEAM(10);
    if (IN(11)) { p_final(P, wave, lane, G); }
#undef IN
#undef SEAM
}

extern "C" void kernel_launch(void* const* d_in, const int* in_sizes, int n_in, void* d_out, int out_size, void* d_ws, size_t ws_size, hipStream_t stream) {
    static int grid = 0;
    if (grid == 0) {
        if (n_in != 32 || out_size != (int)O_END || ws_size < WS_END) { fprintf(stderr, "kernel_launch: unexpected shapes: n_in %d out %d ws %zu\n", n_in, out_size, ws_size); grid = -1; return; }
        int dev = 0, cus = 0, per_cu = 0;
        if (hipGetDevice(&dev) != hipSuccess || hipDeviceGetAttribute(&cus, hipDeviceAttributeMultiprocessorCount, dev) != hipSuccess) { grid = -1; return; }
        if (hipFuncSetAttribute((const void*)mega_fwd, hipFuncAttributeMaxDynamicSharedMemorySize, LDS_BYTES) != hipSuccess) { fprintf(stderr, "kernel_launch: hipFuncSetAttribute failed\n"); grid = -1; return; }
        if (hipOccupancyMaxActiveBlocksPerMultiprocessor(&per_cu, (const void*)mega_fwd, NWAVES * 64, LDS_BYTES) != hipSuccess || per_cu < 1) fprintf(stderr, "kernel_launch: occupancy query reports %d\n", per_cu);
        (void)hipGetLastError();
        grid = cus;
    }
    if (grid < 0) return;
    if (hipMemsetAsync((char*)d_ws + WS_CTL, 0, CTL_ZERO_BYTES, stream) != hipSuccess) return;
    Args a{};
    for (int i = 0; i < 32; ++i) a.in[i] = (const float*)d_in[i];
    a.out = (float*)d_out; a.ws = (unsigned char*)d_ws;
#if MK_PER_PHASE
    for (int p = 0; p < N_PHASES; ++p) { a.ph_lo = p; a.ph_hi = p + 1; hipLaunchKernelGGL(mega_fwd, dim3(grid), dim3(NWAVES * 64), LDS_BYTES, stream, a); }
#else
    a.ph_lo = 0; a.ph_hi = N_PHASES; hipLaunchKernelGGL(mega_fwd, dim3(grid), dim3(NWAVES * 64), LDS_BYTES, stream, a);
#endif
}
```

```cpp
#include <hip/hip_runtime.h>
#include <cstdio>
#include <cstdint>

#ifndef MK_PER_PHASE
#define MK_PER_PHASE 0
#endif

constexpr int DM = 1024, NB = 4, SEQ = 4096, MP = NB * SEQ;
constexpr int DB = 32, DS = 4, MS = DB * DS;
constexpr int MREAL = MP + MS, MT = 16640;
constexpr int PAST = 8192, PAGE = 128, NPAGES = PAST / PAGE;
constexpr int DCONV = 512, NH = 4, HDK = 64, HDV = 128, DATT = 512, DIN = 3072;
constexpr int NMEM = 256, MHEADS = 4, MDH = 256, DFF = 2816, DUP = 2 * DFF;
constexpr float EPS = 1e-6f, LOG2E = 1.4426950408889634f;
constexpr float QSC = 0.125f * LOG2E;
constexpr float CQSC = 0.0625f * LOG2E;
constexpr float LAM_INIT = 0.2f;
constexpr size_t O_Y = 0, O_YS = 16777216, O_KP = 16908288, O_VP = 25296896, O_KS = 33685504, O_VS = 33751040,
                 O_CMP = 33816576, O_CMS = 33820672, O_CFP = 33853440, O_CFS = 33898496, O_MK = 34258944, O_MV = 35307520, O_END = 36356096;
namespace pg8 {
#define PG8_LAS __attribute__((address_space(3)))
typedef unsigned short bf16_t;
typedef short bf16x8 __attribute__((ext_vector_type(8)));
typedef float f32x4 __attribute__((ext_vector_type(4)));
typedef unsigned u32x4 __attribute__((ext_vector_type(4)));
constexpr int BM = 256, BK = 64, HALF = 128, HTB = HALF * BK * 2  , STAGE_BYTES = 8 * HTB, NXCD = 8, WGM = 8;

__host__ __device__ __forceinline__ int lds_byte(int r, int c) { const int st = (r >> 4) * 2 + (c >> 5), rr = r & 15, cc = c & 31, ob = rr * 64 + cc * 2; return st * 1024 + (ob ^ (((ob >> 9) & 1) << 5)); }
__host__ __device__ __forceinline__ void stage_rc(int b, int& R, int& C) { const int st = b / 1024, sb = b % 1024, swz = sb ^ (((sb >> 9) & 1) << 5); R = (st >> 1) * 16 + swz / 64; C = (st & 1) * 32 + (swz % 64) / 2; }
__host__ __device__ __forceinline__ int perm32(int rho) { const int n = rho >> 4, i = rho & 15; return 8 * (i >> 2) + 4 * n + (i & 3); }

struct Unit { int pm, pn; };
struct Gemm { const bf16_t* A; const bf16_t* Bt; int M, N, K; };

struct StaticOrder {
    int nM, nN, nwg, G, c;
    __host__ __device__ void init(int M, int N, int G_, int c_) { nM = M / BM; nN = N / BM; nwg = nM * nN; G = G_; c = c_; }
    __host__ __device__ bool next(int i, Unit& u) const {
        const long L = (long)i * G + c; if (L >= nwg) return false;
        int wgid = (int)L; { const int q = nwg / NXCD, r = nwg % NXCD, xcd = wgid % NXCD, off = wgid / NXCD; wgid = (xcd < r ? xcd * (q + 1) : r * (q + 1) + (xcd - r) * q) + off; }
        const int nig = WGM * nN, gid = wgid / nig, fm = gid * WGM, gsz = (nM - fm) < WGM ? (nM - fm) : WGM;
        u.pm = fm + ((wgid % nig) % gsz); u.pn = (wgid % nig) / gsz; return true;
    }
    __device__ __forceinline__ void a_ready(const Unit&) const {}
    __device__ __forceinline__ void done(const Unit&) const {}
};

__device__ __forceinline__ unsigned cvt_pk_bf16(float lo, float hi) { unsigned r; asm volatile("v_cvt_pk_bf16_f32 %0, %1, %2" : "=v"(r) : "v"(lo), "v"(hi)); return r; }
__device__ __forceinline__ u32x4 pack8(const f32x4 a, const f32x4 b) { u32x4 w; w.x = cvt_pk_bf16(a[0], a[1]); w.y = cvt_pk_bf16(a[2], a[3]); w.z = cvt_pk_bf16(b[0], b[1]); w.w = cvt_pk_bf16(b[2], b[3]); return w; }
__device__ __forceinline__ float dot4(const f32x4 a) { return (a[0] * a[0] + a[1] * a[1]) + (a[2] * a[2] + a[3] * a[3]); }

struct EpiIn {
    static constexpr bool PERM = true, AFTER_DRAIN = false;
    const float* r0; bf16_t* zconv; bf16_t* qb; bf16_t* kb; bf16_t* vb; float* out;
    __device__ __forceinline__ void operator()(const f32x4 (&acc)[2][2][4][2], const Unit& u, int wr, int wc, int fr, int fq) const {
        const int pn = u.pn;
#pragma unroll
        for (int ai = 0; ai < 2; ++ai)
#pragma unroll
            for (int m = 0; m < 4; ++m) {
                const int row = u.pm * BM + ai * HALF + wr * 64 + m * 16 + fr;
                {
                    const float rs = r0[row];
#pragma unroll
                    for (int bj = 0; bj < 2; ++bj) {
                        const int col = pn * BM + bj * HALF + wc * 32 + 8 * fq;
                        const f32x4 v0 = acc[ai][bj][m][0] * rs, v1 = acc[ai][bj][m][1] * rs;
                        if (pn < 6) { *(u32x4*)(zconv + (size_t)row * 1536 + col) = pack8(v0, v1); }
                        else if (pn < 8) { *(u32x4*)(qb + (size_t)row * 512 + (col - 1536)) = pack8(v0 * QSC, v1 * QSC); }
                        else { const bool isk = pn < 10; const int c = col - (isk ? 2048 : 2560);
                            *(u32x4*)((isk ? kb : vb) + (size_t)row * 512 + c) = pack8(v0, v1);
                            float* o = out + (isk ? O_KP : O_VP) + (size_t)row * 512 + c;
                            *(f32x4*)o = v0; *(f32x4*)(o + 4) = v1; }
                    }
                }
            }
    }
};
struct EpiMem {
    static constexpr bool PERM = true, AFTER_DRAIN = false;
    const float* rmem; bf16_t* mkb; bf16_t* mvb; float* out;
    __device__ __forceinline__ void operator()(const f32x4 (&acc)[2][2][4][2], const Unit& u, int wr, int wc, int fr, int fq) const {
        const int pn = u.pn; const bool isk = pn < 4;
#pragma unroll
        for (int ai = 0; ai < 2; ++ai)
#pragma unroll
            for (int m = 0; m < 4; ++m) {
                const int row = u.pm * BM + ai * HALF + wr * 64 + m * 16 + fr;
                const float rs = rmem[row];
#pragma unroll
                for (int bj = 0; bj < 2; ++bj) {
                    const int col = (pn & 3) * BM + bj * HALF + wc * 32 + 8 * fq;
                    const f32x4 v0 = acc[ai][bj][m][0] * rs, v1 = acc[ai][bj][m][1] * rs;
                    *(u32x4*)((isk ? mkb : mvb) + (size_t)row * 1024 + col) = pack8(v0, v1);
                    float* o = out + (isk ? O_MK : O_MV) + (size_t)row * 1024 + col;
                    *(f32x4*)o = v0; *(f32x4*)(o + 4) = v1;
                }
            }
    }
};
template <bool RESBF> struct EpiRes {
    static constexpr bool PERM = true, AFTER_DRAIN = false;
    const void* res; float* xo; bf16_t* xob; float* ss;
    __device__ __forceinline__ void operator()(const f32x4 (&acc)[2][2][4][2], const Unit& u, int wr, int wc, int fr, int fq) const {
        const int pn = u.pn;
#pragma unroll
        for (int ai = 0; ai < 2; ++ai)
#pragma unroll
            for (int m = 0; m < 4; ++m) {
                const int row = u.pm * BM + ai * HALF + wr * 64 + m * 16 + fr;
                float sq = 0.f;
#pragma unroll
                for (int bj = 0; bj < 2; ++bj) {
                    const int col = pn * BM + bj * HALF + wc * 32 + 8 * fq;
                    f32x4 a, b;
                    if (RESBF) { const u32x4 w = *(const u32x4*)((const bf16_t*)res + (size_t)row * 1024 + col);
                        a = (f32x4){__uint_as_float(w.x << 16), __uint_as_float(w.x & 0xffff0000u), __uint_as_float(w.y << 16), __uint_as_float(w.y & 0xffff0000u)};
                        b = (f32x4){__uint_as_float(w.z << 16), __uint_as_float(w.z & 0xffff0000u), __uint_as_float(w.w << 16), __uint_as_float(w.w & 0xffff0000u)}; }
                    else { const float* rp = (const float*)res + (size_t)row * 1024 + col; a = *(const f32x4*)rp; b = *(const f32x4*)(rp + 4); }
                    const f32x4 o0 = a + acc[ai][bj][m][0], o1 = b + acc[ai][bj][m][1];
                    if (xo) { float* xp = xo + (size_t)row * 1024 + col; *(f32x4*)xp = o0; *(f32x4*)(xp + 4) = o1; }
                    if (xob) *(u32x4*)(xob + (size_t)row * 1024 + col) = pack8(o0, o1);
                    sq += dot4(o0) + dot4(o1);
                }
                sq += __shfl_xor(sq, 16); sq += __shfl_xor(sq, 32);
                if (fq == 0) ss[(size_t)row * 16 + pn * 4 + wc] = sq;
            }
    }
};
struct EpiScale {
    static constexpr bool PERM = true, AFTER_DRAIN = false;
    const float* ss; bf16_t* O; int ldc; float cs;
    __device__ __forceinline__ void operator()(const f32x4 (&acc)[2][2][4][2], const Unit& u, int wr, int wc, int fr, int fq) const {
        const int pn = u.pn;
#pragma unroll
        for (int ai = 0; ai < 2; ++ai)
#pragma unroll
            for (int m = 0; m < 4; ++m) {
                const int row = u.pm * BM + ai * HALF + wr * 64 + m * 16 + fr;
                const f32x4* sp = (const f32x4*)(ss + (size_t)row * 16);
                const f32x4 s0 = sp[0], s1 = sp[1], s2 = sp[2], s3 = sp[3];
                const float tot = ((s0[0] + s0[1]) + (s0[2] + s0[3])) + ((s1[0] + s1[1]) + (s1[2] + s1[3])) + ((s2[0] + s2[1]) + (s2[2] + s2[3])) + ((s3[0] + s3[1]) + (s3[2] + s3[3]));
                const float rs = cs / sqrtf(fmaxf(tot, 0.f) * (1.0f / 1024.0f) + EPS);
#pragma unroll
                for (int bj = 0; bj < 2; ++bj) {
                    const int col = pn * BM + bj * HALF + wc * 32 + 8 * fq;
                    *(u32x4*)(O + (size_t)row * ldc + col) = pack8(acc[ai][bj][m][0] * rs, acc[ai][bj][m][1] * rs);
                }
            }
    }
};
template <class Epi, class Sched, bool ALIGN_EPI = false, bool SP2 = false>
__device__ __forceinline__ void gemm_phase(PG8_LAS unsigned char* lds, const Gemm g, const Sched& S, const Epi& E) {
    const int tid = threadIdx.x, wid = __builtin_amdgcn_readfirstlane(tid >> 6), lane = tid & 63, wr = wid >> 2, wc = wid & 3, fr = lane & 15, fq = lane >> 4;
    const int K = g.K, nt = K / BK;
    unsigned voffA[2], voffB[2];
#pragma unroll
    for (int i = 0; i < 2; ++i) { int R, C; stage_rc(tid * 16 + i * 8192, R, C); const int Rb = Epi::PERM ? ((R & ~31) + perm32(R & 31)) : R;
        voffA[i] = (unsigned)(R * K + C) * 2u; voffB[i] = (unsigned)(Rb * K + C) * 2u; }
    const size_t kstep = (size_t)(BK * 2);
    const size_t hstep = (size_t)HALF * K * 2;
    const size_t tstep = 2 * hstep;
    const unsigned ldsw = (unsigned)wid * 1024u;
    const int aoff = lds_byte(wr * 64 + fr, fq * 8), boff = lds_byte(wc * 32 + fr, fq * 8);
#define PG8_SA(b, h) (((b) * 2 + (h)) * HTB)
#define PG8_SB(b, h) ((4 + (b) * 2 + (h)) * HTB)
#define PG8_STAGE(bufoff, gbase, voff) do { _Pragma("unroll") for (int _i = 0; _i < 2; ++_i) \
        __builtin_amdgcn_global_load_lds((const unsigned*)((const char*)(gbase) + (voff)[_i]), (PG8_LAS unsigned*)(lds + (bufoff) + ldsw + _i * 8192), 16, 0, 0); } while (0)
#define PG8_LDA(dst, b, h) do { _Pragma("unroll") for (int m = 0; m < 4; ++m) _Pragma("unroll") for (int k = 0; k < 2; ++k) dst[m][k] = *(const PG8_LAS bf16x8*)(lds + PG8_SA(b, h) + aoff + m * 2048 + k * 1024); } while (0)
#define PG8_LDB(dst, b, h) do { _Pragma("unroll") for (int n = 0; n < 2; ++n) _Pragma("unroll") for (int k = 0; k < 2; ++k) dst[n][k] = *(const PG8_LAS bf16x8*)(lds + PG8_SB(b, h) + boff + n * 2048 + k * 1024); } while (0)
#define PG8_MMA(ai, bj, At, Bt) do { __builtin_amdgcn_s_setprio(1); _Pragma("unroll") for (int m = 0; m < 4; ++m) _Pragma("unroll") for (int n = 0; n < 2; ++n) _Pragma("unroll") for (int k = 0; k < 2; ++k) \
        acc[ai][bj][m][n] = __builtin_amdgcn_mfma_f32_16x16x32_bf16(Bt[n][k], At[m][k], acc[ai][bj][m][n], 0, 0, 0); __builtin_amdgcn_s_setprio(0); } while (0)
#define PG8_WAIT_V(n) asm volatile("s_waitcnt vmcnt(" #n ")" ::: "memory")
#define PG8_WAIT_L(n) asm volatile("s_waitcnt lgkmcnt(" #n ")" ::: "memory")
#define PG8_BAR __builtin_amdgcn_s_barrier()
#define PG8_SCHED __builtin_amdgcn_sched_barrier(0)
    Unit cur, nxt; int ui = 0;
    if (!S.next(0, cur)) return;
    f32x4 acc[2][2][4][2];
#pragma unroll
    for (int a = 0; a < 2; ++a)
#pragma unroll
        for (int b = 0; b < 2; ++b)
#pragma unroll
            for (int m = 0; m < 4; ++m)
#pragma unroll
                for (int n = 0; n < 2; ++n) acc[a][b][m][n] = (f32x4){0.f, 0.f, 0.f, 0.f};
    bf16x8 At[4][2], B0[2][2], B1[2][2];
    const char* cA = (const char*)g.A + (size_t)cur.pm * tstep; const char* cB = (const char*)g.Bt + (size_t)cur.pn * tstep;
    S.a_ready(cur);
    if constexpr (SP2) {
        PG8_STAGE(PG8_SB(0, 0), cB, voffB); PG8_STAGE(PG8_SB(0, 1), cB + hstep, voffB); PG8_STAGE(PG8_SA(0, 0), cA, voffA); PG8_STAGE(PG8_SA(0, 1), cA + hstep, voffA);
        if (wr == 1) PG8_BAR;
        PG8_WAIT_V(2); PG8_BAR;
        PG8_STAGE(PG8_SB(1, 0), cB + kstep, voffB); PG8_STAGE(PG8_SA(1, 0), cA + kstep, voffA); PG8_STAGE(PG8_SB(1, 1), cB + hstep + kstep, voffB);
        PG8_WAIT_V(6); PG8_BAR;
    } else {
        PG8_STAGE(PG8_SB(0, 0), cB, voffB); PG8_STAGE(PG8_SA(0, 0), cA, voffA); PG8_STAGE(PG8_SB(0, 1), cB + hstep, voffB); PG8_STAGE(PG8_SA(0, 1), cA + hstep, voffA);
        if (wr == 1) PG8_BAR;
        PG8_WAIT_V(4); PG8_BAR;
        PG8_STAGE(PG8_SB(1, 0), cB + kstep, voffB); PG8_STAGE(PG8_SA(1, 0), cA + kstep, voffA); PG8_STAGE(PG8_SB(1, 1), cB + hstep + kstep, voffB);
        PG8_WAIT_V(6); PG8_BAR;
    }
    for (;;) {
        const bool has_next = S.next(ui + 1, nxt);
        const char* nA = has_next ? (const char*)g.A + (size_t)nxt.pm * tstep : cA; const char* nB = has_next ? (const char*)g.Bt + (size_t)nxt.pn * tstep : cB;
        for (int t = 0; t < nt; t += 2) {
            const bool last = (t == nt - 2);
            const char* a1 = cA + (size_t)(t + 1) * kstep;
            const char* a2 = last ? nA : cA + (size_t)(t + 2) * kstep; const char* b2 = last ? nB : cB + (size_t)(t + 2) * kstep;
            const char* a3 = a2 + kstep; const char* b3 = b2 + kstep;
            if (last && has_next) S.a_ready(nxt);
            if constexpr (SP2) {
            PG8_LDB(B0, 0, 0); PG8_LDB(B1, 0, 1); PG8_SCHED; PG8_LDA(At, 0, 0); PG8_STAGE(PG8_SA(1, 1), a1 + hstep, voffA);
            PG8_WAIT_V(8); PG8_WAIT_L(0); PG8_BAR; PG8_MMA(0, 0, At, B0); PG8_MMA(0, 1, At, B1); PG8_BAR; PG8_SCHED;
            PG8_LDA(At, 0, 1); PG8_STAGE(PG8_SB(0, 0), b2, voffB); PG8_STAGE(PG8_SB(0, 1), b2 + hstep, voffB); PG8_STAGE(PG8_SA(0, 0), a2, voffA);
            PG8_WAIT_V(8); PG8_WAIT_L(0); PG8_BAR; PG8_MMA(1, 0, At, B0); PG8_MMA(1, 1, At, B1); PG8_BAR; PG8_SCHED;
            PG8_LDB(B0, 1, 0); PG8_LDB(B1, 1, 1); PG8_SCHED; PG8_LDA(At, 1, 0); PG8_STAGE(PG8_SA(0, 1), a2 + hstep, voffA);
            PG8_WAIT_V(8); PG8_WAIT_L(0); PG8_BAR; PG8_MMA(0, 0, At, B0); PG8_MMA(0, 1, At, B1); PG8_BAR; PG8_SCHED;
            PG8_LDA(At, 1, 1); PG8_STAGE(PG8_SB(1, 0), b3, voffB); PG8_STAGE(PG8_SB(1, 1), b3 + hstep, voffB); PG8_STAGE(PG8_SA(1, 0), a3, voffA);
            PG8_WAIT_V(8); PG8_WAIT_L(0); PG8_BAR; PG8_MMA(1, 0, At, B0); PG8_MMA(1, 1, At, B1); PG8_BAR; PG8_SCHED;
            } else {
            PG8_LDB(B0, 0, 0); PG8_SCHED; PG8_LDA(At, 0, 0); PG8_STAGE(PG8_SA(1, 1), a1 + hstep, voffA);
            PG8_WAIT_L(8); PG8_BAR; PG8_WAIT_L(0); PG8_MMA(0, 0, At, B0); PG8_BAR; PG8_SCHED;
            PG8_LDB(B1, 0, 1); PG8_STAGE(PG8_SB(0, 0), b2, voffB);
            PG8_BAR; PG8_WAIT_L(0); PG8_MMA(0, 1, At, B1); PG8_BAR;
            PG8_LDA(At, 0, 1); PG8_STAGE(PG8_SA(0, 0), a2, voffA);
            PG8_BAR; PG8_WAIT_L(0); PG8_MMA(1, 0, At, B0); PG8_BAR; PG8_SCHED;
            PG8_STAGE(PG8_SB(0, 1), b2 + hstep, voffB);
            PG8_WAIT_V(6); PG8_BAR; PG8_MMA(1, 1, At, B1); PG8_BAR;
            PG8_LDB(B0, 1, 0); PG8_SCHED; PG8_LDA(At, 1, 0); PG8_STAGE(PG8_SA(0, 1), a2 + hstep, voffA);
            PG8_WAIT_L(8); PG8_BAR; PG8_WAIT_L(0); PG8_MMA(0, 0, At, B0); PG8_BAR; PG8_SCHED;
            PG8_LDB(B1, 1, 1); PG8_STAGE(PG8_SB(1, 0), b3, voffB);
            PG8_BAR; PG8_WAIT_L(0); PG8_MMA(0, 1, At, B1); PG8_BAR;
            PG8_LDA(At, 1, 1); PG8_STAGE(PG8_SA(1, 0), a3, voffA);
            PG8_BAR; PG8_WAIT_L(0); PG8_MMA(1, 0, At, B0); PG8_BAR; PG8_SCHED;
            PG8_STAGE(PG8_SB(1, 1), b3 + hstep, voffB);
            PG8_WAIT_V(6); PG8_BAR; PG8_MMA(1, 1, At, B1); PG8_BAR;
            }
        }
        if constexpr (ALIGN_EPI) { if (wr == 0) PG8_BAR; }
        if constexpr (!Epi::AFTER_DRAIN) { E(acc, cur, wr, wc, fr, fq); S.done(cur); }
        if (!has_next) break;
#pragma unroll
        for (int a = 0; a < 2; ++a)
#pragma unroll
            for (int b = 0; b < 2; ++b)
#pragma unroll
                for (int m = 0; m < 4; ++m)
#pragma unroll
                    for (int n = 0; n < 2; ++n) acc[a][b][m][n] = (f32x4){0.f, 0.f, 0.f, 0.f};
        cur = nxt; cA = nA; cB = nB; ++ui;
        if constexpr (ALIGN_EPI) { if (wr == 1) PG8_BAR; }
    }
    PG8_WAIT_V(0);
    if constexpr (!ALIGN_EPI) { if (wr == 0) PG8_BAR; }
    PG8_BAR;
    if constexpr (Epi::AFTER_DRAIN) { E.fused(acc, cur, wr, wc, fr, fq, lds, wid, lane); S.done(cur); }
#undef PG8_SA
#undef PG8_SB
#undef PG8_STAGE
#undef PG8_LDA
#undef PG8_LDB
#undef PG8_MMA
#undef PG8_WAIT_V
#undef PG8_WAIT_L
#undef PG8_BAR
#undef PG8_SCHED
}
}
#define GAS __attribute__((address_space(1)))
#define LAS __attribute__((address_space(3)))
typedef unsigned short bf16;
typedef unsigned v4u __attribute__((ext_vector_type(4)));
typedef float f32x4 __attribute__((ext_vector_type(4)));
typedef short bf16x8 __attribute__((ext_vector_type(8)));
typedef GAS unsigned gu32;
typedef GAS unsigned long long gu64;
#define RLX_AGENT __ATOMIC_RELAXED, __HIP_MEMORY_SCOPE_AGENT
#define LDS_WAIT() asm volatile("s_waitcnt lgkmcnt(0)" ::: "memory")
#define VM_WAIT() asm volatile("s_waitcnt vmcnt(0)" ::: "memory")
__device__ __forceinline__ unsigned long long rt() { return __builtin_amdgcn_s_memrealtime(); }
__device__ __forceinline__ unsigned f2bf(float f) { unsigned u = __builtin_bit_cast(unsigned, f); return (u + 0x7fffu + ((u >> 16) & 1u)) >> 16; }
__device__ __forceinline__ unsigned pk2(float lo, float hi) { return f2bf(lo) | (f2bf(hi) << 16); }

#define XB_TMO      128
#define XB_XCNT(j)  (256  + 64 * (j))
#define XB_XSUB(j)  (1280 + 64 * (j))
#define XB_XGEN(j)  (2304 + 64 * (j))
#define XB_TOP      3328
#define XB_TOPGEN   3392
#define XCD_BAR_WORDS 3456
#define XB_SPIN_CAP (1u << 18)

__device__ __forceinline__ unsigned xb_ld(unsigned* p)              { return __hip_atomic_load(p, __ATOMIC_RELAXED, __HIP_MEMORY_SCOPE_AGENT); }
__device__ __forceinline__ unsigned xb_add(unsigned* p, unsigned v) { return __hip_atomic_fetch_add(p, v, __ATOMIC_RELAXED, __HIP_MEMORY_SCOPE_AGENT); }
__device__ __forceinline__ unsigned xb_xcc_id() { return (unsigned)__builtin_amdgcn_s_getreg((3 << 11) | 20) & 0xFu; }
#define XB_SPIN(cond, bar) do { unsigned _sp = 0; while (cond) { __builtin_amdgcn_s_sleep(1); \
    if ((++_sp & 255u) == 0u) { if (xb_ld(&(bar)[XB_TMO])) break; if (_sp > XB_SPIN_CAP) { atomicAdd(&(bar)[XB_TMO], 1u); break; } } } } while (0)

struct XcdBarrier {
    unsigned* bar; unsigned x;
    volatile LAS unsigned* st;
};

__device__ __forceinline__ XcdBarrier xcd_barrier_post(unsigned* bar, volatile LAS unsigned* st) {
    XcdBarrier b; b.bar = bar; b.x = xb_xcc_id(); b.st = st;
    if (threadIdx.x == 0) (void)xb_add(&bar[XB_XCNT(b.x)], 1u);
    return b;
}
__device__ __forceinline__ void xcd_barrier_complete(unsigned* bar, unsigned x, unsigned& nloc, unsigned& nx) {
    const unsigned G = gridDim.x * gridDim.y * gridDim.z;
    unsigned sum, cnt, mine, sp = 0u;
    for (;;) {
        sum = 0u; cnt = 0u; mine = 0u;
#pragma unroll
        for (unsigned j = 0; j < 16; ++j) { const unsigned c = xb_ld(&bar[XB_XCNT(j)]); sum += c; cnt += (c > 0u) ? 1u : 0u; mine = (j == x) ? c : mine; }
        if (sum == G) break;
        __builtin_amdgcn_s_sleep(1);
        if ((++sp & 255u) == 0u) { if (xb_ld(&bar[XB_TMO])) break; if (sp > XB_SPIN_CAP) { atomicAdd(&bar[XB_TMO], 1u); break; } }
    }
    nloc = mine > 0u ? mine : 1u; nx = cnt > 0u ? cnt : 1u;
}

__device__ __forceinline__ void xcd_barrier(const XcdBarrier& b) {
    asm volatile("s_waitcnt vmcnt(0)" ::: "memory");
    __syncthreads();
    if (threadIdx.x == 0) {
        unsigned* bar = b.bar;
        __builtin_amdgcn_s_waitcnt(0);
        unsigned nloc = b.st[0], nx = b.st[1];
        if (nloc == 0u) { xcd_barrier_complete(bar, b.x, nloc, nx); b.st[0] = nloc; b.st[1] = nx; }
        const unsigned old = xb_add(&bar[XB_XSUB(b.x)], 1u);
        const unsigned gen = old / nloc;
        if (old + 1u == (gen + 1u) * nloc) {
            __builtin_amdgcn_fence(__ATOMIC_RELEASE, "agent");
            asm volatile("s_waitcnt vmcnt(0)" ::: "memory");
            const unsigned og = xb_add(&bar[XB_TOP], 1u);
            const unsigned tg = og / nx;
            if (og + 1u == (tg + 1u) * nx) xb_add(&bar[XB_TOPGEN], 1u);
            else XB_SPIN(xb_ld(&bar[XB_TOPGEN]) == tg, bar);
            __builtin_amdgcn_fence(__ATOMIC_ACQUIRE, "agent");
            xb_add(&bar[XB_XGEN(b.x)], 1u);
            asm volatile("s_waitcnt vmcnt(0)" ::: "memory");
        } else {
            XB_SPIN(xb_ld(&bar[XB_XGEN(b.x)]) == gen, bar);
            __builtin_amdgcn_fence(__ATOMIC_ACQUIRE, "agent");
            asm volatile("s_waitcnt vmcnt(0)" ::: "memory");
        }
    }
    __syncthreads();
}


constexpr size_t MiB = 1u << 20;
constexpr size_t WS_CTL = 0, CTL_ZERO_BYTES = 1 * MiB;
constexpr size_t WS_BIAS = 1 * MiB, WS_LAM = 1 * MiB + 4096, WS_RMEM = 1 * MiB + 8192, WS_R0 = 1 * MiB + 65536;
constexpr size_t WS_SS1 = 2 * MiB, WS_SS2 = 4 * MiB, WS_SS3 = 6 * MiB;
constexpr size_t WS_WIN = 8 * MiB, WS_WOUT = 14 * MiB, WS_WCQ = 16 * MiB, WS_WCKV = 18 * MiB, WS_WCO = 22 * MiB, WS_WUP = 24 * MiB, WS_WDOWN = 36 * MiB;
constexpr size_t WS_MEMB = 42 * MiB, WS_MKB = 44 * MiB, WS_MVB = 46 * MiB;
constexpr size_t WS_XB = 48 * MiB, WS_ZCONV = 82 * MiB, WS_QB = 132 * MiB, WS_KB = 149 * MiB, WS_VB = 166 * MiB, WS_MIX = 184 * MiB;
constexpr size_t WS_X1 = 218 * MiB, WS_X1B = 284 * MiB, WS_QC = 317 * MiB, WS_OC = 350 * MiB, WS_X2 = 383 * MiB, WS_X2B = 449 * MiB;
constexpr size_t WS_UPB = 482 * MiB, WS_ACT = 661 * MiB, WS_X3 = 751 * MiB, WS_DPART = 817 * MiB, WS_END = 826 * MiB;
constexpr size_t WS_SSS1 = 1 * MiB + 256 * 1024, WS_SSS2 = WS_SSS1 + 32768, WS_SSS3 = WS_SSS2 + 32768;
constexpr int CW_BAR = 4096;
constexpr int DP_STRIDE = 132;

constexpr int RING_OFF = 0, RING_BYTES = 131072;
constexpr int LDSCTL_OFF = RING_BYTES, MISC_OFF = LDSCTL_OFF + 320;
constexpr int LDS_BYTES = 147456;
constexpr int NWAVES = 8;

__device__ __forceinline__ float wave_sum(float v) {
#pragma unroll
    for (int o = 1; o < 64; o <<= 1) v += __shfl_xor(v, o);
    return v;
}
__device__ __forceinline__ float wave_max(float v) {
#pragma unroll
    for (int o = 1; o < 64; o <<= 1) v = fmaxf(v, __shfl_xor(v, o));
    return v;
}
__device__ __forceinline__ float bf_lo(unsigned w) { return __uint_as_float(w << 16); }
__device__ __forceinline__ float bf_hi(unsigned w) { return __uint_as_float(w & 0xffff0000u); }
__device__ __forceinline__ void unpack8(const v4u w, float (&f)[8]) { f[0] = bf_lo(w.x); f[1] = bf_hi(w.x); f[2] = bf_lo(w.y); f[3] = bf_hi(w.y); f[4] = bf_lo(w.z); f[5] = bf_hi(w.z); f[6] = bf_lo(w.w); f[7] = bf_hi(w.w); }
__device__ __forceinline__ v4u pack8f(const float (&f)[8]) { v4u o; o.x = pk2(f[0], f[1]); o.y = pk2(f[2], f[3]); o.z = pk2(f[4], f[5]); o.w = pk2(f[6], f[7]); return o; }
template <int CTRL> __device__ __forceinline__ float dppf(float x) { return __int_as_float(__builtin_amdgcn_update_dpp(0, __float_as_int(x), CTRL, 0xF, 0xF, true)); }
__device__ __forceinline__ float ex2(float x) { return __builtin_amdgcn_exp2f(x); }
__device__ __forceinline__ int t5_bucket(int n) {
    if (n < 16) return n;
    const int b = 16 + (int)(__log2f((float)n * 0.0625f) * (16.0f / 3.0f));
    return b < 31 ? b : 31;
}

__device__ __forceinline__ void transpose_item(const float* W, int K, int N, bf16* WT, const float* ksc, LAS float* scr, int item, int lane) {
    const int nblk = N / 32, kb = item / nblk, nb = item % nblk, k0 = 64 * kb, n0 = 32 * nb;
#pragma unroll 8
    for (int i = 0; i < 32; ++i) { const int kk = 2 * i + (lane >> 5); const float sc = ksc ? ksc[k0 + kk] : 1.0f; scr[kk * 33 + (lane & 31)] = W[(size_t)(k0 + kk) * N + n0 + (lane & 31)] * sc; }
    LDS_WAIT(); asm volatile("" ::: "memory");
    const int c = lane & 7;
#pragma unroll
    for (int j = 0; j < 4; ++j) { const int n = (lane >> 3) + 8 * j; const LAS float* s = scr + (8 * c) * 33 + n;
        v4u o; o.x = pk2(s[0 * 33], s[1 * 33]); o.y = pk2(s[2 * 33], s[3 * 33]); o.z = pk2(s[4 * 33], s[5 * 33]); o.w = pk2(s[6 * 33], s[7 * 33]);
        *(GAS v4u*)(WT + (size_t)(n0 + n) * K + k0 + 8 * c) = o; }
    LDS_WAIT(); asm volatile("" ::: "memory");
}
__device__ __forceinline__ void rms_row(const float* xrow, bf16* orow, float* rout, int lane) {
    const GAS f32x4* xr = (const GAS f32x4*)xrow + lane;
    f32x4 v[4]; float s = 0.f;
#pragma unroll
    for (int j = 0; j < 4; ++j) { v[j] = xr[64 * j]; s += (v[j].x * v[j].x + v[j].y * v[j].y) + (v[j].z * v[j].z + v[j].w * v[j].w); }
    s = wave_sum(s);
    if (lane == 0) *rout = 1.0f / sqrtf(s * (1.0f / 1024.0f) + EPS);
    GAS unsigned long long* o8 = (GAS unsigned long long*)orow + lane;
#pragma unroll
    for (int j = 0; j < 4; ++j) o8[64 * j] = (unsigned long long)pk2(v[j].x, v[j].y) | ((unsigned long long)pk2(v[j].z, v[j].w) << 32);
}
struct Ptrs {
    const float* in[32]; float* out; unsigned char* ws;
};
#define WSP(T, off) ((T*)(P.ws + (off)))

__device__ __forceinline__ void p0_prologue(const Ptrs& P, LAS unsigned char* lds, int wave, int lane, int G) {
    LAS float* scr = (LAS float*)(lds + RING_OFF + wave * 16384);
    const int gw = blockIdx.x * NWAVES + wave, NGW = G * NWAVES;
    constexpr int I_IN = 16 * 96, I_OUT = 16 * 32, I_CQ = 16 * 32, I_CKV = 16 * 64, I_CO = 16 * 32, I_UP = 16 * 176, I_DOWN = 44 * 32;
    constexpr int NITEMS = I_IN + I_OUT + I_CQ + I_CKV + I_CO + I_UP + I_DOWN;
    for (int it = gw; it < NITEMS; it += NGW) {
        int r = it;
        if (r < I_IN) { transpose_item(P.in[12], 1024, 3072, WSP(bf16, WS_WIN), P.in[11], scr, r, lane); continue; } r -= I_IN;
        if (r < I_OUT) { transpose_item(P.in[20], 1024, 1024, WSP(bf16, WS_WOUT), nullptr, scr, r, lane); continue; } r -= I_OUT;
        if (r < I_CQ) { transpose_item(P.in[23], 1024, 1024, WSP(bf16, WS_WCQ), P.in[21], scr, r, lane); continue; } r -= I_CQ;
        if (r < I_CKV) { transpose_item(P.in[24], 1024, 2048, WSP(bf16, WS_WCKV), P.in[22], scr, r, lane); continue; } r -= I_CKV;
        if (r < I_CO) { transpose_item(P.in[25], 1024, 1024, WSP(bf16, WS_WCO), nullptr, scr, r, lane); continue; } r -= I_CO;
        if (r < I_UP) { transpose_item(P.in[27], 1024, 5632, WSP(bf16, WS_WUP), P.in[26], scr, r, lane); continue; } r -= I_UP;
        transpose_item(P.in[30], 2816, 1024, WSP(bf16, WS_WDOWN), nullptr, scr, r, lane);
    }
    bf16* xb = WSP(bf16, WS_XB); float* r0 = WSP(float, WS_R0);
    for (int m = gw; m < MT; m += NGW) {
        if (m < MREAL) { const float* src = m < MP ? P.in[0] + (size_t)m * DM : P.in[1] + (size_t)(m - MP) * DM; rms_row(src, xb + (size_t)m * DM, r0 + m, lane); }
        else { GAS unsigned long long* o8 = (GAS unsigned long long*)(xb + (size_t)m * DM) + lane;
#pragma unroll
            for (int j = 0; j < 4; ++j) o8[64 * j] = 0ull;
            if (lane == 0) r0[m] = 0.f; }
    }
    bf16* memb = WSP(bf16, WS_MEMB); float* rmem = WSP(float, WS_RMEM);
    for (int m = gw; m < NB * NMEM; m += NGW) rms_row(P.in[2] + (size_t)m * DM, memb + (size_t)m * DM, rmem + m, lane);
    if (blockIdx.x == 0) {
        float* bt = WSP(float, WS_BIAS);
        for (int idx = threadIdx.x; idx < 4 * DP_STRIDE; idx += NWAVES * 64) { const int h = idx / DP_STRIDE, n = idx % DP_STRIDE; const int bk = n < 128 ? t5_bucket(n) : 31; bt[idx] = P.in[10][bk * 4 + h] * LOG2E; }
        if (wave == 0) { const float a = wave_sum(P.in[15][lane] * P.in[16][lane]), b = wave_sum(P.in[17][lane] * P.in[18][lane]);
            if (lane == 0) *WSP(float, WS_LAM) = expf(a) - expf(b) + LAM_INIT; }
    }
}

__device__ __forceinline__ void p_convmix(const Ptrs& P, int wave, int lane, int G) {
    const int gw = blockIdx.x * NWAVES + wave, NGW = G * NWAVES;
    const bf16* zc = WSP(const bf16, WS_ZCONV); bf16* mix = WSP(bf16, WS_MIX);
    const int ch = lane * 8;
    float w0[8], w1[8], w2[8], bb[8];
#pragma unroll
    for (int i = 0; i < 8; ++i) { w0[i] = P.in[13][ch + i]; w1[i] = P.in[13][512 + ch + i]; w2[i] = P.in[13][1024 + ch + i]; bb[i] = P.in[14][ch + i]; }
    constexpr int NPI = MP / 16;
    for (int it = gw; it < NPI + DB; it += NGW) {
        float p2[8], p1[8];
        int row0, nrow, t0, bidx; const bool prompt = it < NPI;
        if (prompt) { row0 = it * 16; nrow = 16; t0 = row0 % SEQ; bidx = row0 / SEQ;
            if (t0 == 0) {
#pragma unroll
                for (int i = 0; i < 8; ++i) { p2[i] = 0.f; p1[i] = 0.f; } }
            else { float c[8], u[8];
                unpack8(*(const GAS v4u*)(zc + (size_t)(row0 - 2) * 1536 + 512 + ch), c); unpack8(*(const GAS v4u*)(zc + (size_t)(row0 - 2) * 1536 + 1024 + ch), u);
#pragma unroll
                for (int i = 0; i < 8; ++i) p2[i] = c[i] * u[i];
                unpack8(*(const GAS v4u*)(zc + (size_t)(row0 - 1) * 1536 + 512 + ch), c); unpack8(*(const GAS v4u*)(zc + (size_t)(row0 - 1) * 1536 + 1024 + ch), u);
#pragma unroll
                for (int i = 0; i < 8; ++i) p1[i] = c[i] * u[i]; } }
        else { bidx = it - NPI; row0 = MP + bidx * DS; nrow = DS; t0 = 0;
            const float* st = P.in[6] + (size_t)bidx * 2 * DCONV;
#pragma unroll
            for (int i = 0; i < 8; ++i) { p2[i] = st[ch + i]; p1[i] = st[DCONV + ch + i]; } }
        for (int r = 0; r < nrow; ++r) {
            const size_t row = (size_t)(row0 + r);
            float bv[8], c[8], u[8], pre[8], y[8];
            unpack8(*(const GAS v4u*)(zc + row * 1536 + ch), bv); unpack8(*(const GAS v4u*)(zc + row * 1536 + 512 + ch), c); unpack8(*(const GAS v4u*)(zc + row * 1536 + 1024 + ch), u);
#pragma unroll
            for (int i = 0; i < 8; ++i) { pre[i] = c[i] * u[i]; y[i] = bv[i] * (bb[i] + w0[i] * p2[i] + w1[i] * p1[i] + w2[i] * pre[i]); }
            *(GAS v4u*)(mix + row * 1024 + ch) = pack8f(y);
            const int t = t0 + r;
            if (prompt) { if (t >= SEQ - 2) { float* o = P.out + O_CMP + (size_t)(bidx * 2 + (t - (SEQ - 2))) * DCONV + ch; *(f32x4*)o = (f32x4){pre[0], pre[1], pre[2], pre[3]}; *(f32x4*)(o + 4) = (f32x4){pre[4], pre[5], pre[6], pre[7]}; } }
            else { if (t >= DS - 2) { float* o = P.out + O_CMS + (size_t)(bidx * 2 + (t - (DS - 2))) * DCONV + ch; *(f32x4*)o = (f32x4){pre[0], pre[1], pre[2], pre[3]}; *(f32x4*)(o + 4) = (f32x4){pre[4], pre[5], pre[6], pre[7]}; } }
#pragma unroll
            for (int i = 0; i < 8; ++i) { p2[i] = p1[i]; p1[i] = pre[i]; }
        }
    }
}

__device__ __forceinline__ void p_convffn(const Ptrs& P, int wave, int lane, int G) {
    const int gw = blockIdx.x * NWAVES + wave, NGW = G * NWAVES;
    const bf16* up = WSP(const bf16, WS_UPB); bf16* act = WSP(bf16, WS_ACT);
    constexpr int NPI = MP / 16, NCH = 6;
    for (int it = gw; it < (NPI + DB) * NCH; it += NGW) {
        const int rb = it / NCH, cc = it % NCH; const int cg = cc * 64 + lane;
        if (cg < DFF / 8) {
            const int ch = cg * 8;
            float wg0[8], wg1[8], wg2[8], bg[8], wu0[8], wu1[8], wu2[8], bu[8];
#pragma unroll
            for (int i = 0; i < 8; ++i) { wg0[i] = P.in[28][ch + i]; wg1[i] = P.in[28][DUP + ch + i]; wg2[i] = P.in[28][2 * DUP + ch + i]; bg[i] = P.in[29][ch + i];
                wu0[i] = P.in[28][DFF + ch + i]; wu1[i] = P.in[28][DUP + DFF + ch + i]; wu2[i] = P.in[28][2 * DUP + DFF + ch + i]; bu[i] = P.in[29][DFF + ch + i]; }
            float g2[8], g1[8], u2[8], u1[8];
            int row0, nrow, t0, bidx; const bool prompt = rb < NPI;
            if (prompt) { row0 = rb * 16; nrow = 16; t0 = row0 % SEQ; bidx = row0 / SEQ;
                if (t0 == 0) {
#pragma unroll
                    for (int i = 0; i < 8; ++i) { g2[i] = 0.f; g1[i] = 0.f; u2[i] = 0.f; u1[i] = 0.f; } }
                else { unpack8(*(const GAS v4u*)(up + (size_t)(row0 - 2) * DUP + ch), g2); unpack8(*(const GAS v4u*)(up + (size_t)(row0 - 2) * DUP + DFF + ch), u2);
                    unpack8(*(const GAS v4u*)(up + (size_t)(row0 - 1) * DUP + ch), g1); unpack8(*(const GAS v4u*)(up + (size_t)(row0 - 1) * DUP + DFF + ch), u1); } }
            else { bidx = rb - NPI; row0 = MP + bidx * DS; nrow = DS; t0 = 0;
                const float* st = P.in[7] + (size_t)bidx * 2 * DUP;
#pragma unroll
                for (int i = 0; i < 8; ++i) { g2[i] = st[ch + i]; u2[i] = st[DFF + ch + i]; g1[i] = st[DUP + ch + i]; u1[i] = st[DUP + DFF + ch + i]; } }
            for (int r = 0; r < nrow; ++r) {
                const size_t row = (size_t)(row0 + r);
                float g0[8], u0[8], a[8];
                unpack8(*(const GAS v4u*)(up + row * DUP + ch), g0); unpack8(*(const GAS v4u*)(up + row * DUP + DFF + ch), u0);
#pragma unroll
                for (int i = 0; i < 8; ++i) { const float gc = bg[i] + wg0[i] * g2[i] + wg1[i] * g1[i] + wg2[i] * g0[i]; const float uc = bu[i] + wu0[i] * u2[i] + wu1[i] * u1[i] + wu2[i] * u0[i];
                    a[i] = gc / (1.0f + __expf(-gc)) * uc; }
                *(GAS v4u*)(act + row * DFF + ch) = pack8f(a);
                const int t = t0 + r; const int tl = prompt ? SEQ - 2 : DS - 2;
                if (t >= tl) { float* o = P.out + (prompt ? O_CFP : O_CFS) + (size_t)(bidx * 2 + (t - tl)) * DUP + ch;
                    *(f32x4*)o = (f32x4){g0[0], g0[1], g0[2], g0[3]}; *(f32x4*)(o + 4) = (f32x4){g0[4], g0[5], g0[6], g0[7]};
                    *(f32x4*)(o + DFF) = (f32x4){u0[0], u0[1], u0[2], u0[3]}; *(f32x4*)(o + DFF + 4) = (f32x4){u0[4], u0[5], u0[6], u0[7]}; }
#pragma unroll
                for (int i = 0; i < 8; ++i) { g2[i] = g1[i]; g1[i] = g0[i]; u2[i] = u1[i]; u1[i] = u0[i]; }
            }
        }
    }
}

__device__ __forceinline__ void p_final(const Ptrs& P, int wave, int lane, int G) {
    const int gw = blockIdx.x * NWAVES + wave, NGW = G * NWAVES;
    const float* x3 = WSP(const float, WS_X3); const float* ss = WSP(const float, WS_SS3); const float* w = P.in[31];
    f32x4 wv[4];
#pragma unroll
    for (int j = 0; j < 4; ++j) wv[j] = *((const f32x4*)w + lane + 64 * j);
    for (int m = gw; m < MREAL; m += NGW) {
        const float tot = m < MP ? wave_sum(lane < 16 ? ss[(size_t)m * 16 + lane] : 0.f) : wave_sum(WSP(const float, WS_SSS3)[(size_t)(m - MP) * 64 + lane]);
        const float rs = 1.0f / sqrtf(tot * (1.0f / 1024.0f) + EPS);
        const GAS f32x4* xr = (const GAS f32x4*)(x3 + (size_t)m * DM) + lane;
        GAS f32x4* o = (GAS f32x4*)(P.out + (m < MP ? O_Y + (size_t)m * DM : O_YS + (size_t)(m - MP) * DM)) + lane;
#pragma unroll
        for (int j = 0; j < 4; ++j) o[64 * j] = xr[64 * j] * rs * wv[j];
    }
}

__device__ __forceinline__ void p_dattn_naive(const Ptrs& P, LAS unsigned char* lds, int wave, int lane, int G) {
    const int gw = blockIdx.x * NWAVES + wave, NGW = G * NWAVES;
    const bf16* qb = WSP(const bf16, WS_QB); const bf16* kb = WSP(const bf16, WS_KB); const bf16* vb = WSP(const bf16, WS_VB); bf16* mix = WSP(bf16, WS_MIX);
    const float* bt = WSP(const float, WS_BIAS); const float lam = *WSP(const float, WS_LAM);
    LAS float* qs = (LAS float*)(lds + wave * 1024); LAS float* ps = qs + 128;
    for (int it = gw; it < MP * NH; it += NGW) {
        const int m = it >> 2, h = it & 3, b = m / SEQ, t = m % SEQ;
        { const unsigned w = *(const GAS unsigned*)(qb + (size_t)m * 512 + h * 128 + 2 * lane); qs[2 * lane] = bf_lo(w); qs[2 * lane + 1] = bf_hi(w); }
        LDS_WAIT(); asm volatile("" ::: "memory");
        float m1 = -1e30f, m2 = -1e30f, l1 = 0.f, l2 = 0.f, o1x = 0.f, o1y = 0.f, o2x = 0.f, o2y = 0.f;
        for (int k0 = 0; k0 <= t; k0 += 64) {
            const int key = k0 + lane; const bool valid = key <= t; const int kc = valid ? key : t;
            const bf16* kr = kb + (size_t)(b * SEQ + kc) * 512 + h * 128;
            float s1 = 0.f, s2 = 0.f;
#pragma unroll
            for (int c = 0; c < 16; ++c) { float kf[8]; unpack8(*(const GAS v4u*)(kr + c * 8), kf);
#pragma unroll
                for (int i = 0; i < 8; ++i) { if (c < 8) s1 += kf[i] * qs[c * 8 + i]; else s2 += kf[i] * qs[c * 8 + i]; } }
            const int rel = t - kc; const float bias = bt[h * DP_STRIDE + (rel < 128 ? rel : 128)];
            s1 = valid ? s1 + bias : -1e30f; s2 = valid ? s2 + bias : -1e30f;
            const float mn1 = fmaxf(m1, wave_max(s1)), mn2 = fmaxf(m2, wave_max(s2));
            const float a1 = ex2(m1 - mn1), a2 = ex2(m2 - mn2);
            const float p1 = valid ? ex2(s1 - mn1) : 0.f, p2 = valid ? ex2(s2 - mn2) : 0.f;
            l1 = l1 * a1 + wave_sum(p1); l2 = l2 * a2 + wave_sum(p2); m1 = mn1; m2 = mn2;
            o1x *= a1; o1y *= a1; o2x *= a2; o2y *= a2;
            ps[lane] = p1; ps[64 + lane] = p2;
            LDS_WAIT(); asm volatile("" ::: "memory");
            const int nk = (t - k0 + 1) < 64 ? (t - k0 + 1) : 64;
            const bf16* vr = vb + (size_t)(b * SEQ + k0) * 512 + h * 128 + 2 * lane;
            for (int kk = 0; kk < nk; ++kk) { const float pa = ps[kk], pb = ps[64 + kk]; const unsigned w = *(const GAS unsigned*)(vr + (size_t)kk * 512); const float vx = bf_lo(w), vy = bf_hi(w);
                o1x += pa * vx; o1y += pa * vy; o2x += pb * vx; o2y += pb * vy; }
            LDS_WAIT(); asm volatile("" ::: "memory");
        }
        const float ax = o1x / l1 - lam * (o2x / l2), ay = o1y / l1 - lam * (o2y / l2);
        const float ssq = wave_sum(ax * ax + ay * ay);
        const float rn = (1.0f - LAM_INIT) / sqrtf(ssq * (1.0f / 128.0f) + EPS);
        const float wx = P.in[19][2 * lane], wy = P.in[19][2 * lane + 1];
        *(GAS unsigned*)(mix + (size_t)m * 1024 + 512 + h * 128 + 2 * lane) = pk2(ax * rn * wx, ay * rn * wy);
    }
}

template <bool SAMPLE> __device__ __forceinline__ void p_xattn_naive(const Ptrs& P, LAS unsigned char* lds, int wave, int lane, int G) {
    const int gw = blockIdx.x * NWAVES + wave, NGW = G * NWAVES;
    const bf16* qc = WSP(const bf16, WS_QC); bf16* oc = WSP(bf16, WS_OC);
    const bf16* mkb = WSP(const bf16, WS_MKB); const bf16* mvb = WSP(const bf16, WS_MVB);
    LAS float* qs = (LAS float*)(lds + wave * 2048); LAS float* ps = qs + 256;
    const int nit = (SAMPLE ? MS : MP) * MHEADS;
    for (int it = gw; it < nit; it += NGW) {
        const int mr = it >> 2, h = it & 3; const int m = SAMPLE ? MP + mr : mr; const int b = SAMPLE ? mr / DS : mr / SEQ;
        { const unsigned long long w = *(const GAS unsigned long long*)(qc + (size_t)m * 1024 + h * 256 + 4 * lane);
          qs[4 * lane] = bf_lo((unsigned)w); qs[4 * lane + 1] = bf_hi((unsigned)w); qs[4 * lane + 2] = bf_lo((unsigned)(w >> 32)); qs[4 * lane + 3] = bf_hi((unsigned)(w >> 32)); }
        LDS_WAIT(); asm volatile("" ::: "memory");
        float s[4];
#pragma unroll
        for (int c = 0; c < 4; ++c) {
            const int key = c * 64 + lane; float acc = 0.f;
            if (SAMPLE) { const float* kr = P.in[8] + ((size_t)(b * NMEM + key) * MHEADS + h) * MDH;
#pragma unroll 8
                for (int d = 0; d < 64; ++d) { const f32x4 kv = *(const GAS f32x4*)(kr + 4 * d); acc += kv.x * qs[4 * d] + kv.y * qs[4 * d + 1] + kv.z * qs[4 * d + 2] + kv.w * qs[4 * d + 3]; } }
            else { const bf16* kr = mkb + (size_t)(b * NMEM + key) * 1024 + h * 256;
#pragma unroll 8
                for (int d = 0; d < 32; ++d) { float kf[8]; unpack8(*(const GAS v4u*)(kr + 8 * d), kf);
#pragma unroll
                    for (int i = 0; i < 8; ++i) acc += kf[i] * qs[8 * d + i]; } }
            s[c] = acc;
        }
        const float mx = wave_max(fmaxf(fmaxf(s[0], s[1]), fmaxf(s[2], s[3])));
        float lsum = 0.f;
#pragma unroll
        for (int c = 0; c < 4; ++c) { const float p = ex2(s[c] - mx); ps[c * 64 + lane] = p; lsum += p; }
        lsum = wave_sum(lsum);
        LDS_WAIT(); asm volatile("" ::: "memory");
        float o[4] = {0.f, 0.f, 0.f, 0.f};
        for (int key = 0; key < NMEM; ++key) {
            const float p = ps[key];
            if (SAMPLE) { const f32x4 v = *(const GAS f32x4*)(P.in[9] + ((size_t)(b * NMEM + key) * MHEADS + h) * MDH + 4 * lane); o[0] += p * v.x; o[1] += p * v.y; o[2] += p * v.z; o[3] += p * v.w; }
            else { const unsigned long long w = *(const GAS unsigned long long*)(mvb + (size_t)(b * NMEM + key) * 1024 + h * 256 + 4 * lane);
                o[0] += p * bf_lo((unsigned)w); o[1] += p * bf_hi((unsigned)w); o[2] += p * bf_lo((unsigned)(w >> 32)); o[3] += p * bf_hi((unsigned)(w >> 32)); }
        }
        const float il = 1.0f / lsum;
        *(GAS unsigned long long*)(oc + (size_t)m * 1024 + h * 256 + 4 * lane) = (unsigned long long)pk2(o[0] * il, o[1] * il) | ((unsigned long long)pk2(o[2] * il, o[3] * il) << 32);
        LDS_WAIT(); asm volatile("" ::: "memory");
    }
}

template <int U> __device__ __forceinline__ void dec_step(const f32x4* K, const f32x4* V, const float (&qv)[4][4], float (&mm)[4], float (&ll)[4], float (&accA)[4][4], float (&accB)[4][4],
                                         const bool nearb, const float b31, const float* bth, const int relb) {
    float s[U][4];
#pragma unroll
    for (int u = 0; u < U; ++u)
#pragma unroll
        for (int t = 0; t < 4; ++t) s[u][t] = K[u].x * qv[t][0] + K[u].y * qv[t][1] + K[u].z * qv[t][2] + K[u].w * qv[t][3];
#pragma unroll
    for (int u = 0; u < U; ++u)
#pragma unroll
        for (int t = 0; t < 4; ++t) s[u][t] += dppf<0xB1>(s[u][t]);
#pragma unroll
    for (int u = 0; u < U; ++u)
#pragma unroll
        for (int t = 0; t < 4; ++t) s[u][t] += dppf<0x4E>(s[u][t]);
#pragma unroll
    for (int u = 0; u < U; ++u)
#pragma unroll
        for (int t = 0; t < 4; ++t) s[u][t] += dppf<0x141>(s[u][t]);
#pragma unroll
    for (int u = 0; u < U; ++u)
#pragma unroll
        for (int t = 0; t < 4; ++t) s[u][t] += dppf<0x140>(s[u][t]);
    if (!nearb) {
#pragma unroll
        for (int u = 0; u < U; ++u)
#pragma unroll
            for (int t = 0; t < 4; ++t) s[u][t] += b31;
    } else {
#pragma unroll
        for (int u = 0; u < U; ++u)
#pragma unroll
            for (int t = 0; t < 4; ++t) { const int rel = relb - 2 * u + t; s[u][t] += bth[rel < 128 ? rel : 128]; }
    }
    float mx[4]; bool grow = false;
#pragma unroll
    for (int t = 0; t < 4; ++t) { mx[t] = s[0][t];
#pragma unroll
        for (int u = 1; u < U; ++u) mx[t] = fmaxf(mx[t], s[u][t]);
        grow = grow || (mx[t] > mm[t] + 8.0f); }
    if (__any(grow)) {
#pragma unroll
        for (int t = 0; t < 4; ++t) { const float mn = fmaxf(mm[t], mx[t]); const float al = ex2(mm[t] - mn); const float alo = __shfl_xor(al, 16); ll[t] *= al; mm[t] = mn;
#pragma unroll
            for (int d = 0; d < 4; ++d) { accA[t][d] *= al; accB[t][d] *= alo; } }
    }
    float p[U][4], po[U][4];
#pragma unroll
    for (int u = 0; u < U; ++u)
#pragma unroll
        for (int t = 0; t < 4; ++t) p[u][t] = ex2(s[u][t] - mm[t]);
#pragma unroll
    for (int u = 0; u < U; ++u)
#pragma unroll
        for (int t = 0; t < 4; ++t) po[u][t] = __shfl_xor(p[u][t], 16);
#pragma unroll
    for (int u = 0; u < U; ++u)
#pragma unroll
        for (int t = 0; t < 4; ++t) { ll[t] += p[u][t];
            accA[t][0] += p[u][t] * V[u].x; accA[t][1] += p[u][t] * V[u].y; accA[t][2] += p[u][t] * V[u].z; accA[t][3] += p[u][t] * V[u].w;
            accB[t][0] += po[u][t] * V[u].x; accB[t][1] += po[u][t] * V[u].y; accB[t][2] += po[u][t] * V[u].z; accB[t][3] += po[u][t] * V[u].w; }
}
constexpr int DEC_U = 4, DEC_R = 8;
template <int MODE> __device__ __forceinline__ void p_decode_split(const Ptrs& P, int wave, int lane, int G) {
    const int gw = blockIdx.x * NWAVES + wave, NGW = G * NWAVES;
    const bf16* qb = WSP(const bf16, WS_QB); const float* bt = WSP(const float, WS_BIAS); float* dpart = MODE == 0 ? WSP(float, WS_DPART) : WSP(float, WS_END + 16 * MiB);
    const float* ck = P.in[3]; const float* cv = P.in[4]; const int* ptab = (const int*)P.in[5];
    const int kq = lane >> 5, l32 = lane & 31, mp = (lane >> 4) & 1, off = 4 * l32;
    for (int it = gw; it < DB * NH * 16; it += NGW) {
        const int bh = it >> 4, chunk = it & 15, bs = bh >> 2, h = bh & 3;
        float qv[4][4];
#pragma unroll
        for (int t = 0; t < 4; ++t) { const unsigned long long w = *(const GAS unsigned long long*)(qb + (size_t)(MP + bs * DS + t) * 512 + h * 128 + off);
            qv[t][0] = bf_lo((unsigned)w); qv[t][1] = bf_hi((unsigned)w); qv[t][2] = bf_lo((unsigned)(w >> 32)); qv[t][3] = bf_hi((unsigned)(w >> 32)); }
        const float* bth = bt + h * DP_STRIDE; const float b31 = bth[128];
        const int j0 = chunk * 512;
        float mm[4], ll[4], accA[4][4], accB[4][4];
#pragma unroll
        for (int t = 0; t < 4; ++t) { mm[t] = -1e30f; ll[t] = 0.f;
#pragma unroll
            for (int d = 0; d < 4; ++d) { accA[t][d] = 0.f; accB[t][d] = 0.f; } }
        f32x4 Kb[DEC_R], Vb[DEC_R];
        const int pgv = ptab[bs * NPAGES + chunk * 4 + (lane & 3)];
        const int pg0 = __builtin_amdgcn_readlane(pgv, 0), pg1 = MODE == 2 ? pg0 : __builtin_amdgcn_readlane(pgv, 1), pg2 = MODE == 2 ? pg0 : __builtin_amdgcn_readlane(pgv, 2), pg3 = MODE == 2 ? pg0 : __builtin_amdgcn_readlane(pgv, 3);
#define DEC_PG(k_) ((k_) == 0 ? pg0 : (k_) == 1 ? pg1 : (k_) == 2 ? pg2 : pg3)
#define DEC_CBASE(c_) ((((size_t)DEC_PG((2 * DEC_R * (c_)) >> 7) * PAGE + (MODE == 2 ? 0 : ((2 * DEC_R * (c_)) & 127)) + kq) * NH + h) * 128 + off)
        { const size_t gb = DEC_CBASE(0);
#pragma unroll
          for (int j = 0; j < DEC_R; ++j) { Kb[j] = *(const GAS f32x4*)(ck + gb + (size_t)j * 1024); Vb[j] = *(const GAS f32x4*)(cv + gb + (size_t)j * 1024); } }
        constexpr int NCYC = 256 / DEC_R;
        for (int c = 0; c < NCYC; ++c) {
            const bool more = c + 1 < NCYC;
            const size_t gn = more ? DEC_CBASE(c + 1) : 0;
            const bool nearb = (j0 + 2 * DEC_R * c + 2 * DEC_R - 1 + 128 > PAST);
            const int relg = PAST - (j0 + 2 * DEC_R * c + kq);
#pragma unroll
            for (int j = 0; j < DEC_R; j += DEC_U) {
                if (MODE == 1) {
#pragma unroll
                    for (int u = 0; u < DEC_U; ++u) { accA[0][0] += Kb[j + u].x + Vb[j + u].x; accA[0][1] += Kb[j + u].y + Vb[j + u].y; accA[0][2] += Kb[j + u].z + Vb[j + u].z; accA[0][3] += Kb[j + u].w + Vb[j + u].w; } }
                else dec_step<DEC_U>(&Kb[j], &Vb[j], qv, mm, ll, accA, accB, nearb, b31, bth, relg - 2 * j);
                if (more) {
#pragma unroll
                    for (int u = 0; u < DEC_U; ++u) { Kb[j + u] = *(const GAS f32x4*)(ck + gn + (size_t)(j + u) * 1024); Vb[j + u] = *(const GAS f32x4*)(cv + gn + (size_t)(j + u) * 1024); } }
            }
        }
#undef DEC_CBASE
#undef DEC_PG
        float Mx[4];
#pragma unroll
        for (int t = 0; t < 4; ++t) { const float M = fmaxf(mm[t], __shfl_xor(mm[t], 32)); const float f = ex2(mm[t] - M); Mx[t] = M; const float fo = __shfl_xor(f, 16);
            float l = ll[t] * f; l += __shfl_xor(l, 32); ll[t] = l;
#pragma unroll
            for (int d = 0; d < 4; ++d) { float a = accA[t][d] * f; a += __shfl_xor(a, 32); accA[t][d] = a; float bq = accB[t][d] * fo; bq += __shfl_xor(bq, 32); accB[t][d] = bq; } }
        if (kq == 0) {
#pragma unroll
            for (int t = 0; t < 4; ++t) {
                float* pa = dpart + ((size_t)it * 8 + mp * 4 + t) * DP_STRIDE; float* pb = dpart + ((size_t)it * 8 + (1 - mp) * 4 + t) * DP_STRIDE;
                *(f32x4*)(pa + off) = (f32x4){accA[t][0], accA[t][1], accA[t][2], accA[t][3]};
                *(f32x4*)(pb + off) = (f32x4){accB[t][0], accB[t][1], accB[t][2], accB[t][3]};
                if ((lane & 15) == 0) { pa[128] = Mx[t]; pa[129] = ll[t]; }
            }
        }
    }
}
__device__ __forceinline__ void p_decode_combine(const Ptrs& P, int wave, int lane, int G) {
    const int gw = blockIdx.x * NWAVES + wave, NGW = G * NWAVES;
    const bf16* qb = WSP(const bf16, WS_QB); const float* bt = WSP(const float, WS_BIAS); const float* dpart = WSP(const float, WS_DPART); bf16* mix = WSP(bf16, WS_MIX);
    const float lam = *WSP(const float, WS_LAM);
    for (int it = gw; it < DB * NH * DS; it += NGW) {
        const int t = it & 3, bh = it >> 2, bs = bh >> 2, h = bh & 3; const int row = MP + bs * DS + t;
        float res[2][2];
#pragma unroll
        for (int map = 0; map < 2; ++map) {
            const float* pbase = dpart + ((size_t)bh * 16 * 8 + map * 4 + t) * DP_STRIDE;
            float mc = -1e30f, lc = 0.f;
            if (lane < 16) { mc = pbase[(size_t)lane * 8 * DP_STRIDE + 128]; lc = pbase[(size_t)lane * 8 * DP_STRIDE + 129]; }
            const float qd = __uint_as_float((unsigned)qb[(size_t)row * 512 + h * 128 + map * 64 + lane] << 16);
            float sn[4];
#pragma unroll
            for (int i = 0; i < 4; ++i) { const float kd = P.out[O_KS + (size_t)(bs * DS + i) * 512 + h * 128 + map * 64 + lane]; const float s = wave_sum(qd * kd);
                sn[i] = (i <= t) ? s + bt[h * DP_STRIDE + (t - i >= 0 ? t - i : 0)] : -1e30f; }
            float M = wave_max(mc); M = fmaxf(fmaxf(M, sn[0]), fmaxf(fmaxf(sn[1], sn[2]), sn[3]));
            const float wc = ex2(mc - M);
            float L = wave_sum(wc * lc); float pn[4];
#pragma unroll
            for (int i = 0; i < 4; ++i) { pn[i] = (i <= t) ? ex2(sn[i] - M) : 0.f; L += pn[i]; }
            float ox = 0.f, oy = 0.f;
            for (int c = 0; c < 16; ++c) { const float w = __shfl(wc, c); ox += w * pbase[(size_t)c * 8 * DP_STRIDE + lane]; oy += w * pbase[(size_t)c * 8 * DP_STRIDE + 64 + lane]; }
#pragma unroll
            for (int i = 0; i < 4; ++i) { const float* vr = P.out + O_VS + (size_t)(bs * DS + i) * 512 + h * 128; ox += pn[i] * vr[lane]; oy += pn[i] * vr[64 + lane]; }
            res[map][0] = ox / L; res[map][1] = oy / L;
        }
        const float ax = res[0][0] - lam * res[1][0], ay = res[0][1] - lam * res[1][1];
        const float ssq = wave_sum(ax * ax + ay * ay);
        const float rn = (1.0f - LAM_INIT) / sqrtf(ssq * (1.0f / 128.0f) + EPS);
        bf16* o = mix + (size_t)row * 1024 + 512 + h * 128;
        o[lane] = (bf16)f2bf(ax * rn * P.in[19][lane]); o[64 + lane] = (bf16)f2bf(ay * rn * P.in[19][64 + lane]);
    }
}


namespace fa {
typedef short bf16x8 __attribute__((ext_vector_type(8)));
typedef float f32x16 __attribute__((ext_vector_type(16)));
typedef short v4i16_t __attribute__((ext_vector_type(4)));
constexpr int KS = 272, VS = 320, KT_BYTES = 64 * KS, VT_BYTES = 64 * VS, STAGE = KT_BYTES + VT_BYTES;
constexpr int TBL_OFF = 2 * STAGE;
constexpr float THR = 8.0f;
static_assert(TBL_OFF + 132 * 4 <= RING_BYTES && 65536 <= TBL_OFF, "fa LDS map");
__device__ __forceinline__ float swap_max(float x) { auto rr = __builtin_amdgcn_permlane32_swap(__float_as_uint(x), __float_as_uint(x), false, false); return fmaxf(__uint_as_float(rr[0]), __uint_as_float(rr[1])); }
__device__ __forceinline__ float swap_sum(float x) { auto rr = __builtin_amdgcn_permlane32_swap(__float_as_uint(x), __float_as_uint(x), false, false); return __uint_as_float(rr[0]) + __uint_as_float(rr[1]); }
__device__ __forceinline__ unsigned cvtpk(float lo, float hi) { unsigned r; asm volatile("v_cvt_pk_bf16_f32 %0, %1, %2" : "=v"(r) : "v"(lo), "v"(hi)); return r; }
__device__ __forceinline__ bf16x8 pack_p(const f32x16& p, int base) { v4u w; w.x = cvtpk(p[base], p[base + 1]); w.y = cvtpk(p[base + 2], p[base + 3]); w.z = cvtpk(p[base + 4], p[base + 5]); w.w = cvtpk(p[base + 6], p[base + 7]); return __builtin_bit_cast(bf16x8, w); }
__device__ __forceinline__ bf16x8 vfrag(const LAS unsigned char* p) {
    const v4i16_t lo = __builtin_amdgcn_ds_read_tr16_b64_v4i16((LAS v4i16_t*)p), hi = __builtin_amdgcn_ds_read_tr16_b64_v4i16((LAS v4i16_t*)(p + 8 * VS));
    return (bf16x8){lo[0], lo[1], lo[2], lo[3], hi[0], hi[1], hi[2], hi[3]};
}

__device__ __forceinline__ void dattn_flash(const Ptrs& P, LAS unsigned char* lds, int wave, int lane, int G) {
    const int tid = threadIdx.x;
    const bf16* qb = WSP(const bf16, WS_QB); const bf16* kb = WSP(const bf16, WS_KB); const bf16* vb = WSP(const bf16, WS_VB); bf16* mix = WSP(bf16, WS_MIX);
    const float* bt = WSP(const float, WS_BIAS); const float lam = *WSP(const float, WS_LAM);
    const int r32 = lane & 31, hi = lane >> 5, c = wave & 1, rg = wave >> 1;
    const int bx = blockIdx.x; const int vcu = (G % 8 == 0) ? (bx % 8) * (G / 8) + bx / 8 : bx;
    LAS float* tbl = (LAS float*)(lds + TBL_OFF);
    LAS float* ex = (LAS float*)lds;
    const int srow = tid >> 4, sch = tid & 15;
    const unsigned kl = srow * KS + sch * 16, vl = KT_BYTES + srow * VS + sch * 16;
    const unsigned kfo = r32 * KS + (c * 64 + hi * 8) * 2;
    const unsigned vfo = KT_BYTES + (4 * hi + ((lane & 15) >> 2)) * VS + (16 * ((lane >> 4) & 1) + 4 * (lane & 3)) * 2;
    for (int item = vcu; item < 256; item += G) {
        const int bh = item >> 4, pi = item & 15, b = bh >> 2, h = bh & 3;
        const size_t rowbase = (size_t)b * SEQ;
        __syncthreads();
        if (tid < 132) tbl[tid] = bt[h * DP_STRIDE + tid];
        for (int half = 0; half < 2; ++half) {
            const int qblk = half == 0 ? pi : 31 - pi;
            const int q0 = qblk * 128, NT = (q0 + 128) >> 6, tnear = (q0 >> 6) - 2;
            const int qpos = q0 + 32 * rg + r32;
            bf16x8 qr[4];
            { const bf16* qp = qb + (rowbase + qpos) * 512 + h * 128 + c * 64 + hi * 8;
#pragma unroll
              for (int dc = 0; dc < 4; ++dc) qr[dc] = *(const GAS bf16x8*)(qp + dc * 16); }
            const bf16* kg = kb + (rowbase + srow) * 512 + h * 128 + sch * 8; const bf16* vg = vb + (rowbase + srow) * 512 + h * 128 + sch * 8;
            v4u kst[2], vst[2];
#define FA_LOADG(t_) do { _Pragma("unroll") for (int i_ = 0; i_ < 2; ++i_) { kst[i_] = *(const GAS v4u*)(kg + ((size_t)(t_) * 64 + 32 * i_) * 512); vst[i_] = *(const GAS v4u*)(vg + ((size_t)(t_) * 64 + 32 * i_) * 512); } } while (0)
#define FA_STORE(so_) do { _Pragma("unroll") for (int i_ = 0; i_ < 2; ++i_) { *(LAS v4u*)(lds + (so_) + kl + i_ * 32 * KS) = kst[i_]; *(LAS v4u*)(lds + (so_) + vl + i_ * 32 * VS) = vst[i_]; } } while (0)
            FA_LOADG(0); FA_STORE(0);
            __syncthreads();
            const float b31 = tbl[128];
            float m = -1e30f, l = 0.f;
            f32x16 o[4];
#pragma unroll
            for (int k = 0; k < 4; ++k)
#pragma unroll
                for (int r = 0; r < 16; ++r) o[k][r] = 0.f;
            for (int t = 0; t < NT; ++t) {
                const int st = (t & 1) * STAGE;
                if (t + 1 < NT) FA_LOADG(t + 1);
                f32x16 p0, p1;
#pragma unroll
                for (int r = 0; r < 16; ++r) { p0[r] = 0.f; p1[r] = 0.f; }
                const LAS unsigned char* kbp = lds + st + kfo;
#pragma unroll
                for (int dc = 0; dc < 4; ++dc) {
                    const bf16x8 a0 = *(const LAS bf16x8*)(kbp + dc * 32), a1 = *(const LAS bf16x8*)(kbp + 32 * KS + dc * 32);
                    p0 = __builtin_amdgcn_mfma_f32_32x32x16_bf16(a0, qr[dc], p0, 0, 0, 0);
                    p1 = __builtin_amdgcn_mfma_f32_32x32x16_bf16(a1, qr[dc], p1, 0, 0, 0);
                }
                if (t < tnear) {
#pragma unroll
                    for (int r = 0; r < 16; ++r) { p0[r] += b31; p1[r] += b31; }
                } else {
                    const int rb = qpos - t * 64 - 4 * hi;
#pragma unroll
                    for (int r = 0; r < 16; ++r) {
                        const int rel0 = rb - ((r & 3) + 8 * (r >> 2)), rel1 = rel0 - 32;
                        const float b0 = tbl[rel0 < 0 ? 0 : (rel0 < 128 ? rel0 : 128)], b1 = tbl[rel1 < 0 ? 0 : (rel1 < 128 ? rel1 : 128)];
                        p0[r] = rel0 < 0 ? -1e30f : p0[r] + b0; p1[r] = rel1 < 0 ? -1e30f : p1[r] + b1;
                    }
                }
                float mx = fmaxf(p0[0], p1[0]);
#pragma unroll
                for (int r = 1; r < 16; ++r) mx = fmaxf(mx, fmaxf(p0[r], p1[r]));
                mx = swap_max(mx);
                if (__any(mx > m + THR)) {
                    const float mn = fmaxf(m, mx); const float al = ex2(m - mn); l *= al; m = mn;
#pragma unroll
                    for (int k = 0; k < 4; ++k)
#pragma unroll
                        for (int r = 0; r < 16; ++r) o[k][r] *= al;
                }
                float ls = 0.f;
#pragma unroll
                for (int r = 0; r < 16; ++r) { p0[r] = ex2(p0[r] - m); p1[r] = ex2(p1[r] - m); ls += p0[r] + p1[r]; }
                l += ls;
                bf16x8 pa[4]; pa[0] = pack_p(p0, 0); pa[1] = pack_p(p0, 8); pa[2] = pack_p(p1, 0); pa[3] = pack_p(p1, 8);
                const LAS unsigned char* vbp = lds + st + vfo;
#pragma unroll
                for (int s = 0; s < 4; ++s)
#pragma unroll
                    for (int k = 0; k < 4; ++k) {
                        const bf16x8 vf = vfrag(vbp + (16 * s) * VS + k * 64);
                        o[k] = __builtin_amdgcn_mfma_f32_32x32x16_bf16(vf, pa[s], o[k], 0, 0, 0);
                    }
                if (t + 1 < NT) FA_STORE(((t + 1) & 1) * STAGE);
                __syncthreads();
            }
#undef FA_LOADG
#undef FA_STORE
            l = swap_sum(l);
            const float il = 1.0f / l;
            if (c == 1) {
#pragma unroll
                for (int k = 0; k < 4; ++k)
#pragma unroll
                    for (int r = 0; r < 16; ++r) ex[(rg * 64 + k * 16 + r) * 64 + lane] = o[k][r] * il;
            }
            __syncthreads();
            if (c == 0) {
                float ssq = 0.f;
#pragma unroll
                for (int k = 0; k < 4; ++k)
#pragma unroll
                    for (int r = 0; r < 16; ++r) { const float a = o[k][r] * il - lam * ex[(rg * 64 + k * 16 + r) * 64 + lane]; o[k][r] = a; ssq += a * a; }
                ssq = swap_sum(ssq);
                const float rn = (1.0f - LAM_INIT) / sqrtf(ssq * (1.0f / 128.0f) + EPS);
                bf16* orow = mix + (rowbase + qpos) * 1024 + 512 + h * 128;
#pragma unroll
                for (int k = 0; k < 4; ++k)
#pragma unroll
                    for (int g = 0; g < 4; ++g) {
                        const int dv0 = 32 * k + 8 * g + 4 * hi;
                        const f32x4 w = *(const GAS f32x4*)(P.in[19] + dv0);
                        const unsigned long long pk = (unsigned long long)pk2(o[k][4 * g] * rn * w.x, o[k][4 * g + 1] * rn * w.y) | ((unsigned long long)pk2(o[k][4 * g + 2] * rn * w.z, o[k][4 * g + 3] * rn * w.w) << 32);
                        *(GAS unsigned long long*)(orow + dv0) = pk;
                    }
            }
            __syncthreads();
        }
    }
}
}


namespace fx {
using fa::bf16x8; using fa::f32x16; using fa::v4i16_t;
constexpr int KS = 528, VS = 576, TK = 32, KT_BYTES = TK * KS, VT_BYTES = TK * VS, STAGE = KT_BYTES + VT_BYTES;
static_assert(2 * STAGE <= RING_BYTES, "fx LDS map");
__device__ __forceinline__ bf16x8 vfrag(const LAS unsigned char* p) {
    const v4i16_t lo = __builtin_amdgcn_ds_read_tr16_b64_v4i16((LAS v4i16_t*)p), hi = __builtin_amdgcn_ds_read_tr16_b64_v4i16((LAS v4i16_t*)(p + 8 * VS));
    return (bf16x8){lo[0], lo[1], lo[2], lo[3], hi[0], hi[1], hi[2], hi[3]};
}
__device__ __forceinline__ void xattn_flash(const Ptrs& P, LAS unsigned char* lds, int wave, int lane, int G) {
    const int tid = threadIdx.x;
    const bf16* qc = WSP(const bf16, WS_QC); const bf16* mkb = WSP(const bf16, WS_MKB); const bf16* mvb = WSP(const bf16, WS_MVB); bf16* oc = WSP(bf16, WS_OC);
    const int r32 = lane & 31, hi = lane >> 5, dvh = wave & 1, rg = wave >> 1;
    const int bx = blockIdx.x; const int vcu = (G % 8 == 0) ? (bx % 8) * (G / 8) + bx / 8 : bx;
    const int srow = tid >> 5, sch = tid & 31;
    const unsigned kl = srow * KS + sch * 16, vl = KT_BYTES + srow * VS + sch * 16;
    const unsigned kfo = r32 * KS + (hi * 8) * 2;
    const unsigned vfo = KT_BYTES + (4 * hi + ((lane & 15) >> 2)) * VS + (128 * dvh + 16 * ((lane >> 4) & 1) + 4 * (lane & 3)) * 2;
    for (int unit = vcu; unit < 512; unit += G) {
        const int bh = unit >> 5, qblk = unit & 31, b = bh >> 2, h = bh & 3;
        const size_t row = (size_t)b * SEQ + qblk * 128 + 32 * rg + r32;
        bf16x8 qr[16];
        { const bf16* qp = qc + row * 1024 + h * 256 + hi * 8;
#pragma unroll
          for (int dc = 0; dc < 16; ++dc) qr[dc] = *(const GAS bf16x8*)(qp + dc * 16); }
        const bf16* kg = mkb + ((size_t)b * NMEM + srow) * 1024 + h * 256 + sch * 8; const bf16* vg = mvb + ((size_t)b * NMEM + srow) * 1024 + h * 256 + sch * 8;
        v4u kst[2], vst[2];
#define FX_LOADG(t_) do { _Pragma("unroll") for (int i_ = 0; i_ < 2; ++i_) { kst[i_] = *(const GAS v4u*)(kg + ((size_t)(t_) * TK + 16 * i_) * 1024); vst[i_] = *(const GAS v4u*)(vg + ((size_t)(t_) * TK + 16 * i_) * 1024); } } while (0)
#define FX_STORE(so_) do { _Pragma("unroll") for (int i_ = 0; i_ < 2; ++i_) { *(LAS v4u*)(lds + (so_) + kl + i_ * 16 * KS) = kst[i_]; *(LAS v4u*)(lds + (so_) + vl + i_ * 16 * VS) = vst[i_]; } } while (0)
        __syncthreads();
        FX_LOADG(0); FX_STORE(0);
        __syncthreads();
        float m = -1e30f, l = 0.f;
        f32x16 o[4];
#pragma unroll
        for (int k = 0; k < 4; ++k)
#pragma unroll
            for (int r = 0; r < 16; ++r) o[k][r] = 0.f;
        constexpr int NT = NMEM / TK;
        for (int t = 0; t < NT; ++t) {
            const int st = (t & 1) * STAGE;
            if (t + 1 < NT) FX_LOADG(t + 1);
            f32x16 p0;
#pragma unroll
            for (int r = 0; r < 16; ++r) p0[r] = 0.f;
            const LAS unsigned char* kbp = lds + st + kfo;
#pragma unroll
            for (int dc = 0; dc < 16; ++dc) {
                const bf16x8 a0 = *(const LAS bf16x8*)(kbp + dc * 32);
                p0 = __builtin_amdgcn_mfma_f32_32x32x16_bf16(a0, qr[dc], p0, 0, 0, 0);
            }
            float mx = p0[0];
#pragma unroll
            for (int r = 1; r < 16; ++r) mx = fmaxf(mx, p0[r]);
            mx = fa::swap_max(mx);
            if (__any(mx > m + fa::THR)) {
                const float mn = fmaxf(m, mx); const float al = ex2(m - mn); l *= al; m = mn;
#pragma unroll
                for (int k = 0; k < 4; ++k)
#pragma unroll
                    for (int r = 0; r < 16; ++r) o[k][r] *= al;
            }
            float ls = 0.f;
#pragma unroll
            for (int r = 0; r < 16; ++r) { p0[r] = ex2(p0[r] - m); ls += p0[r]; }
            l += ls;
            bf16x8 pa[2]; pa[0] = fa::pack_p(p0, 0); pa[1] = fa::pack_p(p0, 8);
            const LAS unsigned char* vbp = lds + st + vfo;
#pragma unroll
            for (int s = 0; s < 2; ++s)
#pragma unroll
                for (int k = 0; k < 4; ++k) {
                    const bf16x8 vf = vfrag(vbp + (16 * s) * VS + k * 64);
                    o[k] = __builtin_amdgcn_mfma_f32_32x32x16_bf16(vf, pa[s], o[k], 0, 0, 0);
                }
            if (t + 1 < NT) FX_STORE(((t + 1) & 1) * STAGE);
            __syncthreads();
        }
#undef FX_LOADG
#undef FX_STORE
        l = fa::swap_sum(l);
        const float il = 1.0f / l;
        bf16* orow = oc + row * 1024 + h * 256 + 128 * dvh;
#pragma unroll
        for (int k = 0; k < 4; ++k)
#pragma unroll
            for (int g = 0; g < 4; ++g) {
                const int dv0 = 32 * k + 8 * g + 4 * hi;
                const unsigned long long pk = (unsigned long long)pk2(o[k][4 * g] * il, o[k][4 * g + 1] * il) | ((unsigned long long)pk2(o[k][4 * g + 2] * il, o[k][4 * g + 3] * il) << 32);
                *(GAS unsigned long long*)(orow + dv0) = pk;
            }
    }
}
}


__device__ __forceinline__ float sss_total(const float* sss, int srow, int fq) {
    const f32x4* sp = (const f32x4*)(sss + (size_t)srow * 64 + fq * 16);
    const f32x4 a = sp[0], b = sp[1], c = sp[2], d = sp[3];
    float t = ((a[0] + a[1]) + (a[2] + a[3])) + ((b[0] + b[1]) + (b[2] + b[3])) + ((c[0] + c[1]) + (c[2] + c[3])) + ((d[0] + d[1]) + (d[2] + d[3]));
    t += __shfl_xor(t, 16); t += __shfl_xor(t, 32); return t;
}
struct SIn {
    const float* r0; bf16* zconv; bf16* qb; bf16* kb; bf16* vb; float* out;
    __device__ __forceinline__ void put(int srow, int col, f32x4 v, int fq, int cb) const {
        const size_t row = (size_t)MP + srow; v = v * r0[row];
        if (col < 1536) { *(GAS unsigned long long*)(zconv + row * 1536 + col) = (unsigned long long)pk2(v[0], v[1]) | ((unsigned long long)pk2(v[2], v[3]) << 32); }
        else if (col < 2048) { v = v * QSC; *(GAS unsigned long long*)(qb + row * 512 + (col - 1536)) = (unsigned long long)pk2(v[0], v[1]) | ((unsigned long long)pk2(v[2], v[3]) << 32); }
        else { const bool isk = col < 2560; const int c = col - (isk ? 2048 : 2560);
            *(GAS unsigned long long*)((isk ? kb : vb) + row * 512 + c) = (unsigned long long)pk2(v[0], v[1]) | ((unsigned long long)pk2(v[2], v[3]) << 32);
            *(f32x4*)(out + (isk ? O_KS : O_VS) + (size_t)srow * 512 + c) = v; }
    }
};
template <bool RESBF> struct SRes {
    const void* res; float* xo; bf16* xob; float* sss;
    __device__ __forceinline__ void put(int srow, int col, f32x4 v, int fq, int cb) const {
        f32x4 r;
        if (RESBF) { const unsigned long long w = *(const GAS unsigned long long*)((const bf16*)res + (size_t)srow * 1024 + col); r = (f32x4){bf_lo((unsigned)w), bf_hi((unsigned)w), bf_lo((unsigned)(w >> 32)), bf_hi((unsigned)(w >> 32))}; }
        else r = *(const f32x4*)((const float*)res + (size_t)srow * 1024 + col);
        const f32x4 o = r + v;
        if (xo) *(f32x4*)(xo + (size_t)srow * 1024 + col) = o;
        if (xob) *(GAS unsigned long long*)(xob + (size_t)srow * 1024 + col) = (unsigned long long)pk2(o[0], o[1]) | ((unsigned long long)pk2(o[2], o[3]) << 32);
        float sq = (o[0] * o[0] + o[1] * o[1]) + (o[2] * o[2] + o[3] * o[3]);
        sq += __shfl_xor(sq, 16); sq += __shfl_xor(sq, 32);
        if (fq == 0) sss[(size_t)srow * 64 + cb] = sq;
    }
};
struct SScale {
    const float* sss; bf16* O; int ldc; float cs;
    __device__ __forceinline__ void put(int srow, int col, f32x4 v, int fq, int cb) const {
        const float tot = sss_total(sss, srow, fq);
        v = v * (cs / sqrtf(tot * (1.0f / 1024.0f) + EPS));
        *(GAS unsigned long long*)(O + (size_t)srow * ldc + col) = (unsigned long long)pk2(v[0], v[1]) | ((unsigned long long)pk2(v[2], v[3]) << 32);
    }
};
template <class SE> __device__ __forceinline__ void sgemm(const bf16* A, const bf16* Bt, int N, int K, const SE& E, int wave, int lane, int G) {
    const int gw = blockIdx.x * NWAVES + wave, NGW = G * NWAVES;
    const int nunits = N >> 1, fr = lane & 15, fq = lane >> 4;
    for (int u = gw; u < nunits; u += NGW) {
        const int rb = u & 7, cb = u >> 3;
        const bf16* ap = A + (size_t)(rb * 16 + fr) * K + fq * 8; const bf16* bp = Bt + (size_t)(cb * 16 + fr) * K + fq * 8;
        f32x4 acc = (f32x4){0.f, 0.f, 0.f, 0.f};
        for (int k0 = 0; k0 < K; k0 += 256) {
            bf16x8 af[8], bfr[8];
#pragma unroll
            for (int j = 0; j < 8; ++j) { af[j] = *(const GAS bf16x8*)(ap + k0 + 32 * j); bfr[j] = *(const GAS bf16x8*)(bp + k0 + 32 * j); }
#pragma unroll
            for (int j = 0; j < 8; ++j) acc = __builtin_amdgcn_mfma_f32_16x16x32_bf16(bfr[j], af[j], acc, 0, 0, 0);
        }
        E.put(rb * 16 + fr, cb * 16 + 4 * fq, acc, fq, cb);
    }
}

constexpr int N_PHASES = 12;
#ifndef PROBE_REPS
#define PROBE_REPS {1,1,1,1,1,1,1,1,1,1,1,1}
#endif
constexpr int REPS[N_PHASES] = PROBE_REPS;
struct Args { const float* in[32]; float* out; unsigned char* ws; int ph_lo, ph_hi; };
__global__ void __launch_bounds__(NWAVES * 64, 2) mega_fwd(Args args) {
    extern __shared__ __attribute__((aligned(16))) unsigned char lds[];
    LAS unsigned char* L = (LAS unsigned char*)lds;
    volatile LAS unsigned* MISC = (volatile LAS unsigned*)(L + MISC_OFF);
    const int tid = threadIdx.x, lane = tid & 63, wave = __builtin_amdgcn_readfirstlane(tid >> 6);
    const int G = gridDim.x;
    Ptrs P;
#pragma unroll
    for (int i = 0; i < 32; ++i) P.in[i] = args.in[i];
    P.out = args.out; P.ws = args.ws;
    for (int u = tid; u < (LDS_BYTES - LDSCTL_OFF) / 4; u += NWAVES * 64) ((LAS unsigned*)(L + LDSCTL_OFF))[u] = 0u;
    __syncthreads();
    gu32* ctl = (gu32*)(P.ws + WS_CTL);
    XcdBarrier bar; bar.bar = (unsigned*)(ctl + CW_BAR); bar.x = 0; bar.st = nullptr;
#if !MK_PER_PHASE
    bar = xcd_barrier_post((unsigned*)(ctl + CW_BAR), MISC + 8);
#endif
    const int lo = args.ph_lo, hi = args.ph_hi;
#define IN(k) (lo <= (k) && (k) < hi)
#define SEAM(k) do { if (IN(k) && IN((k) + 1)) xcd_barrier(bar); } while (0)

    if (IN(0)) _Pragma("unroll") for (int rr_ = 0; rr_ < REPS[0]; ++rr_) { if (rr_) xcd_barrier(bar); p0_prologue(P, L, wave, lane, G); }
    SEAM(0);
    if (IN(1)) _Pragma("unroll") for (int rr_ = 0; rr_ < REPS[1]; ++rr_) { if (rr_) xcd_barrier(bar);
        { pg8::Gemm g{WSP(const bf16, WS_XB), WSP(const bf16, WS_WIN), MP, DIN, DM}; pg8::StaticOrder S; S.init(MP, DIN, G, (int)blockIdx.x);
          pg8::EpiIn E{WSP(const float, WS_R0), WSP(bf16, WS_ZCONV), WSP(bf16, WS_QB), WSP(bf16, WS_KB), WSP(bf16, WS_VB), P.out};
          pg8::gemm_phase<pg8::EpiIn, pg8::StaticOrder, true, true>(L + RING_OFF, g, S, E); }
        { SIn SE{WSP(const float, WS_R0), WSP(bf16, WS_ZCONV), WSP(bf16, WS_QB), WSP(bf16, WS_KB), WSP(bf16, WS_VB), P.out};
          sgemm<SIn>(WSP(const bf16, WS_XB) + (size_t)MP * DM, WSP(const bf16, WS_WIN), DIN, DM, SE, wave, lane, G); }
        { pg8::Gemm g{WSP(const bf16, WS_MEMB), WSP(const bf16, WS_WCKV), NB * NMEM, 2 * DM, DM}; pg8::StaticOrder S; S.init(NB * NMEM, 2 * DM, G, (int)blockIdx.x);
          pg8::EpiMem E{WSP(const float, WS_RMEM), WSP(bf16, WS_MKB), WSP(bf16, WS_MVB), P.out};
          pg8::gemm_phase<pg8::EpiMem, pg8::StaticOrder, true, true>(L + RING_OFF, g, S, E); }
    }
    SEAM(1);
    if (IN(2)) {
        const bool g1 = ((blockIdx.x >> 3) & 1) == 0;
        if (g1) { p_decode_split<0>(P, wave, lane, G); p_convmix(P, wave, lane, G); }
        fa::dattn_flash(P, L, wave, lane, G);
        if (!g1) { p_convmix(P, wave, lane, G); p_decode_split<0>(P, wave, lane, G); }
    }
    SEAM(2);
    if (IN(3)) _Pragma("unroll") for (int rr_ = 0; rr_ < REPS[3]; ++rr_) { if (rr_) xcd_barrier(bar); p_decode_combine(P, wave, lane, G); }
    SEAM(3);
    if (IN(4)) _Pragma("unroll") for (int rr_ = 0; rr_ < REPS[4]; ++rr_) { if (rr_) xcd_barrier(bar); pg8::Gemm g{WSP(const bf16, WS_MIX), WSP(const bf16, WS_WOUT), MP, DM, DM}; pg8::StaticOrder S; S.init(MP, DM, G, (int)blockIdx.x);
        pg8::EpiRes<false> E{P.in[0], nullptr, WSP(bf16, WS_X1B), WSP(float, WS_SS1)};
        pg8::gemm_phase<pg8::EpiRes<false>, pg8::StaticOrder, true, true>(L + RING_OFF, g, S, E);
        SRes<false> SE{P.in[1], nullptr, WSP(bf16, WS_X1B) + (size_t)MP * DM, WSP(float, WS_SSS1)};
        sgemm<SRes<false>>(WSP(const bf16, WS_MIX) + (size_t)MP * DM, WSP(const bf16, WS_WOUT), DM, DM, SE, wave, lane, G); }
    SEAM(4);
    if (IN(5)) _Pragma("unroll") for (int rr_ = 0; rr_ < REPS[5]; ++rr_) { if (rr_) xcd_barrier(bar); pg8::Gemm g{WSP(const bf16, WS_X1B), WSP(const bf16, WS_WCQ), MP, DM, DM}; pg8::StaticOrder S; S.init(MP, DM, G, (int)blockIdx.x);
        pg8::EpiScale E{WSP(const float, WS_SS1), WSP(bf16, WS_QC), DM, CQSC};
        pg8::gemm_phase<pg8::EpiScale, pg8::StaticOrder, true, true>(L + RING_OFF, g, S, E);
        SScale SE{WSP(const float, WS_SSS1), WSP(bf16, WS_QC) + (size_t)MP * DM, DM, CQSC};
        sgemm<SScale>(WSP(const bf16, WS_X1B) + (size_t)MP * DM, WSP(const bf16, WS_WCQ), DM, DM, SE, wave, lane, G); }
    SEAM(5);
    if (IN(6)) _Pragma("unroll") for (int rr_ = 0; rr_ < REPS[6]; ++rr_) { if (rr_) xcd_barrier(bar); fx::xattn_flash(P, L, wave, lane, G); p_xattn_naive<true>(P, L, wave, lane, G); }
    SEAM(6);
    if (IN(7)) _Pragma("unroll") for (int rr_ = 0; rr_ < REPS[7]; ++rr_) { if (rr_) xcd_barrier(bar); pg8::Gemm g{WSP(const bf16, WS_OC), WSP(const bf16, WS_WCO), MP, DM, DM}; pg8::StaticOrder S; S.init(MP, DM, G, (int)blockIdx.x);
        pg8::EpiRes<true> E{WSP(const bf16, WS_X1B), nullptr, WSP(bf16, WS_X2B), WSP(float, WS_SS2)};
        pg8::gemm_phase<pg8::EpiRes<true>, pg8::StaticOrder, true, true>(L + RING_OFF, g, S, E);
        SRes<true> SE{WSP(const bf16, WS_X1B) + (size_t)MP * DM, nullptr, WSP(bf16, WS_X2B) + (size_t)MP * DM, WSP(float, WS_SSS2)};
        sgemm<SRes<true>>(WSP(const bf16, WS_OC) + (size_t)MP * DM, WSP(const bf16, WS_WCO), DM, DM, SE, wave, lane, G); }
    SEAM(7);
    if (IN(8)) _Pragma("unroll") for (int rr_ = 0; rr_ < REPS[8]; ++rr_) { if (rr_) xcd_barrier(bar); pg8::Gemm g{WSP(const bf16, WS_X2B), WSP(const bf16, WS_WUP), MP, DUP, DM}; pg8::StaticOrder S; S.init(MP, DUP, G, (int)blockIdx.x);
        pg8::EpiScale E{WSP(const float, WS_SS2), WSP(bf16, WS_UPB), DUP, 1.0f};
        pg8::gemm_phase<pg8::EpiScale, pg8::StaticOrder, true, true>(L + RING_OFF, g, S, E);
        SScale SE{WSP(const float, WS_SSS2), WSP(bf16, WS_UPB) + (size_t)MP * DUP, DUP, 1.0f};
        sgemm<SScale>(WSP(const bf16, WS_X2B) + (size_t)MP * DM, WSP(const bf16, WS_WUP), DUP, DM, SE, wave, lane, G); }
    SEAM(8);
    if (IN(9)) _Pragma("unroll") for (int rr_ = 0; rr_ < REPS[9]; ++rr_) { if (rr_) xcd_barrier(bar); p_convffn(P, wave, lane, G); }
    SEAM(9);
    if (IN(10)) _Pragma("unroll") for (int rr_ = 0; rr_ < REPS[10]; ++rr_) { if (rr_) xcd_barrier(bar); pg8::Gemm g{WSP(const bf16, WS_ACT), WSP(const bf16, WS_WDOWN), MP, DM, DFF}; pg8::StaticOrder S; S.init(MP, DM, G, (int)blockIdx.x);
        pg8::EpiRes<true> E{WSP(const bf16, WS_X2B), WSP(float, WS_X3), nullptr, WSP(float, WS_SS3)};
        pg8::gemm_phase<pg8::EpiRes<true>, pg8::StaticOrder, true, true>(L + RING_OFF, g, S, E);
        SRes<true> SE{WSP(const bf16, WS_X2B) + (size_t)MP * DM, WSP(float, WS_X3) + (size_t)MP * DM, nullptr, WSP(float, WS_SSS3)};
        sgemm<SRes<true>>(WSP(const bf16, WS_ACT) + (size_t)MP * DFF, WSP(const bf16, WS_WDOWN), DM, DFF, SE, wave, lane, G); }
    SEAM(10);
    if (IN(11)) _Pragma("unroll") for (int rr_ = 0; rr_ < REPS[11]; ++rr_) { if (rr_) xcd_barrier(bar); p_final(P, wave, lane, G); }
#undef IN
#undef SEAM
}

extern "C" void kernel_launch(void* const* d_in, const int* in_sizes, int n_in, void* d_out, int out_size, void* d_ws, size_t ws_size, hipStream_t stream) {
    static int grid = 0;
    if (grid == 0) {
        if (n_in != 32 || out_size != (int)O_END || ws_size < WS_END) { fprintf(stderr, "kernel_launch: unexpected shapes: n_in %d out %d ws %zu\n", n_in, out_size, ws_size); grid = -1; return; }
        int dev = 0, cus = 0, per_cu = 0;
        if (hipGetDevice(&dev) != hipSuccess || hipDeviceGetAttribute(&cus, hipDeviceAttributeMultiprocessorCount, dev) != hipSuccess) { grid = -1; return; }
        if (hipFuncSetAttribute((const void*)mega_fwd, hipFuncAttributeMaxDynamicSharedMemorySize, LDS_BYTES) != hipSuccess) { fprintf(stderr, "kernel_launch: hipFuncSetAttribute failed\n"); grid = -1; return; }
        if (hipOccupancyMaxActiveBlocksPerMultiprocessor(&per_cu, (const void*)mega_fwd, NWAVES * 64, LDS_BYTES) != hipSuccess || per_cu < 1) fprintf(stderr, "kernel_launch: occupancy query reports %d\n", per_cu);
        (void)hipGetLastError();
        grid = cus;
    }
    if (grid < 0) return;
    if (hipMemsetAsync((char*)d_ws + WS_CTL, 0, CTL_ZERO_BYTES, stream) != hipSuccess) return;
    Args a{};
    for (int i = 0; i < 32; ++i) a.in[i] = (const float*)d_in[i];
    a.out = (float*)d_out; a.ws = (unsigned char*)d_ws;
#if MK_PER_PHASE
    for (int p = 0; p < N_PHASES; ++p) { a.ph_lo = p; a.ph_hi = p + 1; hipLaunchKernelGGL(mega_fwd, dim3(grid), dim3(NWAVES * 64), LDS_BYTES, stream, a); }
#else
    a.ph_lo = 0; a.ph_hi = N_PHASES; hipLaunchKernelGGL(mega_fwd, dim3(grid), dim3(NWAVES * 64), LDS_BYTES, stream, a);
#endif
}
```

```cpp
#include <hip/hip_runtime.h>
#include <cstdio>
#include <cstdint>

#ifndef MK_PER_PHASE
#define MK_PER_PHASE 0
#endif

constexpr int DM = 1024, NB = 4, SEQ = 4096, MP = NB * SEQ;
constexpr int DB = 32, DS = 4, MS = DB * DS;
constexpr int MREAL = MP + MS, MT = 16640;
constexpr int PAST = 8192, PAGE = 128, NPAGES = PAST / PAGE;
constexpr int DCONV = 512, NH = 4, HDK = 64, HDV = 128, DATT = 512, DIN = 3072;
constexpr int NMEM = 256, MHEADS = 4, MDH = 256, DFF = 2816, DUP = 2 * DFF;
constexpr float EPS = 1e-6f, LOG2E = 1.4426950408889634f;
constexpr float QSC = 0.125f * LOG2E;
constexpr float CQSC = 0.0625f * LOG2E;
constexpr float LAM_INIT = 0.2f;
constexpr size_t O_Y = 0, O_YS = 16777216, O_KP = 16908288, O_VP = 25296896, O_KS = 33685504, O_VS = 33751040,
                 O_CMP = 33816576, O_CMS = 33820672, O_CFP = 33853440, O_CFS = 33898496, O_MK = 34258944, O_MV = 35307520, O_END = 36356096;
namespace pg8 {
#define PG8_LAS __attribute__((address_space(3)))
typedef unsigned short bf16_t;
typedef short bf16x8 __attribute__((ext_vector_type(8)));
typedef float f32x4 __attribute__((ext_vector_type(4)));
typedef unsigned u32x4 __attribute__((ext_vector_type(4)));
constexpr int BM = 256, BK = 64, HALF = 128, HTB = HALF * BK * 2  , STAGE_BYTES = 8 * HTB, NXCD = 8, WGM = 8;

__host__ __device__ __forceinline__ int lds_byte(int r, int c) { const int st = (r >> 4) * 2 + (c >> 5), rr = r & 15, cc = c & 31, ob = rr * 64 + cc * 2; return st * 1024 + (ob ^ (((ob >> 9) & 1) << 5)); }
__host__ __device__ __forceinline__ void stage_rc(int b, int& R, int& C) { const int st = b / 1024, sb = b % 1024, swz = sb ^ (((sb >> 9) & 1) << 5); R = (st >> 1) * 16 + swz / 64; C = (st & 1) * 32 + (swz % 64) / 2; }
__host__ __device__ __forceinline__ int perm32(int rho) { const int n = rho >> 4, i = rho & 15; return 8 * (i >> 2) + 4 * n + (i & 3); }

struct Unit { int pm, pn; };
struct Gemm { const bf16_t* A; const bf16_t* Bt; int M, N, K; };

struct StaticOrder {
    int nM, nN, nwg, G, c;
    __host__ __device__ void init(int M, int N, int G_, int c_) { nM = M / BM; nN = N / BM; nwg = nM * nN; G = G_; c = c_; }
    __host__ __device__ bool next(int i, Unit& u) const {
        const long L = (long)i * G + c; if (L >= nwg) return false;
        int wgid = (int)L; { const int q = nwg / NXCD, r = nwg % NXCD, xcd = wgid % NXCD, off = wgid / NXCD; wgid = (xcd < r ? xcd * (q + 1) : r * (q + 1) + (xcd - r) * q) + off; }
        const int nig = WGM * nN, gid = wgid / nig, fm = gid * WGM, gsz = (nM - fm) < WGM ? (nM - fm) : WGM;
        u.pm = fm + ((wgid % nig) % gsz); u.pn = (wgid % nig) / gsz; return true;
    }
    __device__ __forceinline__ void a_ready(const Unit&) const {}
    __device__ __forceinline__ void done(const Unit&) const {}
};

__device__ __forceinline__ unsigned cvt_pk_bf16(float lo, float hi) { unsigned r; asm volatile("v_cvt_pk_bf16_f32 %0, %1, %2" : "=v"(r) : "v"(lo), "v"(hi)); return r; }
__device__ __forceinline__ u32x4 pack8(const f32x4 a, const f32x4 b) { u32x4 w; w.x = cvt_pk_bf16(a[0], a[1]); w.y = cvt_pk_bf16(a[2], a[3]); w.z = cvt_pk_bf16(b[0], b[1]); w.w = cvt_pk_bf16(b[2], b[3]); return w; }
__device__ __forceinline__ float dot4(const f32x4 a) { return (a[0] * a[0] + a[1] * a[1]) + (a[2] * a[2] + a[3] * a[3]); }

struct EpiIn {
    static constexpr bool PERM = true, AFTER_DRAIN = false;
    const float* r0; bf16_t* zconv; bf16_t* qb; bf16_t* kb; bf16_t* vb; float* out;
    __device__ __forceinline__ void operator()(const f32x4 (&acc)[2][2][4][2], const Unit& u, int wr, int wc, int fr, int fq) const {
        const int pn = u.pn;
#pragma unroll
        for (int ai = 0; ai < 2; ++ai)
#pragma unroll
            for (int m = 0; m < 4; ++m) {
                const int row = u.pm * BM + ai * HALF + wr * 64 + m * 16 + fr;
                {
                    const float rs = r0[row];
#pragma unroll
                    for (int bj = 0; bj < 2; ++bj) {
                        const int col = pn * BM + bj * HALF + wc * 32 + 8 * fq;
                        const f32x4 v0 = acc[ai][bj][m][0] * rs, v1 = acc[ai][bj][m][1] * rs;
                        if (pn < 6) { *(u32x4*)(zconv + (size_t)row * 1536 + col) = pack8(v0, v1); }
                        else if (pn < 8) { *(u32x4*)(qb + (size_t)row * 512 + (col - 1536)) = pack8(v0 * QSC, v1 * QSC); }
                        else { const bool isk = pn < 10; const int c = col - (isk ? 2048 : 2560);
                            *(u32x4*)((isk ? kb : vb) + (size_t)row * 512 + c) = pack8(v0, v1);
                            float* o = out + (isk ? O_KP : O_VP) + (size_t)row * 512 + c;
                            *(f32x4*)o = v0; *(f32x4*)(o + 4) = v1; }
                    }
                }
            }
    }
};
struct EpiMem {
    static constexpr bool PERM = true, AFTER_DRAIN = false;
    const float* rmem; bf16_t* mkb; bf16_t* mvb; float* out;
    __device__ __forceinline__ void operator()(const f32x4 (&acc)[2][2][4][2], const Unit& u, int wr, int wc, int fr, int fq) const {
        const int pn = u.pn; const bool isk = pn < 4;
#pragma unroll
        for (int ai = 0; ai < 2; ++ai)
#pragma unroll
            for (int m = 0; m < 4; ++m) {
                const int row = u.pm * BM + ai * HALF + wr * 64 + m * 16 + fr;
                const float rs = rmem[row];
#pragma unroll
                for (int bj = 0; bj < 2; ++bj) {
                    const int col = (pn & 3) * BM + bj * HALF + wc * 32 + 8 * fq;
                    const f32x4 v0 = acc[ai][bj][m][0] * rs, v1 = acc[ai][bj][m][1] * rs;
                    *(u32x4*)((isk ? mkb : mvb) + (size_t)row * 1024 + col) = pack8(v0, v1);
                    float* o = out + (isk ? O_MK : O_MV) + (size_t)row * 1024 + col;
                    *(f32x4*)o = v0; *(f32x4*)(o + 4) = v1;
                }
            }
    }
};
template <bool RESBF> struct EpiRes {
    static constexpr bool PERM = true, AFTER_DRAIN = false;
    const void* res; float* xo; bf16_t* xob; float* ss;
    __device__ __forceinline__ void operator()(const f32x4 (&acc)[2][2][4][2], const Unit& u, int wr, int wc, int fr, int fq) const {
        const int pn = u.pn;
#pragma unroll
        for (int ai = 0; ai < 2; ++ai)
#pragma unroll
            for (int m = 0; m < 4; ++m) {
                const int row = u.pm * BM + ai * HALF + wr * 64 + m * 16 + fr;
                float sq = 0.f;
#pragma unroll
                for (int bj = 0; bj < 2; ++bj) {
                    const int col = pn * BM + bj * HALF + wc * 32 + 8 * fq;
                    f32x4 a, b;
                    if (RESBF) { const u32x4 w = *(const u32x4*)((const bf16_t*)res + (size_t)row * 1024 + col);
                        a = (f32x4){__uint_as_float(w.x << 16), __uint_as_float(w.x & 0xffff0000u), __uint_as_float(w.y << 16), __uint_as_float(w.y & 0xffff0000u)};
                        b = (f32x4){__uint_as_float(w.z << 16), __uint_as_float(w.z & 0xffff0000u), __uint_as_float(w.w << 16), __uint_as_float(w.w & 0xffff0000u)}; }
                    else { const float* rp = (const float*)res + (size_t)row * 1024 + col; a = *(const f32x4*)rp; b = *(const f32x4*)(rp + 4); }
                    const f32x4 o0 = a + acc[ai][bj][m][0], o1 = b + acc[ai][bj][m][1];
                    if (xo) { float* xp = xo + (size_t)row * 1024 + col; *(f32x4*)xp = o0; *(f32x4*)(xp + 4) = o1; }
                    if (xob) *(u32x4*)(xob + (size_t)row * 1024 + col) = pack8(o0, o1);
                    sq += dot4(o0) + dot4(o1);
                }
                sq += __shfl_xor(sq, 16); sq += __shfl_xor(sq, 32);
                if (fq == 0) ss[(size_t)row * 16 + pn * 4 + wc] = sq;
            }
    }
};
struct EpiScale {
    static constexpr bool PERM = true, AFTER_DRAIN = false;
    const float* ss; bf16_t* O; int ldc; float cs;
    __device__ __forceinline__ void operator()(const f32x4 (&acc)[2][2][4][2], const Unit& u, int wr, int wc, int fr, int fq) const {
        const int pn = u.pn;
#pragma unroll
        for (int ai = 0; ai < 2; ++ai)
#pragma unroll
            for (int m = 0; m < 4; ++m) {
                const int row = u.pm * BM + ai * HALF + wr * 64 + m * 16 + fr;
                const f32x4* sp = (const f32x4*)(ss + (size_t)row * 16);
                const f32x4 s0 = sp[0], s1 = sp[1], s2 = sp[2], s3 = sp[3];
                const float tot = ((s0[0] + s0[1]) + (s0[2] + s0[3])) + ((s1[0] + s1[1]) + (s1[2] + s1[3])) + ((s2[0] + s2[1]) + (s2[2] + s2[3])) + ((s3[0] + s3[1]) + (s3[2] + s3[3]));
                const float rs = cs / sqrtf(fmaxf(tot, 0.f) * (1.0f / 1024.0f) + EPS);
#pragma unroll
                for (int bj = 0; bj < 2; ++bj) {
                    const int col = pn * BM + bj * HALF + wc * 32 + 8 * fq;
                    *(u32x4*)(O + (size_t)row * ldc + col) = pack8(acc[ai][bj][m][0] * rs, acc[ai][bj][m][1] * rs);
                }
            }
    }
};
template <class Epi, class Sched, bool ALIGN_EPI = false, bool SP2 = false>
__device__ __forceinline__ void gemm_phase(PG8_LAS unsigned char* lds, const Gemm g, const Sched& S, const Epi& E) {
    const int tid = threadIdx.x, wid = __builtin_amdgcn_readfirstlane(tid >> 6), lane = tid & 63, wr = wid >> 2, wc = wid & 3, fr = lane & 15, fq = lane >> 4;
    const int K = g.K, nt = K / BK;
    unsigned voffA[2], voffB[2];
#pragma unroll
    for (int i = 0; i < 2; ++i) { int R, C; stage_rc(tid * 16 + i * 8192, R, C); const int Rb = Epi::PERM ? ((R & ~31) + perm32(R & 31)) : R;
        voffA[i] = (unsigned)(R * K + C) * 2u; voffB[i] = (unsigned)(Rb * K + C) * 2u; }
    const size_t kstep = (size_t)(BK * 2);
    const size_t hstep = (size_t)HALF * K * 2;
    const size_t tstep = 2 * hstep;
    const unsigned ldsw = (unsigned)wid * 1024u;
    const int aoff = lds_byte(wr * 64 + fr, fq * 8), boff = lds_byte(wc * 32 + fr, fq * 8);
#define PG8_SA(b, h) (((b) * 2 + (h)) * HTB)
#define PG8_SB(b, h) ((4 + (b) * 2 + (h)) * HTB)
#define PG8_STAGE(bufoff, gbase, voff) do { _Pragma("unroll") for (int _i = 0; _i < 2; ++_i) \
        __builtin_amdgcn_global_load_lds((const unsigned*)((const char*)(gbase) + (voff)[_i]), (PG8_LAS unsigned*)(lds + (bufoff) + ldsw + _i * 8192), 16, 0, 0); } while (0)
#define PG8_LDA(dst, b, h) do { _Pragma("unroll") for (int m = 0; m < 4; ++m) _Pragma("unroll") for (int k = 0; k < 2; ++k) dst[m][k] = *(const PG8_LAS bf16x8*)(lds + PG8_SA(b, h) + aoff + m * 2048 + k * 1024); } while (0)
#define PG8_LDB(dst, b, h) do { _Pragma("unroll") for (int n = 0; n < 2; ++n) _Pragma("unroll") for (int k = 0; k < 2; ++k) dst[n][k] = *(const PG8_LAS bf16x8*)(lds + PG8_SB(b, h) + boff + n * 2048 + k * 1024); } while (0)
#define PG8_MMA(ai, bj, At, Bt) do { __builtin_amdgcn_s_setprio(1); _Pragma("unroll") for (int m = 0; m < 4; ++m) _Pragma("unroll") for (int n = 0; n < 2; ++n) _Pragma("unroll") for (int k = 0; k < 2; ++k) \
        acc[ai][bj][m][n] = __builtin_amdgcn_mfma_f32_16x16x32_bf16(Bt[n][k], At[m][k], acc[ai][bj][m][n], 0, 0, 0); __builtin_amdgcn_s_setprio(0); } while (0)
#define PG8_WAIT_V(n) asm volatile("s_waitcnt vmcnt(" #n ")" ::: "memory")
#define PG8_WAIT_L(n) asm volatile("s_waitcnt lgkmcnt(" #n ")" ::: "memory")
#define PG8_BAR __builtin_amdgcn_s_barrier()
#define PG8_SCHED __builtin_amdgcn_sched_barrier(0)
    Unit cur, nxt; int ui = 0;
    if (!S.next(0, cur)) return;
    f32x4 acc[2][2][4][2];
#pragma unroll
    for (int a = 0; a < 2; ++a)
#pragma unroll
        for (int b = 0; b < 2; ++b)
#pragma unroll
            for (int m = 0; m < 4; ++m)
#pragma unroll
                for (int n = 0; n < 2; ++n) acc[a][b][m][n] = (f32x4){0.f, 0.f, 0.f, 0.f};
    bf16x8 At[4][2], B0[2][2], B1[2][2];
    const char* cA = (const char*)g.A + (size_t)cur.pm * tstep; const char* cB = (const char*)g.Bt + (size_t)cur.pn * tstep;
    S.a_ready(cur);
    if constexpr (SP2) {
        PG8_STAGE(PG8_SB(0, 0), cB, voffB); PG8_STAGE(PG8_SB(0, 1), cB + hstep, voffB); PG8_STAGE(PG8_SA(0, 0), cA, voffA); PG8_STAGE(PG8_SA(0, 1), cA + hstep, voffA);
        if (wr == 1) PG8_BAR;
        PG8_WAIT_V(2); PG8_BAR;
        PG8_STAGE(PG8_SB(1, 0), cB + kstep, voffB); PG8_STAGE(PG8_SA(1, 0), cA + kstep, voffA); PG8_STAGE(PG8_SB(1, 1), cB + hstep + kstep, voffB);
        PG8_WAIT_V(6); PG8_BAR;
    } else {
        PG8_STAGE(PG8_SB(0, 0), cB, voffB); PG8_STAGE(PG8_SA(0, 0), cA, voffA); PG8_STAGE(PG8_SB(0, 1), cB + hstep, voffB); PG8_STAGE(PG8_SA(0, 1), cA + hstep, voffA);
        if (wr == 1) PG8_BAR;
        PG8_WAIT_V(4); PG8_BAR;
        PG8_STAGE(PG8_SB(1, 0), cB + kstep, voffB); PG8_STAGE(PG8_SA(1, 0), cA + kstep, voffA); PG8_STAGE(PG8_SB(1, 1), cB + hstep + kstep, voffB);
        PG8_WAIT_V(6); PG8_BAR;
    }
    for (;;) {
        const bool has_next = S.next(ui + 1, nxt);
        const char* nA = has_next ? (const char*)g.A + (size_t)nxt.pm * tstep : cA; const char* nB = has_next ? (const char*)g.Bt + (size_t)nxt.pn * tstep : cB;
        for (int t = 0; t < nt; t += 2) {
            const bool last = (t == nt - 2);
            const char* a1 = cA + (size_t)(t + 1) * kstep;
            const char* a2 = last ? nA : cA + (size_t)(t + 2) * kstep; const char* b2 = last ? nB : cB + (size_t)(t + 2) * kstep;
            const char* a3 = a2 + kstep; const char* b3 = b2 + kstep;
            if (last && has_next) S.a_ready(nxt);
            if constexpr (SP2) {
            PG8_LDB(B0, 0, 0); PG8_LDB(B1, 0, 1); PG8_SCHED; PG8_LDA(At, 0, 0); PG8_STAGE(PG8_SA(1, 1), a1 + hstep, voffA);
            PG8_WAIT_V(8); PG8_WAIT_L(0); PG8_BAR; PG8_MMA(0, 0, At, B0); PG8_MMA(0, 1, At, B1); PG8_BAR; PG8_SCHED;
            PG8_LDA(At, 0, 1); PG8_STAGE(PG8_SB(0, 0), b2, voffB); PG8_STAGE(PG8_SB(0, 1), b2 + hstep, voffB); PG8_STAGE(PG8_SA(0, 0), a2, voffA);
            PG8_WAIT_V(8); PG8_WAIT_L(0); PG8_BAR; PG8_MMA(1, 0, At, B0); PG8_MMA(1, 1, At, B1); PG8_BAR; PG8_SCHED;
            PG8_LDB(B0, 1, 0); PG8_LDB(B1, 1, 1); PG8_SCHED; PG8_LDA(At, 1, 0); PG8_STAGE(PG8_SA(0, 1), a2 + hstep, voffA);
            PG8_WAIT_V(8); PG8_WAIT_L(0); PG8_BAR; PG8_MMA(0, 0, At, B0); PG8_MMA(0, 1, At, B1); PG8_BAR; PG8_SCHED;
            PG8_LDA(At, 1, 1); PG8_STAGE(PG8_SB(1, 0), b3, voffB); PG8_STAGE(PG8_SB(1, 1), b3 + hstep, voffB); PG8_STAGE(PG8_SA(1, 0), a3, voffA);
            PG8_WAIT_V(8); PG8_WAIT_L(0); PG8_BAR; PG8_MMA(1, 0, At, B0); PG8_MMA(1, 1, At, B1); PG8_BAR; PG8_SCHED;
            } else {
            PG8_LDB(B0, 0, 0); PG8_SCHED; PG8_LDA(At, 0, 0); PG8_STAGE(PG8_SA(1, 1), a1 + hstep, voffA);
            PG8_WAIT_L(8); PG8_BAR; PG8_WAIT_L(0); PG8_MMA(0, 0, At, B0); PG8_BAR; PG8_SCHED;
            PG8_LDB(B1, 0, 1); PG8_STAGE(PG8_SB(0, 0), b2, voffB);
            PG8_BAR; PG8_WAIT_L(0); PG8_MMA(0, 1, At, B1); PG8_BAR;
            PG8_LDA(At, 0, 1); PG8_STAGE(PG8_SA(0, 0), a2, voffA);
            PG8_BAR; PG8_WAIT_L(0); PG8_MMA(1, 0, At, B0); PG8_BAR; PG8_SCHED;
            PG8_STAGE(PG8_SB(0, 1), b2 + hstep, voffB);
            PG8_WAIT_V(6); PG8_BAR; PG8_MMA(1, 1, At, B1); PG8_BAR;
            PG8_LDB(B0, 1, 0); PG8_SCHED; PG8_LDA(At, 1, 0); PG8_STAGE(PG8_SA(0, 1), a2 + hstep, voffA);
            PG8_WAIT_L(8); PG8_BAR; PG8_WAIT_L(0); PG8_MMA(0, 0, At, B0); PG8_BAR; PG8_SCHED;
            PG8_LDB(B1, 1, 1); PG8_STAGE(PG8_SB(1, 0), b3, voffB);
            PG8_BAR; PG8_WAIT_L(0); PG8_MMA(0, 1, At, B1); PG8_BAR;
            PG8_LDA(At, 1, 1); PG8_STAGE(PG8_SA(1, 0), a3, voffA);
            PG8_BAR; PG8_WAIT_L(0); PG8_MMA(1, 0, At, B0); PG8_BAR; PG8_SCHED;
            PG8_STAGE(PG8_SB(1, 1), b3 + hstep, voffB);
            PG8_WAIT_V(6); PG8_BAR; PG8_MMA(1, 1, At, B1); PG8_BAR;
            }
        }
        if constexpr (ALIGN_EPI) { if (wr == 0) PG8_BAR; }
        if constexpr (!Epi::AFTER_DRAIN) { E(acc, cur, wr, wc, fr, fq); S.done(cur); }
        if (!has_next) break;
#pragma unroll
        for (int a = 0; a < 2; ++a)
#pragma unroll
            for (int b = 0; b < 2; ++b)
#pragma unroll
                for (int m = 0; m < 4; ++m)
#pragma unroll
                    for (int n = 0; n < 2; ++n) acc[a][b][m][n] = (f32x4){0.f, 0.f, 0.f, 0.f};
        cur = nxt; cA = nA; cB = nB; ++ui;
        if constexpr (ALIGN_EPI) { if (wr == 1) PG8_BAR; }
    }
    PG8_WAIT_V(0);
    if constexpr (!ALIGN_EPI) { if (wr == 0) PG8_BAR; }
    PG8_BAR;
    if constexpr (Epi::AFTER_DRAIN) { E.fused(acc, cur, wr, wc, fr, fq, lds, wid, lane); S.done(cur); }
#undef PG8_SA
#undef PG8_SB
#undef PG8_STAGE
#undef PG8_LDA
#undef PG8_LDB
#undef PG8_MMA
#undef PG8_WAIT_V
#undef PG8_WAIT_L
#undef PG8_BAR
#undef PG8_SCHED
}
}
#define GAS __attribute__((address_space(1)))
#define LAS __attribute__((address_space(3)))
typedef unsigned short bf16;
typedef unsigned v4u __attribute__((ext_vector_type(4)));
typedef float f32x4 __attribute__((ext_vector_type(4)));
typedef short bf16x8 __attribute__((ext_vector_type(8)));
typedef GAS unsigned gu32;
typedef GAS unsigned long long gu64;
#define RLX_AGENT __ATOMIC_RELAXED, __HIP_MEMORY_SCOPE_AGENT
#define LDS_WAIT() asm volatile("s_waitcnt lgkmcnt(0)" ::: "memory")
#define VM_WAIT() asm volatile("s_waitcnt vmcnt(0)" ::: "memory")
__device__ __forceinline__ unsigned long long rt() { return __builtin_amdgcn_s_memrealtime(); }
__device__ __forceinline__ unsigned f2bf(float f) { unsigned u = __builtin_bit_cast(unsigned, f); return (u + 0x7fffu + ((u >> 16) & 1u)) >> 16; }
__device__ __forceinline__ unsigned pk2(float lo, float hi) { return f2bf(lo) | (f2bf(hi) << 16); }

#define XB_TMO      128
#define XB_XCNT(j)  (256  + 64 * (j))
#define XB_XSUB(j)  (1280 + 64 * (j))
#define XB_XGEN(j)  (2304 + 64 * (j))
#define XB_TOP      3328
#define XB_TOPGEN   3392
#define XCD_BAR_WORDS 3456
#define XB_SPIN_CAP (1u << 18)

__device__ __forceinline__ unsigned xb_ld(unsigned* p)              { return __hip_atomic_load(p, __ATOMIC_RELAXED, __HIP_MEMORY_SCOPE_AGENT); }
__device__ __forceinline__ unsigned xb_add(unsigned* p, unsigned v) { return __hip_atomic_fetch_add(p, v, __ATOMIC_RELAXED, __HIP_MEMORY_SCOPE_AGENT); }
__device__ __forceinline__ unsigned xb_xcc_id() { return (unsigned)__builtin_amdgcn_s_getreg((3 << 11) | 20) & 0xFu; }
#define XB_SPIN(cond, bar) do { unsigned _sp = 0; while (cond) { __builtin_amdgcn_s_sleep(1); \
    if ((++_sp & 255u) == 0u) { if (xb_ld(&(bar)[XB_TMO])) break; if (_sp > XB_SPIN_CAP) { atomicAdd(&(bar)[XB_TMO], 1u); break; } } } } while (0)

struct XcdBarrier {
    unsigned* bar; unsigned x;
    volatile LAS unsigned* st;
};

__device__ __forceinline__ XcdBarrier xcd_barrier_post(unsigned* bar, volatile LAS unsigned* st) {
    XcdBarrier b; b.bar = bar; b.x = xb_xcc_id(); b.st = st;
    if (threadIdx.x == 0) (void)xb_add(&bar[XB_XCNT(b.x)], 1u);
    return b;
}
__device__ __forceinline__ void xcd_barrier_complete(unsigned* bar, unsigned x, unsigned& nloc, unsigned& nx) {
    const unsigned G = gridDim.x * gridDim.y * gridDim.z;
    unsigned sum, cnt, mine, sp = 0u;
    for (;;) {
        sum = 0u; cnt = 0u; mine = 0u;
#pragma unroll
        for (unsigned j = 0; j < 16; ++j) { const unsigned c = xb_ld(&bar[XB_XCNT(j)]); sum += c; cnt += (c > 0u) ? 1u : 0u; mine = (j == x) ? c : mine; }
        if (sum == G) break;
        __builtin_amdgcn_s_sleep(1);
        if ((++sp & 255u) == 0u) { if (xb_ld(&bar[XB_TMO])) break; if (sp > XB_SPIN_CAP) { atomicAdd(&bar[XB_TMO], 1u); break; } }
    }
    nloc = mine > 0u ? mine : 1u; nx = cnt > 0u ? cnt : 1u;
}

__device__ __forceinline__ void xcd_barrier(const XcdBarrier& b) {
    asm volatile("s_waitcnt vmcnt(0)" ::: "memory");
    __syncthreads();
    if (threadIdx.x == 0) {
        unsigned* bar = b.bar;
        __builtin_amdgcn_s_waitcnt(0);
        unsigned nloc = b.st[0], nx = b.st[1];
        if (nloc == 0u) { xcd_barrier_complete(bar, b.x, nloc, nx); b.st[0] = nloc; b.st[1] = nx; }
        const unsigned old = xb_add(&bar[XB_XSUB(b.x)], 1u);
        const unsigned gen = old / nloc;
        if (old + 1u == (gen + 1u) * nloc) {
            __builtin_amdgcn_fence(__ATOMIC_RELEASE, "agent");
            asm volatile("s_waitcnt vmcnt(0)" ::: "memory");
            const unsigned og = xb_add(&bar[XB_TOP], 1u);
            const unsigned tg = og / nx;
            if (og + 1u == (tg + 1u) * nx) xb_add(&bar[XB_TOPGEN], 1u);
            else XB_SPIN(xb_ld(&bar[XB_TOPGEN]) == tg, bar);
            __builtin_amdgcn_fence(__ATOMIC_ACQUIRE, "agent");
            xb_add(&bar[XB_XGEN(b.x)], 1u);
            asm volatile("s_waitcnt vmcnt(0)" ::: "memory");
        } else {
            XB_SPIN(xb_ld(&bar[XB_XGEN(b.x)]) == gen, bar);
            __builtin_amdgcn_fence(__ATOMIC_ACQUIRE, "agent");
            asm volatile("s_waitcnt vmcnt(0)" ::: "memory");
        }
    }
    __syncthreads();
}


constexpr size_t MiB = 1u << 20;
constexpr size_t WS_CTL = 0, CTL_ZERO_BYTES = 1 * MiB;
constexpr size_t WS_BIAS = 1 * MiB, WS_LAM = 1 * MiB + 4096, WS_RMEM = 1 * MiB + 8192, WS_R0 = 1 * MiB + 65536;
constexpr size_t WS_SS1 = 2 * MiB, WS_SS2 = 4 * MiB, WS_SS3 = 6 * MiB;
constexpr size_t WS_WIN = 8 * MiB, WS_WOUT = 14 * MiB, WS_WCQ = 16 * MiB, WS_WCKV = 18 * MiB, WS_WCO = 22 * MiB, WS_WUP = 24 * MiB, WS_WDOWN = 36 * MiB;
constexpr size_t WS_MEMB = 42 * MiB, WS_MKB = 44 * MiB, WS_MVB = 46 * MiB;
constexpr size_t WS_XB = 48 * MiB, WS_ZCONV = 82 * MiB, WS_QB = 132 * MiB, WS_KB = 149 * MiB, WS_VB = 166 * MiB, WS_MIX = 184 * MiB;
constexpr size_t WS_X1 = 218 * MiB, WS_X1B = 284 * MiB, WS_QC = 317 * MiB, WS_OC = 350 * MiB, WS_X2 = 383 * MiB, WS_X2B = 449 * MiB;
constexpr size_t WS_UPB = 482 * MiB, WS_ACT = 661 * MiB, WS_X3 = 751 * MiB, WS_DPART = 817 * MiB, WS_END = 826 * MiB;
constexpr size_t WS_SSS1 = 1 * MiB + 256 * 1024, WS_SSS2 = WS_SSS1 + 32768, WS_SSS3 = WS_SSS2 + 32768;
constexpr int CW_BAR = 4096;
constexpr int DP_STRIDE = 132;

constexpr int RING_OFF = 0, RING_BYTES = 131072;
constexpr int LDSCTL_OFF = RING_BYTES, MISC_OFF = LDSCTL_OFF + 320;
constexpr int LDS_BYTES = 147456;
constexpr int NWAVES = 8;

__device__ __forceinline__ float wave_sum(float v) {
#pragma unroll
    for (int o = 1; o < 64; o <<= 1) v += __shfl_xor(v, o);
    return v;
}
__device__ __forceinline__ float wave_max(float v) {
#pragma unroll
    for (int o = 1; o < 64; o <<= 1) v = fmaxf(v, __shfl_xor(v, o));
    return v;
}
__device__ __forceinline__ float bf_lo(unsigned w) { return __uint_as_float(w << 16); }
__device__ __forceinline__ float bf_hi(unsigned w) { return __uint_as_float(w & 0xffff0000u); }
__device__ __forceinline__ void unpack8(const v4u w, float (&f)[8]) { f[0] = bf_lo(w.x); f[1] = bf_hi(w.x); f[2] = bf_lo(w.y); f[3] = bf_hi(w.y); f[4] = bf_lo(w.z); f[5] = bf_hi(w.z); f[6] = bf_lo(w.w); f[7] = bf_hi(w.w); }
__device__ __forceinline__ v4u pack8f(const float (&f)[8]) { v4u o; o.x = pk2(f[0], f[1]); o.y = pk2(f[2], f[3]); o.z = pk2(f[4], f[5]); o.w = pk2(f[6], f[7]); return o; }
template <int CTRL> __device__ __forceinline__ float dppf(float x) { return __int_as_float(__builtin_amdgcn_update_dpp(0, __float_as_int(x), CTRL, 0xF, 0xF, true)); }
__device__ __forceinline__ float ex2(float x) { return __builtin_amdgcn_exp2f(x); }
__device__ __forceinline__ int t5_bucket(int n) {
    if (n < 16) return n;
    const int b = 16 + (int)(__log2f((float)n * 0.0625f) * (16.0f / 3.0f));
    return b < 31 ? b : 31;
}

__device__ __host__ __forceinline__ int up_orig(int np) { const int t = np >> 8, j = np & 255; return j < 128 ? 128 * t + j : DFF + 128 * t + (j - 128); }
template <bool UPPERM = false> __device__ __forceinline__ void transpose_item(const float* W, int K, int N, bf16* WT, const float* ksc, LAS float* scr, int item, int lane) {
    const int nblk = N / 32, kb = item / nblk, nb = item % nblk, k0 = 64 * kb, n0 = 32 * nb; const int ns0 = UPPERM ? up_orig(n0) : n0;
#pragma unroll 8
    for (int i = 0; i < 32; ++i) { const int kk = 2 * i + (lane >> 5); const float sc = ksc ? ksc[k0 + kk] : 1.0f; scr[kk * 33 + (lane & 31)] = W[(size_t)(k0 + kk) * N + ns0 + (lane & 31)] * sc; }
    LDS_WAIT(); asm volatile("" ::: "memory");
    const int c = lane & 7;
#pragma unroll
    for (int j = 0; j < 4; ++j) { const int n = (lane >> 3) + 8 * j; const LAS float* s = scr + (8 * c) * 33 + n;
        v4u o; o.x = pk2(s[0 * 33], s[1 * 33]); o.y = pk2(s[2 * 33], s[3 * 33]); o.z = pk2(s[4 * 33], s[5 * 33]); o.w = pk2(s[6 * 33], s[7 * 33]);
        *(GAS v4u*)(WT + (size_t)(n0 + n) * K + k0 + 8 * c) = o; }
    LDS_WAIT(); asm volatile("" ::: "memory");
}
__device__ __forceinline__ void rms_row(const float* xrow, bf16* orow, float* rout, int lane) {
    const GAS f32x4* xr = (const GAS f32x4*)xrow + lane;
    f32x4 v[4]; float s = 0.f;
#pragma unroll
    for (int j = 0; j < 4; ++j) { v[j] = xr[64 * j]; s += (v[j].x * v[j].x + v[j].y * v[j].y) + (v[j].z * v[j].z + v[j].w * v[j].w); }
    s = wave_sum(s);
    if (lane == 0) *rout = 1.0f / sqrtf(s * (1.0f / 1024.0f) + EPS);
    GAS unsigned long long* o8 = (GAS unsigned long long*)orow + lane;
#pragma unroll
    for (int j = 0; j < 4; ++j) o8[64 * j] = (unsigned long long)pk2(v[j].x, v[j].y) | ((unsigned long long)pk2(v[j].z, v[j].w) << 32);
}
struct Ptrs {
    const float* in[32]; float* out; unsigned char* ws;
};
#define WSP(T, off) ((T*)(P.ws + (off)))

__device__ __forceinline__ void p0_prologue(const Ptrs& P, LAS unsigned char* lds, int wave, int lane, int G) {
    LAS float* scr = (LAS float*)(lds + RING_OFF + wave * 16384);
    const int gw = blockIdx.x * NWAVES + wave, NGW = G * NWAVES;
    constexpr int I_IN = 16 * 96, I_OUT = 16 * 32, I_CQ = 16 * 32, I_CKV = 16 * 64, I_CO = 16 * 32, I_UP = 16 * 176, I_DOWN = 44 * 32;
    constexpr int NITEMS = I_IN + I_OUT + I_CQ + I_CKV + I_CO + I_UP + I_DOWN;
    for (int it = gw; it < NITEMS; it += NGW) {
        int r = it;
        if (r < I_IN) { transpose_item(P.in[12], 1024, 3072, WSP(bf16, WS_WIN), P.in[11], scr, r, lane); continue; } r -= I_IN;
        if (r < I_OUT) { transpose_item(P.in[20], 1024, 1024, WSP(bf16, WS_WOUT), nullptr, scr, r, lane); continue; } r -= I_OUT;
        if (r < I_CQ) { transpose_item(P.in[23], 1024, 1024, WSP(bf16, WS_WCQ), P.in[21], scr, r, lane); continue; } r -= I_CQ;
        if (r < I_CKV) { transpose_item(P.in[24], 1024, 2048, WSP(bf16, WS_WCKV), P.in[22], scr, r, lane); continue; } r -= I_CKV;
        if (r < I_CO) { transpose_item(P.in[25], 1024, 1024, WSP(bf16, WS_WCO), nullptr, scr, r, lane); continue; } r -= I_CO;
        if (r < I_UP) { transpose_item<true>(P.in[27], 1024, 5632, WSP(bf16, WS_WUP), P.in[26], scr, r, lane); continue; } r -= I_UP;
        transpose_item(P.in[30], 2816, 1024, WSP(bf16, WS_WDOWN), nullptr, scr, r, lane);
    }
    bf16* xb = WSP(bf16, WS_XB); float* r0 = WSP(float, WS_R0);
    for (int m = gw; m < MT; m += NGW) {
        if (m < MREAL) { const float* src = m < MP ? P.in[0] + (size_t)m * DM : P.in[1] + (size_t)(m - MP) * DM; rms_row(src, xb + (size_t)m * DM, r0 + m, lane); }
        else { GAS unsigned long long* o8 = (GAS unsigned long long*)(xb + (size_t)m * DM) + lane;
#pragma unroll
            for (int j = 0; j < 4; ++j) o8[64 * j] = 0ull;
            if (lane == 0) r0[m] = 0.f; }
    }
    bf16* memb = WSP(bf16, WS_MEMB); float* rmem = WSP(float, WS_RMEM);
    for (int m = gw; m < NB * NMEM; m += NGW) rms_row(P.in[2] + (size_t)m * DM, memb + (size_t)m * DM, rmem + m, lane);
    if (blockIdx.x == 0) {
        float* bt = WSP(float, WS_BIAS);
        for (int idx = threadIdx.x; idx < 4 * DP_STRIDE; idx += NWAVES * 64) { const int h = idx / DP_STRIDE, n = idx % DP_STRIDE; const int bk = n < 128 ? t5_bucket(n) : 31; bt[idx] = P.in[10][bk * 4 + h] * LOG2E; }
        if (wave == 0) { const float a = wave_sum(P.in[15][lane] * P.in[16][lane]), b = wave_sum(P.in[17][lane] * P.in[18][lane]);
            if (lane == 0) *WSP(float, WS_LAM) = expf(a) - expf(b) + LAM_INIT; }
    }
}

__device__ __forceinline__ void p_convmix(const Ptrs& P, int wave, int lane, int G) {
    const int gw = blockIdx.x * NWAVES + wave, NGW = G * NWAVES;
    const bf16* zc = WSP(const bf16, WS_ZCONV); bf16* mix = WSP(bf16, WS_MIX);
    const int ch = lane * 8;
    float w0[8], w1[8], w2[8], bb[8];
#pragma unroll
    for (int i = 0; i < 8; ++i) { w0[i] = P.in[13][ch + i]; w1[i] = P.in[13][512 + ch + i]; w2[i] = P.in[13][1024 + ch + i]; bb[i] = P.in[14][ch + i]; }
    constexpr int NPI = MP / 16;
    for (int it = gw; it < NPI + DB; it += NGW) {
        float p2[8], p1[8];
        int row0, nrow, t0, bidx; const bool prompt = it < NPI;
        if (prompt) { row0 = it * 16; nrow = 16; t0 = row0 % SEQ; bidx = row0 / SEQ;
            if (t0 == 0) {
#pragma unroll
                for (int i = 0; i < 8; ++i) { p2[i] = 0.f; p1[i] = 0.f; } }
            else { float c[8], u[8];
                unpack8(*(const GAS v4u*)(zc + (size_t)(row0 - 2) * 1536 + 512 + ch), c); unpack8(*(const GAS v4u*)(zc + (size_t)(row0 - 2) * 1536 + 1024 + ch), u);
#pragma unroll
                for (int i = 0; i < 8; ++i) p2[i] = c[i] * u[i];
                unpack8(*(const GAS v4u*)(zc + (size_t)(row0 - 1) * 1536 + 512 + ch), c); unpack8(*(const GAS v4u*)(zc + (size_t)(row0 - 1) * 1536 + 1024 + ch), u);
#pragma unroll
                for (int i = 0; i < 8; ++i) p1[i] = c[i] * u[i]; } }
        else { bidx = it - NPI; row0 = MP + bidx * DS; nrow = DS; t0 = 0;
            const float* st = P.in[6] + (size_t)bidx * 2 * DCONV;
#pragma unroll
            for (int i = 0; i < 8; ++i) { p2[i] = st[ch + i]; p1[i] = st[DCONV + ch + i]; } }
        for (int r = 0; r < nrow; ++r) {
            const size_t row = (size_t)(row0 + r);
            float bv[8], c[8], u[8], pre[8], y[8];
            unpack8(*(const GAS v4u*)(zc + row * 1536 + ch), bv); unpack8(*(const GAS v4u*)(zc + row * 1536 + 512 + ch), c); unpack8(*(const GAS v4u*)(zc + row * 1536 + 1024 + ch), u);
#pragma unroll
            for (int i = 0; i < 8; ++i) { pre[i] = c[i] * u[i]; y[i] = bv[i] * (bb[i] + w0[i] * p2[i] + w1[i] * p1[i] + w2[i] * pre[i]); }
            *(GAS v4u*)(mix + row * 1024 + ch) = pack8f(y);
            const int t = t0 + r;
            if (prompt) { if (t >= SEQ - 2) { float* o = P.out + O_CMP + (size_t)(bidx * 2 + (t - (SEQ - 2))) * DCONV + ch; *(f32x4*)o = (f32x4){pre[0], pre[1], pre[2], pre[3]}; *(f32x4*)(o + 4) = (f32x4){pre[4], pre[5], pre[6], pre[7]}; } }
            else { if (t >= DS - 2) { float* o = P.out + O_CMS + (size_t)(bidx * 2 + (t - (DS - 2))) * DCONV + ch; *(f32x4*)o = (f32x4){pre[0], pre[1], pre[2], pre[3]}; *(f32x4*)(o + 4) = (f32x4){pre[4], pre[5], pre[6], pre[7]}; } }
#pragma unroll
            for (int i = 0; i < 8; ++i) { p2[i] = p1[i]; p1[i] = pre[i]; }
        }
    }
}

__device__ __forceinline__ void p_convffn(const Ptrs& P, int wave, int lane, int G) {
    const int gw = blockIdx.x * NWAVES + wave, NGW = G * NWAVES;
    const bf16* up = WSP(const bf16, WS_UPB); bf16* act = WSP(bf16, WS_ACT);
    constexpr int NPI = MP / 16, NCH = 6;
    for (int it = NPI * NCH + gw; it < (NPI + DB) * NCH; it += NGW) {
        const int rb = it / NCH, cc = it % NCH; const int cg = cc * 64 + lane;
        if (cg < DFF / 8) {
            const int ch = cg * 8;
            float wg0[8], wg1[8], wg2[8], bg[8], wu0[8], wu1[8], wu2[8], bu[8];
#pragma unroll
            for (int i = 0; i < 8; ++i) { wg0[i] = P.in[28][ch + i]; wg1[i] = P.in[28][DUP + ch + i]; wg2[i] = P.in[28][2 * DUP + ch + i]; bg[i] = P.in[29][ch + i];
                wu0[i] = P.in[28][DFF + ch + i]; wu1[i] = P.in[28][DUP + DFF + ch + i]; wu2[i] = P.in[28][2 * DUP + DFF + ch + i]; bu[i] = P.in[29][DFF + ch + i]; }
            float g2[8], g1[8], u2[8], u1[8];
            int row0, nrow, t0, bidx; const bool prompt = rb < NPI;
            if (prompt) { row0 = rb * 16; nrow = 16; t0 = row0 % SEQ; bidx = row0 / SEQ;
                if (t0 == 0) {
#pragma unroll
                    for (int i = 0; i < 8; ++i) { g2[i] = 0.f; g1[i] = 0.f; u2[i] = 0.f; u1[i] = 0.f; } }
                else { unpack8(*(const GAS v4u*)(up + (size_t)(row0 - 2) * DUP + ch), g2); unpack8(*(const GAS v4u*)(up + (size_t)(row0 - 2) * DUP + DFF + ch), u2);
                    unpack8(*(const GAS v4u*)(up + (size_t)(row0 - 1) * DUP + ch), g1); unpack8(*(const GAS v4u*)(up + (size_t)(row0 - 1) * DUP + DFF + ch), u1); } }
            else { bidx = rb - NPI; row0 = MP + bidx * DS; nrow = DS; t0 = 0;
                const float* st = P.in[7] + (size_t)bidx * 2 * DUP;
#pragma unroll
                for (int i = 0; i < 8; ++i) { g2[i] = st[ch + i]; u2[i] = st[DFF + ch + i]; g1[i] = st[DUP + ch + i]; u1[i] = st[DUP + DFF + ch + i]; } }
            for (int r = 0; r < nrow; ++r) {
                const size_t row = (size_t)(row0 + r);
                float g0[8], u0[8], a[8];
                unpack8(*(const GAS v4u*)(up + row * DUP + ch), g0); unpack8(*(const GAS v4u*)(up + row * DUP + DFF + ch), u0);
#pragma unroll
                for (int i = 0; i < 8; ++i) { const float gc = bg[i] + wg0[i] * g2[i] + wg1[i] * g1[i] + wg2[i] * g0[i]; const float uc = bu[i] + wu0[i] * u2[i] + wu1[i] * u1[i] + wu2[i] * u0[i];
                    a[i] = gc / (1.0f + __expf(-gc)) * uc; }
                *(GAS v4u*)(act + row * DFF + ch) = pack8f(a);
                const int t = t0 + r; const int tl = prompt ? SEQ - 2 : DS - 2;
                if (t >= tl) { float* o = P.out + (prompt ? O_CFP : O_CFS) + (size_t)(bidx * 2 + (t - tl)) * DUP + ch;
                    *(f32x4*)o = (f32x4){g0[0], g0[1], g0[2], g0[3]}; *(f32x4*)(o + 4) = (f32x4){g0[4], g0[5], g0[6], g0[7]};
                    *(f32x4*)(o + DFF) = (f32x4){u0[0], u0[1], u0[2], u0[3]}; *(f32x4*)(o + DFF + 4) = (f32x4){u0[4], u0[5], u0[6], u0[7]}; }
#pragma unroll
                for (int i = 0; i < 8; ++i) { g2[i] = g1[i]; g1[i] = g0[i]; u2[i] = u1[i]; u1[i] = u0[i]; }
            }
        }
    }
}

__device__ __forceinline__ void p_final(const Ptrs& P, int wave, int lane, int G) {
    const int gw = blockIdx.x * NWAVES + wave, NGW = G * NWAVES;
    const float* x3 = WSP(const float, WS_X3); const float* ss = WSP(const float, WS_SS3); const float* w = P.in[31];
    f32x4 wv[4];
#pragma unroll
    for (int j = 0; j < 4; ++j) wv[j] = *((const f32x4*)w + lane + 64 * j);
    for (int m = gw; m < MREAL; m += NGW) {
        const float tot = m < MP ? wave_sum(lane < 16 ? ss[(size_t)m * 16 + lane] : 0.f) : wave_sum(WSP(const float, WS_SSS3)[(size_t)(m - MP) * 64 + lane]);
        const float rs = 1.0f / sqrtf(tot * (1.0f / 1024.0f) + EPS);
        const GAS f32x4* xr = (const GAS f32x4*)(x3 + (size_t)m * DM) + lane;
        GAS f32x4* o = (GAS f32x4*)(P.out + (m < MP ? O_Y + (size_t)m * DM : O_YS + (size_t)(m - MP) * DM)) + lane;
#pragma unroll
        for (int j = 0; j < 4; ++j) o[64 * j] = xr[64 * j] * rs * wv[j];
    }
}

__device__ __forceinline__ void p_dattn_naive(const Ptrs& P, LAS unsigned char* lds, int wave, int lane, int G) {
    const int gw = blockIdx.x * NWAVES + wave, NGW = G * NWAVES;
    const bf16* qb = WSP(const bf16, WS_QB); const bf16* kb = WSP(const bf16, WS_KB); const bf16* vb = WSP(const bf16, WS_VB); bf16* mix = WSP(bf16, WS_MIX);
    const float* bt = WSP(const float, WS_BIAS); const float lam = *WSP(const float, WS_LAM);
    LAS float* qs = (LAS float*)(lds + wave * 1024); LAS float* ps = qs + 128;
    for (int it = gw; it < MP * NH; it += NGW) {
        const int m = it >> 2, h = it & 3, b = m / SEQ, t = m % SEQ;
        { const unsigned w = *(const GAS unsigned*)(qb + (size_t)m * 512 + h * 128 + 2 * lane); qs[2 * lane] = bf_lo(w); qs[2 * lane + 1] = bf_hi(w); }
        LDS_WAIT(); asm volatile("" ::: "memory");
        float m1 = -1e30f, m2 = -1e30f, l1 = 0.f, l2 = 0.f, o1x = 0.f, o1y = 0.f, o2x = 0.f, o2y = 0.f;
        for (int k0 = 0; k0 <= t; k0 += 64) {
            const int key = k0 + lane; const bool valid = key <= t; const int kc = valid ? key : t;
            const bf16* kr = kb + (size_t)(b * SEQ + kc) * 512 + h * 128;
            float s1 = 0.f, s2 = 0.f;
#pragma unroll
            for (int c = 0; c < 16; ++c) { float kf[8]; unpack8(*(const GAS v4u*)(kr + c * 8), kf);
#pragma unroll
                for (int i = 0; i < 8; ++i) { if (c < 8) s1 += kf[i] * qs[c * 8 + i]; else s2 += kf[i] * qs[c * 8 + i]; } }
            const int rel = t - kc; const float bias = bt[h * DP_STRIDE + (rel < 128 ? rel : 128)];
            s1 = valid ? s1 + bias : -1e30f; s2 = valid ? s2 + bias : -1e30f;
            const float mn1 = fmaxf(m1, wave_max(s1)), mn2 = fmaxf(m2, wave_max(s2));
            const float a1 = ex2(m1 - mn1), a2 = ex2(m2 - mn2);
            const float p1 = valid ? ex2(s1 - mn1) : 0.f, p2 = valid ? ex2(s2 - mn2) : 0.f;
            l1 = l1 * a1 + wave_sum(p1); l2 = l2 * a2 + wave_sum(p2); m1 = mn1; m2 = mn2;
            o1x *= a1; o1y *= a1; o2x *= a2; o2y *= a2;
            ps[lane] = p1; ps[64 + lane] = p2;
            LDS_WAIT(); asm volatile("" ::: "memory");
            const int nk = (t - k0 + 1) < 64 ? (t - k0 + 1) : 64;
            const bf16* vr = vb + (size_t)(b * SEQ + k0) * 512 + h * 128 + 2 * lane;
            for (int kk = 0; kk < nk; ++kk) { const float pa = ps[kk], pb = ps[64 + kk]; const unsigned w = *(const GAS unsigned*)(vr + (size_t)kk * 512); const float vx = bf_lo(w), vy = bf_hi(w);
                o1x += pa * vx; o1y += pa * vy; o2x += pb * vx; o2y += pb * vy; }
            LDS_WAIT(); asm volatile("" ::: "memory");
        }
        const float ax = o1x / l1 - lam * (o2x / l2), ay = o1y / l1 - lam * (o2y / l2);
        const float ssq = wave_sum(ax * ax + ay * ay);
        const float rn = (1.0f - LAM_INIT) / sqrtf(ssq * (1.0f / 128.0f) + EPS);
        const float wx = P.in[19][2 * lane], wy = P.in[19][2 * lane + 1];
        *(GAS unsigned*)(mix + (size_t)m * 1024 + 512 + h * 128 + 2 * lane) = pk2(ax * rn * wx, ay * rn * wy);
    }
}

template <bool SAMPLE> __device__ __forceinline__ void p_xattn_naive(const Ptrs& P, LAS unsigned char* lds, int wave, int lane, int G) {
    const int gw = blockIdx.x * NWAVES + wave, NGW = G * NWAVES;
    const bf16* qc = WSP(const bf16, WS_QC); bf16* oc = WSP(bf16, WS_OC);
    const bf16* mkb = WSP(const bf16, WS_MKB); const bf16* mvb = WSP(const bf16, WS_MVB);
    LAS float* qs = (LAS float*)(lds + wave * 2048); LAS float* ps = qs + 256;
    const int nit = (SAMPLE ? MS : MP) * MHEADS;
    for (int it = gw; it < nit; it += NGW) {
        const int mr = it >> 2, h = it & 3; const int m = SAMPLE ? MP + mr : mr; const int b = SAMPLE ? mr / DS : mr / SEQ;
        { const unsigned long long w = *(const GAS unsigned long long*)(qc + (size_t)m * 1024 + h * 256 + 4 * lane);
          qs[4 * lane] = bf_lo((unsigned)w); qs[4 * lane + 1] = bf_hi((unsigned)w); qs[4 * lane + 2] = bf_lo((unsigned)(w >> 32)); qs[4 * lane + 3] = bf_hi((unsigned)(w >> 32)); }
        LDS_WAIT(); asm volatile("" ::: "memory");
        float s[4];
#pragma unroll
        for (int c = 0; c < 4; ++c) {
            const int key = c * 64 + lane; float acc = 0.f;
            if (SAMPLE) { const float* kr = P.in[8] + ((size_t)(b * NMEM + key) * MHEADS + h) * MDH;
#pragma unroll 8
                for (int d = 0; d < 64; ++d) { const f32x4 kv = *(const GAS f32x4*)(kr + 4 * d); acc += kv.x * qs[4 * d] + kv.y * qs[4 * d + 1] + kv.z * qs[4 * d + 2] + kv.w * qs[4 * d + 3]; } }
            else { const bf16* kr = mkb + (size_t)(b * NMEM + key) * 1024 + h * 256;
#pragma unroll 8
                for (int d = 0; d < 32; ++d) { float kf[8]; unpack8(*(const GAS v4u*)(kr + 8 * d), kf);
#pragma unroll
                    for (int i = 0; i < 8; ++i) acc += kf[i] * qs[8 * d + i]; } }
            s[c] = acc;
        }
        const float mx = wave_max(fmaxf(fmaxf(s[0], s[1]), fmaxf(s[2], s[3])));
        float lsum = 0.f;
#pragma unroll
        for (int c = 0; c < 4; ++c) { const float p = ex2(s[c] - mx); ps[c * 64 + lane] = p; lsum += p; }
        lsum = wave_sum(lsum);
        LDS_WAIT(); asm volatile("" ::: "memory");
        float o[4] = {0.f, 0.f, 0.f, 0.f};
        for (int key = 0; key < NMEM; ++key) {
            const float p = ps[key];
            if (SAMPLE) { const f32x4 v = *(const GAS f32x4*)(P.in[9] + ((size_t)(b * NMEM + key) * MHEADS + h) * MDH + 4 * lane); o[0] += p * v.x; o[1] += p * v.y; o[2] += p * v.z; o[3] += p * v.w; }
            else { const unsigned long long w = *(const GAS unsigned long long*)(mvb + (size_t)(b * NMEM + key) * 1024 + h * 256 + 4 * lane);
                o[0] += p * bf_lo((unsigned)w); o[1] += p * bf_hi((unsigned)w); o[2] += p * bf_lo((unsigned)(w >> 32)); o[3] += p * bf_hi((unsigned)(w >> 32)); }
        }
        const float il = 1.0f / lsum;
        *(GAS unsigned long long*)(oc + (size_t)m * 1024 + h * 256 + 4 * lane) = (unsigned long long)pk2(o[0] * il, o[1] * il) | ((unsigned long long)pk2(o[2] * il, o[3] * il) << 32);
        LDS_WAIT(); asm volatile("" ::: "memory");
    }
}

template <int U> __device__ __forceinline__ void dec_step(const f32x4* K, const f32x4* V, const float (&qv)[4][4], float (&mm)[4], float (&ll)[4], float (&accA)[4][4], float (&accB)[4][4],
                                         const bool nearb, const float b31, const float* bth, const int relb) {
    float s[U][4];
#pragma unroll
    for (int u = 0; u < U; ++u)
#pragma unroll
        for (int t = 0; t < 4; ++t) s[u][t] = K[u].x * qv[t][0] + K[u].y * qv[t][1] + K[u].z * qv[t][2] + K[u].w * qv[t][3];
#pragma unroll
    for (int u = 0; u < U; ++u)
#pragma unroll
        for (int t = 0; t < 4; ++t) s[u][t] += dppf<0xB1>(s[u][t]);
#pragma unroll
    for (int u = 0; u < U; ++u)
#pragma unroll
        for (int t = 0; t < 4; ++t) s[u][t] += dppf<0x4E>(s[u][t]);
#pragma unroll
    for (int u = 0; u < U; ++u)
#pragma unroll
        for (int t = 0; t < 4; ++t) s[u][t] += dppf<0x141>(s[u][t]);
#pragma unroll
    for (int u = 0; u < U; ++u)
#pragma unroll
        for (int t = 0; t < 4; ++t) s[u][t] += dppf<0x140>(s[u][t]);
    if (!nearb) {
#pragma unroll
        for (int u = 0; u < U; ++u)
#pragma unroll
            for (int t = 0; t < 4; ++t) s[u][t] += b31;
    } else {
#pragma unroll
        for (int u = 0; u < U; ++u)
#pragma unroll
            for (int t = 0; t < 4; ++t) { const int rel = relb - 2 * u + t; s[u][t] += bth[rel < 128 ? rel : 128]; }
    }
    float mx[4]; bool grow = false;
#pragma unroll
    for (int t = 0; t < 4; ++t) { mx[t] = s[0][t];
#pragma unroll
        for (int u = 1; u < U; ++u) mx[t] = fmaxf(mx[t], s[u][t]);
        grow = grow || (mx[t] > mm[t] + 8.0f); }
    if (__any(grow)) {
#pragma unroll
        for (int t = 0; t < 4; ++t) { const float mn = fmaxf(mm[t], mx[t]); const float al = ex2(mm[t] - mn); const float alo = __shfl_xor(al, 16); ll[t] *= al; mm[t] = mn;
#pragma unroll
            for (int d = 0; d < 4; ++d) { accA[t][d] *= al; accB[t][d] *= alo; } }
    }
    float p[U][4], po[U][4];
#pragma unroll
    for (int u = 0; u < U; ++u)
#pragma unroll
        for (int t = 0; t < 4; ++t) p[u][t] = ex2(s[u][t] - mm[t]);
#pragma unroll
    for (int u = 0; u < U; ++u)
#pragma unroll
        for (int t = 0; t < 4; ++t) po[u][t] = __shfl_xor(p[u][t], 16);
#pragma unroll
    for (int u = 0; u < U; ++u)
#pragma unroll
        for (int t = 0; t < 4; ++t) { ll[t] += p[u][t];
            accA[t][0] += p[u][t] * V[u].x; accA[t][1] += p[u][t] * V[u].y; accA[t][2] += p[u][t] * V[u].z; accA[t][3] += p[u][t] * V[u].w;
            accB[t][0] += po[u][t] * V[u].x; accB[t][1] += po[u][t] * V[u].y; accB[t][2] += po[u][t] * V[u].z; accB[t][3] += po[u][t] * V[u].w; }
}
constexpr int DEC_U = 4, DEC_R = 8;
template <int MODE> __device__ __forceinline__ void p_decode_split(const Ptrs& P, int wave, int lane, int G) {
    const int gw = blockIdx.x * NWAVES + wave, NGW = G * NWAVES;
    const bf16* qb = WSP(const bf16, WS_QB); const float* bt = WSP(const float, WS_BIAS); float* dpart = MODE == 0 ? WSP(float, WS_DPART) : WSP(float, WS_END + 16 * MiB);
    const float* ck = P.in[3]; const float* cv = P.in[4]; const int* ptab = (const int*)P.in[5];
    const int kq = lane >> 5, l32 = lane & 31, mp = (lane >> 4) & 1, off = 4 * l32;
    for (int it = gw; it < DB * NH * 16; it += NGW) {
        const int bh = it >> 4, chunk = it & 15, bs = bh >> 2, h = bh & 3;
        float qv[4][4];
#pragma unroll
        for (int t = 0; t < 4; ++t) { const unsigned long long w = *(const GAS unsigned long long*)(qb + (size_t)(MP + bs * DS + t) * 512 + h * 128 + off);
            qv[t][0] = bf_lo((unsigned)w); qv[t][1] = bf_hi((unsigned)w); qv[t][2] = bf_lo((unsigned)(w >> 32)); qv[t][3] = bf_hi((unsigned)(w >> 32)); }
        const float* bth = bt + h * DP_STRIDE; const float b31 = bth[128];
        const int j0 = chunk * 512;
        float mm[4], ll[4], accA[4][4], accB[4][4];
#pragma unroll
        for (int t = 0; t < 4; ++t) { mm[t] = -1e30f; ll[t] = 0.f;
#pragma unroll
            for (int d = 0; d < 4; ++d) { accA[t][d] = 0.f; accB[t][d] = 0.f; } }
        f32x4 Kb[DEC_R], Vb[DEC_R];
        const int pgv = ptab[bs * NPAGES + chunk * 4 + (lane & 3)];
        const int pg0 = __builtin_amdgcn_readlane(pgv, 0), pg1 = MODE == 2 ? pg0 : __builtin_amdgcn_readlane(pgv, 1), pg2 = MODE == 2 ? pg0 : __builtin_amdgcn_readlane(pgv, 2), pg3 = MODE == 2 ? pg0 : __builtin_amdgcn_readlane(pgv, 3);
#define DEC_PG(k_) ((k_) == 0 ? pg0 : (k_) == 1 ? pg1 : (k_) == 2 ? pg2 : pg3)
#define DEC_CBASE(c_) ((((size_t)DEC_PG((2 * DEC_R * (c_)) >> 7) * PAGE + (MODE == 2 ? 0 : ((2 * DEC_R * (c_)) & 127)) + kq) * NH + h) * 128 + off)
        { const size_t gb = DEC_CBASE(0);
#pragma unroll
          for (int j = 0; j < DEC_R; ++j) { Kb[j] = *(const GAS f32x4*)(ck + gb + (size_t)j * 1024); Vb[j] = *(const GAS f32x4*)(cv + gb + (size_t)j * 1024); } }
        constexpr int NCYC = 256 / DEC_R;
        for (int c = 0; c < NCYC; ++c) {
            const bool more = c + 1 < NCYC;
            const size_t gn = more ? DEC_CBASE(c + 1) : 0;
            const bool nearb = (j0 + 2 * DEC_R * c + 2 * DEC_R - 1 + 128 > PAST);
            const int relg = PAST - (j0 + 2 * DEC_R * c + kq);
#pragma unroll
            for (int j = 0; j < DEC_R; j += DEC_U) {
                if (MODE == 1) {
#pragma unroll
                    for (int u = 0; u < DEC_U; ++u) { accA[0][0] += Kb[j + u].x + Vb[j + u].x; accA[0][1] += Kb[j + u].y + Vb[j + u].y; accA[0][2] += Kb[j + u].z + Vb[j + u].z; accA[0][3] += Kb[j + u].w + Vb[j + u].w; } }
                else dec_step<DEC_U>(&Kb[j], &Vb[j], qv, mm, ll, accA, accB, nearb, b31, bth, relg - 2 * j);
                if (more) {
#pragma unroll
                    for (int u = 0; u < DEC_U; ++u) { Kb[j + u] = *(const GAS f32x4*)(ck + gn + (size_t)(j + u) * 1024); Vb[j + u] = *(const GAS f32x4*)(cv + gn + (size_t)(j + u) * 1024); } }
            }
        }
#undef DEC_CBASE
#undef DEC_PG
        float Mx[4];
#pragma unroll
        for (int t = 0; t < 4; ++t) { const float M = fmaxf(mm[t], __shfl_xor(mm[t], 32)); const float f = ex2(mm[t] - M); Mx[t] = M; const float fo = __shfl_xor(f, 16);
            float l = ll[t] * f; l += __shfl_xor(l, 32); ll[t] = l;
#pragma unroll
            for (int d = 0; d < 4; ++d) { float a = accA[t][d] * f; a += __shfl_xor(a, 32); accA[t][d] = a; float bq = accB[t][d] * fo; bq += __shfl_xor(bq, 32); accB[t][d] = bq; } }
        if (kq == 0) {
#pragma unroll
            for (int t = 0; t < 4; ++t) {
                float* pa = dpart + ((size_t)it * 8 + mp * 4 + t) * DP_STRIDE; float* pb = dpart + ((size_t)it * 8 + (1 - mp) * 4 + t) * DP_STRIDE;
                *(f32x4*)(pa + off) = (f32x4){accA[t][0], accA[t][1], accA[t][2], accA[t][3]};
                *(f32x4*)(pb + off) = (f32x4){accB[t][0], accB[t][1], accB[t][2], accB[t][3]};
                if ((lane & 15) == 0) { pa[128] = Mx[t]; pa[129] = ll[t]; }
            }
        }
    }
}
__device__ __forceinline__ void p_decode_combine(const Ptrs& P, int wave, int lane, int G) {
    const int gw = blockIdx.x * NWAVES + wave, NGW = G * NWAVES;
    const bf16* qb = WSP(const bf16, WS_QB); const float* bt = WSP(const float, WS_BIAS); const float* dpart = WSP(const float, WS_DPART); bf16* mix = WSP(bf16, WS_MIX);
    const float lam = *WSP(const float, WS_LAM);
    for (int it = gw; it < DB * NH * DS; it += NGW) {
        const int t = it & 3, bh = it >> 2, bs = bh >> 2, h = bh & 3; const int row = MP + bs * DS + t;
        float res[2][2];
#pragma unroll
        for (int map = 0; map < 2; ++map) {
            const float* pbase = dpart + ((size_t)bh * 16 * 8 + map * 4 + t) * DP_STRIDE;
            float mc = -1e30f, lc = 0.f;
            if (lane < 16) { mc = pbase[(size_t)lane * 8 * DP_STRIDE + 128]; lc = pbase[(size_t)lane * 8 * DP_STRIDE + 129]; }
            const float qd = __uint_as_float((unsigned)qb[(size_t)row * 512 + h * 128 + map * 64 + lane] << 16);
            float sn[4];
#pragma unroll
            for (int i = 0; i < 4; ++i) { const float kd = P.out[O_KS + (size_t)(bs * DS + i) * 512 + h * 128 + map * 64 + lane]; const float s = wave_sum(qd * kd);
                sn[i] = (i <= t) ? s + bt[h * DP_STRIDE + (t - i >= 0 ? t - i : 0)] : -1e30f; }
            float M = wave_max(mc); M = fmaxf(fmaxf(M, sn[0]), fmaxf(fmaxf(sn[1], sn[2]), sn[3]));
            const float wc = ex2(mc - M);
            float L = wave_sum(wc * lc); float pn[4];
#pragma unroll
            for (int i = 0; i < 4; ++i) { pn[i] = (i <= t) ? ex2(sn[i] - M) : 0.f; L += pn[i]; }
            float ox = 0.f, oy = 0.f;
            for (int c = 0; c < 16; ++c) { const float w = __shfl(wc, c); ox += w * pbase[(size_t)c * 8 * DP_STRIDE + lane]; oy += w * pbase[(size_t)c * 8 * DP_STRIDE + 64 + lane]; }
#pragma unroll
            for (int i = 0; i < 4; ++i) { const float* vr = P.out + O_VS + (size_t)(bs * DS + i) * 512 + h * 128; ox += pn[i] * vr[lane]; oy += pn[i] * vr[64 + lane]; }
            res[map][0] = ox / L; res[map][1] = oy / L;
        }
        const float ax = res[0][0] - lam * res[1][0], ay = res[0][1] - lam * res[1][1];
        const float ssq = wave_sum(ax * ax + ay * ay);
        const float rn = (1.0f - LAM_INIT) / sqrtf(ssq * (1.0f / 128.0f) + EPS);
        bf16* o = mix + (size_t)row * 1024 + 512 + h * 128;
        o[lane] = (bf16)f2bf(ax * rn * P.in[19][lane]); o[64 + lane] = (bf16)f2bf(ay * rn * P.in[19][64 + lane]);
    }
}


namespace fa {
typedef short bf16x8 __attribute__((ext_vector_type(8)));
typedef float f32x16 __attribute__((ext_vector_type(16)));
typedef short v4i16_t __attribute__((ext_vector_type(4)));
constexpr int KS = 272, VS = 320, KT_BYTES = 64 * KS, VT_BYTES = 64 * VS, STAGE = KT_BYTES + VT_BYTES;
constexpr int TBL_OFF = 2 * STAGE;
constexpr float THR = 8.0f;
static_assert(TBL_OFF + 132 * 4 <= RING_BYTES && 65536 <= TBL_OFF, "fa LDS map");
__device__ __forceinline__ float swap_max(float x) { auto rr = __builtin_amdgcn_permlane32_swap(__float_as_uint(x), __float_as_uint(x), false, false); return fmaxf(__uint_as_float(rr[0]), __uint_as_float(rr[1])); }
__device__ __forceinline__ float swap_sum(float x) { auto rr = __builtin_amdgcn_permlane32_swap(__float_as_uint(x), __float_as_uint(x), false, false); return __uint_as_float(rr[0]) + __uint_as_float(rr[1]); }
__device__ __forceinline__ unsigned cvtpk(float lo, float hi) { unsigned r; asm volatile("v_cvt_pk_bf16_f32 %0, %1, %2" : "=v"(r) : "v"(lo), "v"(hi)); return r; }
__device__ __forceinline__ bf16x8 pack_p(const f32x16& p, int base) { v4u w; w.x = cvtpk(p[base], p[base + 1]); w.y = cvtpk(p[base + 2], p[base + 3]); w.z = cvtpk(p[base + 4], p[base + 5]); w.w = cvtpk(p[base + 6], p[base + 7]); return __builtin_bit_cast(bf16x8, w); }
__device__ __forceinline__ bf16x8 vfrag(const LAS unsigned char* p) {
    const v4i16_t lo = __builtin_amdgcn_ds_read_tr16_b64_v4i16((LAS v4i16_t*)p), hi = __builtin_amdgcn_ds_read_tr16_b64_v4i16((LAS v4i16_t*)(p + 8 * VS));
    return (bf16x8){lo[0], lo[1], lo[2], lo[3], hi[0], hi[1], hi[2], hi[3]};
}

__device__ __forceinline__ void dattn_flash(const Ptrs& P, LAS unsigned char* lds, int wave, int lane, int G) {
    const int tid = threadIdx.x;
    const bf16* qb = WSP(const bf16, WS_QB); const bf16* kb = WSP(const bf16, WS_KB); const bf16* vb = WSP(const bf16, WS_VB); bf16* mix = WSP(bf16, WS_MIX);
    const float* bt = WSP(const float, WS_BIAS); const float lam = *WSP(const float, WS_LAM);
    const int r32 = lane & 31, hi = lane >> 5, c = wave & 1, rg = wave >> 1;
    const int bx = blockIdx.x; const int vcu = (G % 8 == 0) ? (bx % 8) * (G / 8) + bx / 8 : bx;
    LAS float* tbl = (LAS float*)(lds + TBL_OFF);
    LAS float* ex = (LAS float*)lds;
    const int srow = tid >> 4, sch = tid & 15;
    const unsigned kl = srow * KS + sch * 16, vl = KT_BYTES + srow * VS + sch * 16;
    const unsigned kfo = r32 * KS + (c * 64 + hi * 8) * 2;
    const unsigned vfo = KT_BYTES + (4 * hi + ((lane & 15) >> 2)) * VS + (16 * ((lane >> 4) & 1) + 4 * (lane & 3)) * 2;
    for (int item = vcu; item < 256; item += G) {
        const int bh = item >> 4, pi = item & 15, b = bh >> 2, h = bh & 3;
        const size_t rowbase = (size_t)b * SEQ;
        __syncthreads();
        if (tid < 132) tbl[tid] = bt[h * DP_STRIDE + tid];
        for (int half = 0; half < 2; ++half) {
            const int qblk = half == 0 ? pi : 31 - pi;
            const int q0 = qblk * 128, NT = (q0 + 128) >> 6, tnear = (q0 >> 6) - 2;
            const int qpos = q0 + 32 * rg + r32;
            bf16x8 qr[4];
            { const bf16* qp = qb + (rowbase + qpos) * 512 + h * 128 + c * 64 + hi * 8;
#pragma unroll
              for (int dc = 0; dc < 4; ++dc) qr[dc] = *(const GAS bf16x8*)(qp + dc * 16); }
            const bf16* kg = kb + (rowbase + srow) * 512 + h * 128 + sch * 8; const bf16* vg = vb + (rowbase + srow) * 512 + h * 128 + sch * 8;
            v4u kst[2], vst[2];
#define FA_LOADG(t_) do { _Pragma("unroll") for (int i_ = 0; i_ < 2; ++i_) { kst[i_] = *(const GAS v4u*)(kg + ((size_t)(t_) * 64 + 32 * i_) * 512); vst[i_] = *(const GAS v4u*)(vg + ((size_t)(t_) * 64 + 32 * i_) * 512); } } while (0)
#define FA_STORE(so_) do { _Pragma("unroll") for (int i_ = 0; i_ < 2; ++i_) { *(LAS v4u*)(lds + (so_) + kl + i_ * 32 * KS) = kst[i_]; *(LAS v4u*)(lds + (so_) + vl + i_ * 32 * VS) = vst[i_]; } } while (0)
            FA_LOADG(0); FA_STORE(0);
            __syncthreads();
            const float b31 = tbl[128];
            float m = -1e30f, l = 0.f;
            f32x16 o[4];
#pragma unroll
            for (int k = 0; k < 4; ++k)
#pragma unroll
                for (int r = 0; r < 16; ++r) o[k][r] = 0.f;
            for (int t = 0; t < NT; ++t) {
                const int st = (t & 1) * STAGE;
                if (t + 1 < NT) FA_LOADG(t + 1);
                f32x16 p0, p1;
#pragma unroll
                for (int r = 0; r < 16; ++r) { p0[r] = 0.f; p1[r] = 0.f; }
                const LAS unsigned char* kbp = lds + st + kfo;
#pragma unroll
                for (int dc = 0; dc < 4; ++dc) {
                    const bf16x8 a0 = *(const LAS bf16x8*)(kbp + dc * 32), a1 = *(const LAS bf16x8*)(kbp + 32 * KS + dc * 32);
                    p0 = __builtin_amdgcn_mfma_f32_32x32x16_bf16(a0, qr[dc], p0, 0, 0, 0);
                    p1 = __builtin_amdgcn_mfma_f32_32x32x16_bf16(a1, qr[dc], p1, 0, 0, 0);
                }
                if (t < tnear) {
#pragma unroll
                    for (int r = 0; r < 16; ++r) { p0[r] += b31; p1[r] += b31; }
                } else {
                    const int rb = qpos - t * 64 - 4 * hi;
#pragma unroll
                    for (int r = 0; r < 16; ++r) {
                        const int rel0 = rb - ((r & 3) + 8 * (r >> 2)), rel1 = rel0 - 32;
                        const float b0 = tbl[rel0 < 0 ? 0 : (rel0 < 128 ? rel0 : 128)], b1 = tbl[rel1 < 0 ? 0 : (rel1 < 128 ? rel1 : 128)];
                        p0[r] = rel0 < 0 ? -1e30f : p0[r] + b0; p1[r] = rel1 < 0 ? -1e30f : p1[r] + b1;
                    }
                }
                float mx = fmaxf(p0[0], p1[0]);
#pragma unroll
                for (int r = 1; r < 16; ++r) mx = fmaxf(mx, fmaxf(p0[r], p1[r]));
                mx = swap_max(mx);
                if (__any(mx > m + THR)) {
                    const float mn = fmaxf(m, mx); const float al = ex2(m - mn); l *= al; m = mn;
#pragma unroll
                    for (int k = 0; k < 4; ++k)
#pragma unroll
                        for (int r = 0; r < 16; ++r) o[k][r] *= al;
                }
                float ls = 0.f;
#pragma unroll
                for (int r = 0; r < 16; ++r) { p0[r] = ex2(p0[r] - m); p1[r] = ex2(p1[r] - m); ls += p0[r] + p1[r]; }
                l += ls;
                bf16x8 pa[4]; pa[0] = pack_p(p0, 0); pa[1] = pack_p(p0, 8); pa[2] = pack_p(p1, 0); pa[3] = pack_p(p1, 8);
                const LAS unsigned char* vbp = lds + st + vfo;
#pragma unroll
                for (int s = 0; s < 4; ++s)
#pragma unroll
                    for (int k = 0; k < 4; ++k) {
                        const bf16x8 vf = vfrag(vbp + (16 * s) * VS + k * 64);
                        o[k] = __builtin_amdgcn_mfma_f32_32x32x16_bf16(vf, pa[s], o[k], 0, 0, 0);
                    }
                if (t + 1 < NT) FA_STORE(((t + 1) & 1) * STAGE);
                __syncthreads();
            }
#undef FA_LOADG
#undef FA_STORE
            l = swap_sum(l);
            const float il = 1.0f / l;
            if (c == 1) {
#pragma unroll
                for (int k = 0; k < 4; ++k)
#pragma unroll
                    for (int r = 0; r < 16; ++r) ex[(rg * 64 + k * 16 + r) * 64 + lane] = o[k][r] * il;
            }
            __syncthreads();
            if (c == 0) {
                float ssq = 0.f;
#pragma unroll
                for (int k = 0; k < 4; ++k)
#pragma unroll
                    for (int r = 0; r < 16; ++r) { const float a = o[k][r] * il - lam * ex[(rg * 64 + k * 16 + r) * 64 + lane]; o[k][r] = a; ssq += a * a; }
                ssq = swap_sum(ssq);
                const float rn = (1.0f - LAM_INIT) / sqrtf(ssq * (1.0f / 128.0f) + EPS);
                bf16* orow = mix + (rowbase + qpos) * 1024 + 512 + h * 128;
#pragma unroll
                for (int k = 0; k < 4; ++k)
#pragma unroll
                    for (int g = 0; g < 4; ++g) {
                        const int dv0 = 32 * k + 8 * g + 4 * hi;
                        const f32x4 w = *(const GAS f32x4*)(P.in[19] + dv0);
                        const unsigned long long pk = (unsigned long long)pk2(o[k][4 * g] * rn * w.x, o[k][4 * g + 1] * rn * w.y) | ((unsigned long long)pk2(o[k][4 * g + 2] * rn * w.z, o[k][4 * g + 3] * rn * w.w) << 32);
                        *(GAS unsigned long long*)(orow + dv0) = pk;
                    }
            }
            __syncthreads();
        }
    }
}
}


namespace fx {
using fa::bf16x8; using fa::f32x16; using fa::v4i16_t;
constexpr int KS = 528, VS = 576, TK = 32, KT_BYTES = TK * KS, VT_BYTES = TK * VS, STAGE = KT_BYTES + VT_BYTES;
static_assert(2 * STAGE <= RING_BYTES, "fx LDS map");
__device__ __forceinline__ bf16x8 vfrag(const LAS unsigned char* p) {
    const v4i16_t lo = __builtin_amdgcn_ds_read_tr16_b64_v4i16((LAS v4i16_t*)p), hi = __builtin_amdgcn_ds_read_tr16_b64_v4i16((LAS v4i16_t*)(p + 8 * VS));
    return (bf16x8){lo[0], lo[1], lo[2], lo[3], hi[0], hi[1], hi[2], hi[3]};
}
__device__ __forceinline__ void xattn_flash(const Ptrs& P, LAS unsigned char* lds, int wave, int lane, int G) {
    const int tid = threadIdx.x;
    const bf16* qc = WSP(const bf16, WS_QC); const bf16* mkb = WSP(const bf16, WS_MKB); const bf16* mvb = WSP(const bf16, WS_MVB); bf16* oc = WSP(bf16, WS_OC);
    const int r32 = lane & 31, hi = lane >> 5, dvh = wave & 1, rg = wave >> 1;
    const int bx = blockIdx.x; const int vcu = (G % 8 == 0) ? (bx % 8) * (G / 8) + bx / 8 : bx;
    const int srow = tid >> 5, sch = tid & 31;
    const unsigned kl = srow * KS + sch * 16, vl = KT_BYTES + srow * VS + sch * 16;
    const unsigned kfo = r32 * KS + (hi * 8) * 2;
    const unsigned vfo = KT_BYTES + (4 * hi + ((lane & 15) >> 2)) * VS + (128 * dvh + 16 * ((lane >> 4) & 1) + 4 * (lane & 3)) * 2;
    for (int unit = vcu; unit < 512; unit += G) {
        const int bh = unit >> 5, qblk = unit & 31, b = bh >> 2, h = bh & 3;
        const size_t row = (size_t)b * SEQ + qblk * 128 + 32 * rg + r32;
        bf16x8 qr[16];
        { const bf16* qp = qc + row * 1024 + h * 256 + hi * 8;
#pragma unroll
          for (int dc = 0; dc < 16; ++dc) qr[dc] = *(const GAS bf16x8*)(qp + dc * 16); }
        const bf16* kg = mkb + ((size_t)b * NMEM + srow) * 1024 + h * 256 + sch * 8; const bf16* vg = mvb + ((size_t)b * NMEM + srow) * 1024 + h * 256 + sch * 8;
        v4u kst[2], vst[2];
#define FX_LOADG(t_) do { _Pragma("unroll") for (int i_ = 0; i_ < 2; ++i_) { kst[i_] = *(const GAS v4u*)(kg + ((size_t)(t_) * TK + 16 * i_) * 1024); vst[i_] = *(const GAS v4u*)(vg + ((size_t)(t_) * TK + 16 * i_) * 1024); } } while (0)
#define FX_STORE(so_) do { _Pragma("unroll") for (int i_ = 0; i_ < 2; ++i_) { *(LAS v4u*)(lds + (so_) + kl + i_ * 16 * KS) = kst[i_]; *(LAS v4u*)(lds + (so_) + vl + i_ * 16 * VS) = vst[i_]; } } while (0)
        __syncthreads();
        FX_LOADG(0); FX_STORE(0);
        __syncthreads();
        float m = -1e30f, l = 0.f;
        f32x16 o[4];
#pragma unroll
        for (int k = 0; k < 4; ++k)
#pragma unroll
            for (int r = 0; r < 16; ++r) o[k][r] = 0.f;
        constexpr int NT = NMEM / TK;
        for (int t = 0; t < NT; ++t) {
            const int st = (t & 1) * STAGE;
            if (t + 1 < NT) FX_LOADG(t + 1);
            f32x16 p0;
#pragma unroll
            for (int r = 0; r < 16; ++r) p0[r] = 0.f;
            const LAS unsigned char* kbp = lds + st + kfo;
#pragma unroll
            for (int dc = 0; dc < 16; ++dc) {
                const bf16x8 a0 = *(const LAS bf16x8*)(kbp + dc * 32);
                p0 = __builtin_amdgcn_mfma_f32_32x32x16_bf16(a0, qr[dc], p0, 0, 0, 0);
            }
            float mx = p0[0];
#pragma unroll
            for (int r = 1; r < 16; ++r) mx = fmaxf(mx, p0[r]);
            mx = fa::swap_max(mx);
            if (__any(mx > m + fa::THR)) {
                const float mn = fmaxf(m, mx); const float al = ex2(m - mn); l *= al; m = mn;
#pragma unroll
                for (int k = 0; k < 4; ++k)
#pragma unroll
                    for (int r = 0; r < 16; ++r) o[k][r] *= al;
            }
            float ls = 0.f;
#pragma unroll
            for (int r = 0; r < 16; ++r) { p0[r] = ex2(p0[r] - m); ls += p0[r]; }
            l += ls;
            bf16x8 pa[2]; pa[0] = fa::pack_p(p0, 0); pa[1] = fa::pack_p(p0, 8);
            const LAS unsigned char* vbp = lds + st + vfo;
#pragma unroll
            for (int s = 0; s < 2; ++s)
#pragma unroll
                for (int k = 0; k < 4; ++k) {
                    const bf16x8 vf = vfrag(vbp + (16 * s) * VS + k * 64);
                    o[k] = __builtin_amdgcn_mfma_f32_32x32x16_bf16(vf, pa[s], o[k], 0, 0, 0);
                }
            if (t + 1 < NT) FX_STORE(((t + 1) & 1) * STAGE);
            __syncthreads();
        }
#undef FX_LOADG
#undef FX_STORE
        l = fa::swap_sum(l);
        const float il = 1.0f / l;
        bf16* orow = oc + row * 1024 + h * 256 + 128 * dvh;
#pragma unroll
        for (int k = 0; k < 4; ++k)
#pragma unroll
            for (int g = 0; g < 4; ++g) {
                const int dv0 = 32 * k + 8 * g + 4 * hi;
                const unsigned long long pk = (unsigned long long)pk2(o[k][4 * g] * il, o[k][4 * g + 1] * il) | ((unsigned long long)pk2(o[k][4 * g + 2] * il, o[k][4 * g + 3] * il) << 32);
                *(GAS unsigned long long*)(orow + dv0) = pk;
            }
    }
}
}


__device__ __forceinline__ float sss_total(const float* sss, int srow, int fq) {
    const f32x4* sp = (const f32x4*)(sss + (size_t)srow * 64 + fq * 16);
    const f32x4 a = sp[0], b = sp[1], c = sp[2], d = sp[3];
    float t = ((a[0] + a[1]) + (a[2] + a[3])) + ((b[0] + b[1]) + (b[2] + b[3])) + ((c[0] + c[1]) + (c[2] + c[3])) + ((d[0] + d[1]) + (d[2] + d[3]));
    t += __shfl_xor(t, 16); t += __shfl_xor(t, 32); return t;
}
struct SIn {
    const float* r0; bf16* zconv; bf16* qb; bf16* kb; bf16* vb; float* out;
    __device__ __forceinline__ int arow(int i) const { return i; }
    __device__ __forceinline__ void put(int srow, int col, f32x4 v, int fq, int cb) const {
        const size_t row = (size_t)MP + srow; v = v * r0[row];
        if (col < 1536) { *(GAS unsigned long long*)(zconv + row * 1536 + col) = (unsigned long long)pk2(v[0], v[1]) | ((unsigned long long)pk2(v[2], v[3]) << 32); }
        else if (col < 2048) { v = v * QSC; *(GAS unsigned long long*)(qb + row * 512 + (col - 1536)) = (unsigned long long)pk2(v[0], v[1]) | ((unsigned long long)pk2(v[2], v[3]) << 32); }
        else { const bool isk = col < 2560; const int c = col - (isk ? 2048 : 2560);
            *(GAS unsigned long long*)((isk ? kb : vb) + row * 512 + c) = (unsigned long long)pk2(v[0], v[1]) | ((unsigned long long)pk2(v[2], v[3]) << 32);
            *(f32x4*)(out + (isk ? O_KS : O_VS) + (size_t)srow * 512 + c) = v; }
    }
};
template <bool RESBF> struct SRes {
    const void* res; float* xo; bf16* xob; float* sss;
    __device__ __forceinline__ int arow(int i) const { return i; }
    __device__ __forceinline__ void put(int srow, int col, f32x4 v, int fq, int cb) const {
        f32x4 r;
        if (RESBF) { const unsigned long long w = *(const GAS unsigned long long*)((const bf16*)res + (size_t)srow * 1024 + col); r = (f32x4){bf_lo((unsigned)w), bf_hi((unsigned)w), bf_lo((unsigned)(w >> 32)), bf_hi((unsigned)(w >> 32))}; }
        else r = *(const f32x4*)((const float*)res + (size_t)srow * 1024 + col);
        const f32x4 o = r + v;
        if (xo) *(f32x4*)(xo + (size_t)srow * 1024 + col) = o;
        if (xob) *(GAS unsigned long long*)(xob + (size_t)srow * 1024 + col) = (unsigned long long)pk2(o[0], o[1]) | ((unsigned long long)pk2(o[2], o[3]) << 32);
        float sq = (o[0] * o[0] + o[1] * o[1]) + (o[2] * o[2] + o[3] * o[3]);
        sq += __shfl_xor(sq, 16); sq += __shfl_xor(sq, 32);
        if (fq == 0) sss[(size_t)srow * 64 + cb] = sq;
    }
};
struct SScale {
    const float* sss; bf16* O; int ldc; float cs;
    __device__ __forceinline__ int arow(int i) const { return i; }
    __device__ __forceinline__ void put(int srow, int col, f32x4 v, int fq, int cb) const {
        const float tot = sss_total(sss, srow, fq);
        v = v * (cs / sqrtf(tot * (1.0f / 1024.0f) + EPS));
        *(GAS unsigned long long*)(O + (size_t)srow * ldc + col) = (unsigned long long)pk2(v[0], v[1]) | ((unsigned long long)pk2(v[2], v[3]) << 32);
    }
};
constexpr size_t WS_HALO = WS_DPART;
constexpr int BL_OFF = LDSCTL_OFF + 512;
static_assert(BL_OFF + 8192 <= LDS_BYTES && WS_DPART + 128 * 5632 * 4 <= WS_END, "EpiUp buffers");
struct SUp {
    const float* sss; bf16* O;
    __device__ __forceinline__ int arow(int i) const { return i; }
    __device__ __forceinline__ void put(int srow, int col, f32x4 v, int fq, int cb) const {
        const float tot = sss_total(sss, srow, fq);
        v = v * (1.0f / sqrtf(tot * (1.0f / 1024.0f) + EPS));
        *(GAS unsigned long long*)(O + (size_t)srow * DUP + up_orig(col)) = (unsigned long long)pk2(v[0], v[1]) | ((unsigned long long)pk2(v[2], v[3]) << 32);
    }
};
struct SHalo {
    const float* ss; float* HB;
    __device__ __forceinline__ int arow(int i) const { const int r = 256 * (i >> 1) - 2 + (i & 1); return r < 0 ? 0 : r; }
    __device__ __forceinline__ void put(int hidx, int col, f32x4 v, int fq, int cb) const {
        const f32x4 s4 = *(const f32x4*)(ss + (size_t)arow(hidx) * 16 + fq * 4);
        float tot = (s4[0] + s4[1]) + (s4[2] + s4[3]); tot += __shfl_xor(tot, 16); tot += __shfl_xor(tot, 32);
        *(f32x4*)(HB + (size_t)hidx * DUP + col) = v * (1.0f / sqrtf(tot * (1.0f / 1024.0f) + EPS));
    }
};
template <int CTRL> __device__ __forceinline__ f32x4 dpp4(const f32x4 v) { return (f32x4){dppf<CTRL>(v[0]), dppf<CTRL>(v[1]), dppf<CTRL>(v[2]), dppf<CTRL>(v[3])}; }
struct EpiUp {
    static constexpr bool PERM = true, AFTER_DRAIN = false;
    const float* ss; const float* cw; const float* cb; const float* HB; bf16* act; float* out; LAS float* bl;
    __device__ __forceinline__ void operator()(const f32x4 (&acc)[2][2][4][2], const pg8::Unit& u, int wr, int wc, int fr, int fq) const {
        const int pn = u.pn, pm = u.pm, jc = wc * 32 + 8 * fq;
        float rs[2][4];
#pragma unroll
        for (int ai = 0; ai < 2; ++ai)
#pragma unroll
            for (int m = 0; m < 4; ++m) rs[ai][m] = ss[pm * 256 + ai * 128 + wr * 64 + m * 16 + fr];
        if (fr >= 14) {
#pragma unroll
            for (int ai = 0; ai < 2; ++ai)
#pragma unroll
                for (int bj = 0; bj < 2; ++bj)
#pragma unroll
                    for (int n = 0; n < 2; ++n) *(LAS f32x4*)(bl + ((ai * 2 + wr) * 2 + (fr - 14)) * 256 + bj * 128 + jc + 4 * n) = acc[ai][bj][3][n] * rs[ai][3];
        }
        asm volatile("s_waitcnt lgkmcnt(0)\n\ts_barrier" ::: "memory");
#pragma unroll
        for (int n = 0; n < 2; ++n) {
            const int gcol = 128 * pn + jc + 4 * n, ucol = DFF + gcol;
            const f32x4 wg0 = *(const f32x4*)(cw + gcol), wg1 = *(const f32x4*)(cw + DUP + gcol), wg2 = *(const f32x4*)(cw + 2 * DUP + gcol), bg = *(const f32x4*)(cb + gcol);
            const f32x4 wu0 = *(const f32x4*)(cw + ucol), wu1 = *(const f32x4*)(cw + DUP + ucol), wu2 = *(const f32x4*)(cw + 2 * DUP + ucol), bu = *(const f32x4*)(cb + ucol);
#pragma unroll
            for (int ai = 0; ai < 2; ++ai) {
                const int B = ai * 2 + wr;
                f32x4 pg = (f32x4){0.f, 0.f, 0.f, 0.f}, pu = pg;
                if (fr >= 14) {
                    if (B >= 1) { const LAS float* bp = bl + ((B - 1) * 2 + (fr - 14)) * 256 + jc + 4 * n; pg = *(const LAS f32x4*)bp; pu = *(const LAS f32x4*)(bp + 128); }
                    else if ((pm & 15) != 0) { const float* hp = HB + (size_t)(pm * 2 + (fr - 14)) * DUP + pn * 256 + jc + 4 * n; pg = *(const f32x4*)hp; pu = *(const f32x4*)(hp + 128); }
                }
                f32x4 lg1 = dpp4<0x121>(pg), lg2 = dpp4<0x122>(pg), lu1 = dpp4<0x121>(pu), lu2 = dpp4<0x122>(pu);
#pragma unroll
                for (int m = 0; m < 4; ++m) {
                    const f32x4 g0 = acc[ai][0][m][n] * rs[ai][m], u0 = acc[ai][1][m][n] * rs[ai][m];
                    const f32x4 sg1 = dpp4<0x121>(g0), sg2 = dpp4<0x122>(g0), su1 = dpp4<0x121>(u0), su2 = dpp4<0x122>(u0);
                    const f32x4 g1 = fr >= 1 ? sg1 : lg1, g2 = fr >= 2 ? sg2 : lg2, u1 = fr >= 1 ? su1 : lu1, u2 = fr >= 2 ? su2 : lu2;
                    const f32x4 gc = bg + wg0 * g2 + wg1 * g1 + wg2 * g0, uc = bu + wu0 * u2 + wu1 * u1 + wu2 * u0;
                    f32x4 a;
#pragma unroll
                    for (int i = 0; i < 4; ++i) a[i] = gc[i] * uc[i] * __builtin_amdgcn_rcpf(1.0f + ex2(-LOG2E * gc[i]));
                    const size_t row = (size_t)pm * 256 + ai * 128 + wr * 64 + m * 16 + fr;
                    *(GAS unsigned long long*)(act + row * DFF + gcol) = (unsigned long long)pk2(a[0], a[1]) | ((unsigned long long)pk2(a[2], a[3]) << 32);
                    if (m == 3 && B == 3 && (pm & 15) == 15 && fr >= 14) {
                        float* o = out + O_CFP + (size_t)((pm >> 4) * 2 + (fr - 14)) * DUP; *(f32x4*)(o + gcol) = g0; *(f32x4*)(o + ucol) = u0; }
                    lg1 = sg1; lg2 = sg2; lu1 = su1; lu2 = su2;
                }
            }
        }
    }
};
template <class SE> __device__ __forceinline__ void sgemm(const bf16* A, const bf16* Bt, int N, int K, const SE& E, int wave, int lane, int G) {
    const int gw = blockIdx.x * NWAVES + wave, NGW = G * NWAVES;
    const int nunits = N >> 1, fr = lane & 15, fq = lane >> 4;
    for (int u = gw; u < nunits; u += NGW) {
        const int rb = u & 7, cb = u >> 3;
        const bf16* ap = A + (size_t)E.arow(rb * 16 + fr) * K + fq * 8; const bf16* bp = Bt + (size_t)(cb * 16 + fr) * K + fq * 8;
        f32x4 acc = (f32x4){0.f, 0.f, 0.f, 0.f};
        for (int k0 = 0; k0 < K; k0 += 256) {
            bf16x8 af[8], bfr[8];
#pragma unroll
            for (int j = 0; j < 8; ++j) { af[j] = *(const GAS bf16x8*)(ap + k0 + 32 * j); bfr[j] = *(const GAS bf16x8*)(bp + k0 + 32 * j); }
#pragma unroll
            for (int j = 0; j < 8; ++j) acc = __builtin_amdgcn_mfma_f32_16x16x32_bf16(bfr[j], af[j], acc, 0, 0, 0);
        }
        E.put(rb * 16 + fr, cb * 16 + 4 * fq, acc, fq, cb);
    }
}

constexpr int N_PHASES = 12;
#ifndef PROBE_REPS
#define PROBE_REPS {1,1,1,1,1,1,1,1,1,1,1,1}
#endif
constexpr int REPS[N_PHASES] = PROBE_REPS;
struct Args { const float* in[32]; float* out; unsigned char* ws; int ph_lo, ph_hi; };
__global__ void __launch_bounds__(NWAVES * 64, 2) mega_fwd(Args args) {
    extern __shared__ __attribute__((aligned(16))) unsigned char lds[];
    LAS unsigned char* L = (LAS unsigned char*)lds;
    volatile LAS unsigned* MISC = (volatile LAS unsigned*)(L + MISC_OFF);
    const int tid = threadIdx.x, lane = tid & 63, wave = __builtin_amdgcn_readfirstlane(tid >> 6);
    const int G = gridDim.x;
    Ptrs P;
#pragma unroll
    for (int i = 0; i < 32; ++i) P.in[i] = args.in[i];
    P.out = args.out; P.ws = args.ws;
    for (int u = tid; u < (LDS_BYTES - LDSCTL_OFF) / 4; u += NWAVES * 64) ((LAS unsigned*)(L + LDSCTL_OFF))[u] = 0u;
    __syncthreads();
    gu32* ctl = (gu32*)(P.ws + WS_CTL);
    XcdBarrier bar; bar.bar = (unsigned*)(ctl + CW_BAR); bar.x = 0; bar.st = nullptr;
#if !MK_PER_PHASE
    bar = xcd_barrier_post((unsigned*)(ctl + CW_BAR), MISC + 8);
#endif
    const int lo = args.ph_lo, hi = args.ph_hi;
#define IN(k) (lo <= (k) && (k) < hi)
#define SEAM(k) do { if (IN(k) && IN((k) + 1)) xcd_barrier(bar); } while (0)

    if (IN(0)) _Pragma("unroll") for (int rr_ = 0; rr_ < REPS[0]; ++rr_) { if (rr_) xcd_barrier(bar); p0_prologue(P, L, wave, lane, G); }
    SEAM(0);
    if (IN(1)) _Pragma("unroll") for (int rr_ = 0; rr_ < REPS[1]; ++rr_) { if (rr_) xcd_barrier(bar);
        { pg8::Gemm g{WSP(const bf16, WS_XB), WSP(const bf16, WS_WIN), MP, DIN, DM}; pg8::StaticOrder S; S.init(MP, DIN, G, (int)blockIdx.x);
          pg8::EpiIn E{WSP(const float, WS_R0), WSP(bf16, WS_ZCONV), WSP(bf16, WS_QB), WSP(bf16, WS_KB), WSP(bf16, WS_VB), P.out};
          pg8::gemm_phase<pg8::EpiIn, pg8::StaticOrder, true, true>(L + RING_OFF, g, S, E); }
        { SIn SE{WSP(const float, WS_R0), WSP(bf16, WS_ZCONV), WSP(bf16, WS_QB), WSP(bf16, WS_KB), WSP(bf16, WS_VB), P.out};
          sgemm<SIn>(WSP(const bf16, WS_XB) + (size_t)MP * DM, WSP(const bf16, WS_WIN), DIN, DM, SE, wave, lane, G); }
        { pg8::Gemm g{WSP(const bf16, WS_MEMB), WSP(const bf16, WS_WCKV), NB * NMEM, 2 * DM, DM}; pg8::StaticOrder S; S.init(NB * NMEM, 2 * DM, G, (int)blockIdx.x);
          pg8::EpiMem E{WSP(const float, WS_RMEM), WSP(bf16, WS_MKB), WSP(bf16, WS_MVB), P.out};
          pg8::gemm_phase<pg8::EpiMem, pg8::StaticOrder, true, true>(L + RING_OFF, g, S, E); }
    }
    SEAM(1);
    if (IN(2)) {
        const bool g1 = ((blockIdx.x >> 3) & 1) == 0;
        if (g1) { p_decode_split<0>(P, wave, lane, G); p_convmix(P, wave, lane, G); }
        fa::dattn_flash(P, L, wave, lane, G);
        if (!g1) { p_convmix(P, wave, lane, G); p_decode_split<0>(P, wave, lane, G); }
    }
    SEAM(2);
    if (IN(3)) _Pragma("unroll") for (int rr_ = 0; rr_ < REPS[3]; ++rr_) { if (rr_) xcd_barrier(bar); p_decode_combine(P, wave, lane, G); }
    SEAM(3);
    if (IN(4)) _Pragma("unroll") for (int rr_ = 0; rr_ < REPS[4]; ++rr_) { if (rr_) xcd_barrier(bar); pg8::Gemm g{WSP(const bf16, WS_MIX), WSP(const bf16, WS_WOUT), MP, DM, DM}; pg8::StaticOrder S; S.init(MP, DM, G, (int)blockIdx.x);
        pg8::EpiRes<false> E{P.in[0], nullptr, WSP(bf16, WS_X1B), WSP(float, WS_SS1)};
        pg8::gemm_phase<pg8::EpiRes<false>, pg8::StaticOrder, true, true>(L + RING_OFF, g, S, E);
        SRes<false> SE{P.in[1], nullptr, WSP(bf16, WS_X1B) + (size_t)MP * DM, WSP(float, WS_SSS1)};
        sgemm<SRes<false>>(WSP(const bf16, WS_MIX) + (size_t)MP * DM, WSP(const bf16, WS_WOUT), DM, DM, SE, wave, lane, G); }
    SEAM(4);
    if (IN(5)) _Pragma("unroll") for (int rr_ = 0; rr_ < REPS[5]; ++rr_) { if (rr_) xcd_barrier(bar); pg8::Gemm g{WSP(const bf16, WS_X1B), WSP(const bf16, WS_WCQ), MP, DM, DM}; pg8::StaticOrder S; S.init(MP, DM, G, (int)blockIdx.x);
        pg8::EpiScale E{WSP(const float, WS_SS1), WSP(bf16, WS_QC), DM, CQSC};
        pg8::gemm_phase<pg8::EpiScale, pg8::StaticOrder, true, true>(L + RING_OFF, g, S, E);
        SScale SE{WSP(const float, WS_SSS1), WSP(bf16, WS_QC) + (size_t)MP * DM, DM, CQSC};
        sgemm<SScale>(WSP(const bf16, WS_X1B) + (size_t)MP * DM, WSP(const bf16, WS_WCQ), DM, DM, SE, wave, lane, G); }
    SEAM(5);
    if (IN(6)) _Pragma("unroll") for (int rr_ = 0; rr_ < REPS[6]; ++rr_) { if (rr_) xcd_barrier(bar); fx::xattn_flash(P, L, wave, lane, G); p_xattn_naive<true>(P, L, wave, lane, G); }
    SEAM(6);
    if (IN(7)) _Pragma("unroll") for (int rr_ = 0; rr_ < REPS[7]; ++rr_) { if (rr_) xcd_barrier(bar); pg8::Gemm g{WSP(const bf16, WS_OC), WSP(const bf16, WS_WCO), MP, DM, DM}; pg8::StaticOrder S; S.init(MP, DM, G, (int)blockIdx.x);
        pg8::EpiRes<true> E{WSP(const bf16, WS_X1B), nullptr, WSP(bf16, WS_X2B), WSP(float, WS_SS2)};
        pg8::gemm_phase<pg8::EpiRes<true>, pg8::StaticOrder, true, true>(L + RING_OFF, g, S, E);
        SRes<true> SE{WSP(const bf16, WS_X1B) + (size_t)MP * DM, nullptr, WSP(bf16, WS_X2B) + (size_t)MP * DM, WSP(float, WS_SSS2)};
        sgemm<SRes<true>>(WSP(const bf16, WS_OC) + (size_t)MP * DM, WSP(const bf16, WS_WCO), DM, DM, SE, wave, lane, G); }
    SEAM(7);
    if (IN(8)) _Pragma("unroll") for (int rr_ = 0; rr_ < REPS[8]; ++rr_) { if (rr_) xcd_barrier(bar);
        { const float* ss2 = WSP(const float, WS_SS2); float* r2 = WSP(float, WS_R0);
          for (int row = blockIdx.x * (NWAVES * 64) + tid; row < MP; row += G * NWAVES * 64) { const f32x4* sp = (const f32x4*)(ss2 + (size_t)row * 16); const f32x4 s0 = sp[0], s1 = sp[1], s2 = sp[2], s3 = sp[3];
              const float tot = ((s0[0] + s0[1]) + (s0[2] + s0[3])) + ((s1[0] + s1[1]) + (s1[2] + s1[3])) + ((s2[0] + s2[1]) + (s2[2] + s2[3])) + ((s3[0] + s3[1]) + (s3[2] + s3[3]));
              r2[row] = 1.0f / sqrtf(tot * (1.0f / 1024.0f) + EPS); } }
        SHalo SH{WSP(const float, WS_SS2), WSP(float, WS_HALO)};
        sgemm<SHalo>(WSP(const bf16, WS_X2B), WSP(const bf16, WS_WUP), DUP, DM, SH, wave, lane, G);
        SUp SE{WSP(const float, WS_SSS2), WSP(bf16, WS_UPB) + (size_t)MP * DUP};
        sgemm<SUp>(WSP(const bf16, WS_X2B) + (size_t)MP * DM, WSP(const bf16, WS_WUP), DUP, DM, SE, wave, lane, G); }
    SEAM(8);
    if (IN(9)) _Pragma("unroll") for (int rr_ = 0; rr_ < REPS[9]; ++rr_) { if (rr_) xcd_barrier(bar); pg8::Gemm g{WSP(const bf16, WS_X2B), WSP(const bf16, WS_WUP), MP, DUP, DM}; pg8::StaticOrder S; S.init(MP, DUP, G, (int)blockIdx.x);
        EpiUp E{WSP(const float, WS_R0), P.in[28], P.in[29], WSP(const float, WS_HALO), WSP(bf16, WS_ACT), P.out, (LAS float*)(L + BL_OFF)};
        pg8::gemm_phase<EpiUp, pg8::StaticOrder, true, true>(L + RING_OFF, g, S, E);
        p_convffn(P, wave, lane, G); }
    SEAM(9);
    if (IN(10)) _Pragma("unroll") for (int rr_ = 0; rr_ < REPS[10]; ++rr_) { if (rr_) xcd_barrier(bar); pg8::Gemm g{WSP(const bf16, WS_ACT), WSP(const bf16, WS_WDOWN), MP, DM, DFF}; pg8::StaticOrder S; S.init(MP, DM, G, (int)blockIdx.x);
        pg8::EpiRes<true> E{WSP(const bf16, WS_X2B), WSP(float, WS_X3), nullptr, WSP(float, WS_SS3)};
        pg8::gemm_phase<pg8::EpiRes<true>, pg8::StaticOrder, true, true>(L + RING_OFF, g, S, E);
        SRes<true> SE{WSP(const bf16, WS_X2B) + (size_t)MP * DM, WSP(float, WS_X3) + (size_t)MP * DM, nullptr, WSP(float, WS_SSS3)};
        sgemm<SRes<true>>(WSP(const bf16, WS_ACT) + (size_t)MP * DFF, WSP(const bf16, WS_WDOWN), DM, DFF, SE, wave, lane, G); }
    SEAM(10);
    if (IN(11)) _Pragma("unroll") for (int rr_ = 0; rr_ < REPS[11]; ++rr_) { if (rr_) xcd_barrier(bar); p_final(P, wave, lane, G); }
#undef IN
#undef SEAM
}

extern "C" void kernel_launch(void* const* d_in, const int* in_sizes, int n_in, void* d_out, int out_size, void* d_ws, size_t ws_size, hipStream_t stream) {
    static int grid = 0;
    if (grid == 0) {
        if (n_in != 32 || out_size != (int)O_END || ws_size < WS_END) { fprintf(stderr, "kernel_launch: unexpected shapes: n_in %d out %d ws %zu\n", n_in, out_size, ws_size); grid = -1; return; }
        int dev = 0, cus = 0, per_cu = 0;
        if (hipGetDevice(&dev) != hipSuccess || hipDeviceGetAttribute(&cus, hipDeviceAttributeMultiprocessorCount, dev) != hipSuccess) { grid = -1; return; }
        if (hipFuncSetAttribute((const void*)mega_fwd, hipFuncAttributeMaxDynamicSharedMemorySize, LDS_BYTES) != hipSuccess) { fprintf(stderr, "kernel_launch: hipFuncSetAttribute failed\n"); grid = -1; return; }
        if (hipOccupancyMaxActiveBlocksPerMultiprocessor(&per_cu, (const void*)mega_fwd, NWAVES * 64, LDS_BYTES) != hipSuccess || per_cu < 1) fprintf(stderr, "kernel_launch: occupancy query reports %d\n", per_cu);
        (void)hipGetLastError();
        grid = cus;
    }
    if (grid < 0) return;
    if (hipMemsetAsync((char*)d_ws + WS_CTL, 0, CTL_ZERO_BYTES, stream) != hipSuccess) return;
    Args a{};
    for (int i = 0; i < 32; ++i) a.in[i] = (const float*)d_in[i];
    a.out = (float*)d_out; a.ws = (unsigned char*)d_ws;
#if MK_PER_PHASE
    for (int p = 0; p < N_PHASES; ++p) { a.ph_lo = p; a.ph_hi = p + 1; hipLaunchKernelGGL(mega_fwd, dim3(grid), dim3(NWAVES * 64), LDS_BYTES, stream, a); }
#else
    a.ph_lo = 0; a.ph_hi = N_PHASES; hipLaunchKernelGGL(mega_fwd, dim3(grid), dim3(NWAVES * 64), LDS_BYTES, stream, a);
#endif
}
```

```cpp
#include <hip/hip_runtime.h>
#include <cstdio>
#include <cstdint>

#ifndef MK_PER_PHASE
#define MK_PER_PHASE 0
#endif

constexpr int DM = 1024, NB = 4, SEQ = 4096, MP = NB * SEQ;
constexpr int DB = 32, DS = 4, MS = DB * DS;
constexpr int MREAL = MP + MS, MT = 16640;
constexpr int PAST = 8192, PAGE = 128, NPAGES = PAST / PAGE;
constexpr int DCONV = 512, NH = 4, HDK = 64, HDV = 128, DATT = 512, DIN = 3072;
constexpr int NMEM = 256, MHEADS = 4, MDH = 256, DFF = 2816, DUP = 2 * DFF;
constexpr float EPS = 1e-6f, LOG2E = 1.4426950408889634f;
constexpr float QSC = 0.125f * LOG2E;
constexpr float CQSC = 0.0625f * LOG2E;
constexpr float LAM_INIT = 0.2f;
constexpr size_t O_Y = 0, O_YS = 16777216, O_KP = 16908288, O_VP = 25296896, O_KS = 33685504, O_VS = 33751040,
                 O_CMP = 33816576, O_CMS = 33820672, O_CFP = 33853440, O_CFS = 33898496, O_MK = 34258944, O_MV = 35307520, O_END = 36356096;
namespace pg8 {
#define PG8_LAS __attribute__((address_space(3)))
typedef unsigned short bf16_t;
typedef short bf16x8 __attribute__((ext_vector_type(8)));
typedef float f32x4 __attribute__((ext_vector_type(4)));
typedef unsigned u32x4 __attribute__((ext_vector_type(4)));
constexpr int BM = 256, BK = 64, HALF = 128, HTB = HALF * BK * 2  , STAGE_BYTES = 8 * HTB, NXCD = 8, WGM = 8;

__host__ __device__ __forceinline__ int lds_byte(int r, int c) { const int st = (r >> 4) * 2 + (c >> 5), rr = r & 15, cc = c & 31, ob = rr * 64 + cc * 2; return st * 1024 + (ob ^ (((ob >> 9) & 1) << 5)); }
__host__ __device__ __forceinline__ void stage_rc(int b, int& R, int& C) { const int st = b / 1024, sb = b % 1024, swz = sb ^ (((sb >> 9) & 1) << 5); R = (st >> 1) * 16 + swz / 64; C = (st & 1) * 32 + (swz % 64) / 2; }
__host__ __device__ __forceinline__ int perm32(int rho) { const int n = rho >> 4, i = rho & 15; return 8 * (i >> 2) + 4 * n + (i & 3); }

struct Unit { int pm, pn; };
struct Gemm { const bf16_t* A; const bf16_t* Bt; int M, N, K; };

struct StaticOrder {
    int nM, nN, nwg, G, c;
    __host__ __device__ void init(int M, int N, int G_, int c_) { nM = M / BM; nN = N / BM; nwg = nM * nN; G = G_; c = c_; }
    __host__ __device__ bool next(int i, Unit& u) const {
        const long L = (long)i * G + c; if (L >= nwg) return false;
        int wgid = (int)L; { const int q = nwg / NXCD, r = nwg % NXCD, xcd = wgid % NXCD, off = wgid / NXCD; wgid = (xcd < r ? xcd * (q + 1) : r * (q + 1) + (xcd - r) * q) + off; }
        const int nig = WGM * nN, gid = wgid / nig, fm = gid * WGM, gsz = (nM - fm) < WGM ? (nM - fm) : WGM;
        u.pm = fm + ((wgid % nig) % gsz); u.pn = (wgid % nig) / gsz; return true;
    }
    __device__ __forceinline__ void a_ready(const Unit&) const {}
    __device__ __forceinline__ void done(const Unit&) const {}
};

__device__ __forceinline__ unsigned cvt_pk_bf16(float lo, float hi) { unsigned r; asm volatile("v_cvt_pk_bf16_f32 %0, %1, %2" : "=v"(r) : "v"(lo), "v"(hi)); return r; }
__device__ __forceinline__ u32x4 pack8(const f32x4 a, const f32x4 b) { u32x4 w; w.x = cvt_pk_bf16(a[0], a[1]); w.y = cvt_pk_bf16(a[2], a[3]); w.z = cvt_pk_bf16(b[0], b[1]); w.w = cvt_pk_bf16(b[2], b[3]); return w; }
__device__ __forceinline__ float dot4(const f32x4 a) { return (a[0] * a[0] + a[1] * a[1]) + (a[2] * a[2] + a[3] * a[3]); }

struct EpiIn {
    static constexpr bool PERM = true, AFTER_DRAIN = false;
    const float* r0; bf16_t* zconv; bf16_t* qb; bf16_t* kb; bf16_t* vb; float* out;
    __device__ __forceinline__ void operator()(const f32x4 (&acc)[2][2][4][2], const Unit& u, int wr, int wc, int fr, int fq) const {
        const int pn = u.pn;
#pragma unroll
        for (int ai = 0; ai < 2; ++ai)
#pragma unroll
            for (int m = 0; m < 4; ++m) {
                const int row = u.pm * BM + ai * HALF + wr * 64 + m * 16 + fr;
                {
                    const float rs = r0[row];
#pragma unroll
                    for (int bj = 0; bj < 2; ++bj) {
                        const int col = pn * BM + bj * HALF + wc * 32 + 8 * fq;
                        const f32x4 v0 = acc[ai][bj][m][0] * rs, v1 = acc[ai][bj][m][1] * rs;
                        if (pn < 6) { *(u32x4*)(zconv + (size_t)row * 1536 + col) = pack8(v0, v1); }
                        else if (pn < 8) { *(u32x4*)(qb + (size_t)row * 512 + (col - 1536)) = pack8(v0 * QSC, v1 * QSC); }
                        else { const bool isk = pn < 10; const int c = col - (isk ? 2048 : 2560);
                            *(u32x4*)((isk ? kb : vb) + (size_t)row * 512 + c) = pack8(v0, v1);
                            float* o = out + (isk ? O_KP : O_VP) + (size_t)row * 512 + c;
                            *(f32x4*)o = v0; *(f32x4*)(o + 4) = v1; }
                    }
                }
            }
    }
};
struct EpiMem {
    static constexpr bool PERM = true, AFTER_DRAIN = false;
    const float* rmem; bf16_t* mkb; bf16_t* mvb; float* out;
    __device__ __forceinline__ void operator()(const f32x4 (&acc)[2][2][4][2], const Unit& u, int wr, int wc, int fr, int fq) const {
        const int pn = u.pn; const bool isk = pn < 4;
#pragma unroll
        for (int ai = 0; ai < 2; ++ai)
#pragma unroll
            for (int m = 0; m < 4; ++m) {
                const int row = u.pm * BM + ai * HALF + wr * 64 + m * 16 + fr;
                const float rs = rmem[row];
#pragma unroll
                for (int bj = 0; bj < 2; ++bj) {
                    const int col = (pn & 3) * BM + bj * HALF + wc * 32 + 8 * fq;
                    const f32x4 v0 = acc[ai][bj][m][0] * rs, v1 = acc[ai][bj][m][1] * rs;
                    *(u32x4*)((isk ? mkb : mvb) + (size_t)row * 1024 + col) = pack8(v0, v1);
                    float* o = out + (isk ? O_MK : O_MV) + (size_t)row * 1024 + col;
                    *(f32x4*)o = v0; *(f32x4*)(o + 4) = v1;
                }
            }
    }
};
template <bool RESBF> struct EpiRes {
    static constexpr bool PERM = true, AFTER_DRAIN = false;
    const void* res; float* xo; bf16_t* xob; float* ss;
    __device__ __forceinline__ void operator()(const f32x4 (&acc)[2][2][4][2], const Unit& u, int wr, int wc, int fr, int fq) const {
        const int pn = u.pn;
#pragma unroll
        for (int ai = 0; ai < 2; ++ai)
#pragma unroll
            for (int m = 0; m < 4; ++m) {
                const int row = u.pm * BM + ai * HALF + wr * 64 + m * 16 + fr;
                float sq = 0.f;
#pragma unroll
                for (int bj = 0; bj < 2; ++bj) {
                    const int col = pn * BM + bj * HALF + wc * 32 + 8 * fq;
                    f32x4 a, b;
                    if (RESBF) { const u32x4 w = *(const u32x4*)((const bf16_t*)res + (size_t)row * 1024 + col);
                        a = (f32x4){__uint_as_float(w.x << 16), __uint_as_float(w.x & 0xffff0000u), __uint_as_float(w.y << 16), __uint_as_float(w.y & 0xffff0000u)};
                        b = (f32x4){__uint_as_float(w.z << 16), __uint_as_float(w.z & 0xffff0000u), __uint_as_float(w.w << 16), __uint_as_float(w.w & 0xffff0000u)}; }
                    else { const float* rp = (const float*)res + (size_t)row * 1024 + col; a = *(const f32x4*)rp; b = *(const f32x4*)(rp + 4); }
                    const f32x4 o0 = a + acc[ai][bj][m][0], o1 = b + acc[ai][bj][m][1];
                    if (xo) { float* xp = xo + (size_t)row * 1024 + col; *(f32x4*)xp = o0; *(f32x4*)(xp + 4) = o1; }
                    if (xob) *(u32x4*)(xob + (size_t)row * 1024 + col) = pack8(o0, o1);
                    sq += dot4(o0) + dot4(o1);
                }
                sq += __shfl_xor(sq, 16); sq += __shfl_xor(sq, 32);
                if (fq == 0) ss[(size_t)row * 16 + pn * 4 + wc] = sq;
            }
    }
};
struct EpiScale {
    static constexpr bool PERM = true, AFTER_DRAIN = false;
    const float* ss; bf16_t* O; int ldc; float cs;
    __device__ __forceinline__ void operator()(const f32x4 (&acc)[2][2][4][2], const Unit& u, int wr, int wc, int fr, int fq) const {
        const int pn = u.pn;
#pragma unroll
        for (int ai = 0; ai < 2; ++ai)
#pragma unroll
            for (int m = 0; m < 4; ++m) {
                const int row = u.pm * BM + ai * HALF + wr * 64 + m * 16 + fr;
                const f32x4* sp = (const f32x4*)(ss + (size_t)row * 16);
                const f32x4 s0 = sp[0], s1 = sp[1], s2 = sp[2], s3 = sp[3];
                const float tot = ((s0[0] + s0[1]) + (s0[2] + s0[3])) + ((s1[0] + s1[1]) + (s1[2] + s1[3])) + ((s2[0] + s2[1]) + (s2[2] + s2[3])) + ((s3[0] + s3[1]) + (s3[2] + s3[3]));
                const float rs = cs / sqrtf(fmaxf(tot, 0.f) * (1.0f / 1024.0f) + EPS);
#pragma unroll
                for (int bj = 0; bj < 2; ++bj) {
                    const int col = pn * BM + bj * HALF + wc * 32 + 8 * fq;
                    *(u32x4*)(O + (size_t)row * ldc + col) = pack8(acc[ai][bj][m][0] * rs, acc[ai][bj][m][1] * rs);
                }
            }
    }
};
template <class Epi, class Sched, bool ALIGN_EPI = false, bool SP2 = false>
__device__ __forceinline__ void gemm_phase(PG8_LAS unsigned char* lds, const Gemm g, const Sched& S, const Epi& E) {
    const int tid = threadIdx.x, wid = __builtin_amdgcn_readfirstlane(tid >> 6), lane = tid & 63, wr = wid >> 2, wc = wid & 3, fr = lane & 15, fq = lane >> 4;
    const int K = g.K, nt = K / BK;
    unsigned voffA[2], voffB[2];
#pragma unroll
    for (int i = 0; i < 2; ++i) { int R, C; stage_rc(tid * 16 + i * 8192, R, C); const int Rb = Epi::PERM ? ((R & ~31) + perm32(R & 31)) : R;
        voffA[i] = (unsigned)(R * K + C) * 2u; voffB[i] = (unsigned)(Rb * K + C) * 2u; }
    const size_t kstep = (size_t)(BK * 2);
    const size_t hstep = (size_t)HALF * K * 2;
    const size_t tstep = 2 * hstep;
    const unsigned ldsw = (unsigned)wid * 1024u;
    const int aoff = lds_byte(wr * 64 + fr, fq * 8), boff = lds_byte(wc * 32 + fr, fq * 8);
#define PG8_SA(b, h) (((b) * 2 + (h)) * HTB)
#define PG8_SB(b, h) ((4 + (b) * 2 + (h)) * HTB)
#define PG8_STAGE(bufoff, gbase, voff) do { _Pragma("unroll") for (int _i = 0; _i < 2; ++_i) \
        __builtin_amdgcn_global_load_lds((const unsigned*)((const char*)(gbase) + (voff)[_i]), (PG8_LAS unsigned*)(lds + (bufoff) + ldsw + _i * 8192), 16, 0, 0); } while (0)
#define PG8_LDA(dst, b, h) do { _Pragma("unroll") for (int m = 0; m < 4; ++m) _Pragma("unroll") for (int k = 0; k < 2; ++k) dst[m][k] = *(const PG8_LAS bf16x8*)(lds + PG8_SA(b, h) + aoff + m * 2048 + k * 1024); } while (0)
#define PG8_LDB(dst, b, h) do { _Pragma("unroll") for (int n = 0; n < 2; ++n) _Pragma("unroll") for (int k = 0; k < 2; ++k) dst[n][k] = *(const PG8_LAS bf16x8*)(lds + PG8_SB(b, h) + boff + n * 2048 + k * 1024); } while (0)
#define PG8_MMA(ai, bj, At, Bt) do { __builtin_amdgcn_s_setprio(1); _Pragma("unroll") for (int m = 0; m < 4; ++m) _Pragma("unroll") for (int n = 0; n < 2; ++n) _Pragma("unroll") for (int k = 0; k < 2; ++k) \
        acc[ai][bj][m][n] = __builtin_amdgcn_mfma_f32_16x16x32_bf16(Bt[n][k], At[m][k], acc[ai][bj][m][n], 0, 0, 0); __builtin_amdgcn_s_setprio(0); } while (0)
#define PG8_WAIT_V(n) asm volatile("s_waitcnt vmcnt(" #n ")" ::: "memory")
#define PG8_WAIT_L(n) asm volatile("s_waitcnt lgkmcnt(" #n ")" ::: "memory")
#define PG8_BAR __builtin_amdgcn_s_barrier()
#define PG8_SCHED __builtin_amdgcn_sched_barrier(0)
    Unit cur, nxt; int ui = 0;
    if (!S.next(0, cur)) return;
    f32x4 acc[2][2][4][2];
#pragma unroll
    for (int a = 0; a < 2; ++a)
#pragma unroll
        for (int b = 0; b < 2; ++b)
#pragma unroll
            for (int m = 0; m < 4; ++m)
#pragma unroll
                for (int n = 0; n < 2; ++n) acc[a][b][m][n] = (f32x4){0.f, 0.f, 0.f, 0.f};
    bf16x8 At[4][2], B0[2][2], B1[2][2];
    const char* cA = (const char*)g.A + (size_t)cur.pm * tstep; const char* cB = (const char*)g.Bt + (size_t)cur.pn * tstep;
    S.a_ready(cur);
    if constexpr (SP2) {
        PG8_STAGE(PG8_SB(0, 0), cB, voffB); PG8_STAGE(PG8_SB(0, 1), cB + hstep, voffB); PG8_STAGE(PG8_SA(0, 0), cA, voffA); PG8_STAGE(PG8_SA(0, 1), cA + hstep, voffA);
        if (wr == 1) PG8_BAR;
        PG8_WAIT_V(2); PG8_BAR;
        PG8_STAGE(PG8_SB(1, 0), cB + kstep, voffB); PG8_STAGE(PG8_SA(1, 0), cA + kstep, voffA); PG8_STAGE(PG8_SB(1, 1), cB + hstep + kstep, voffB);
        PG8_WAIT_V(6); PG8_BAR;
    } else {
        PG8_STAGE(PG8_SB(0, 0), cB, voffB); PG8_STAGE(PG8_SA(0, 0), cA, voffA); PG8_STAGE(PG8_SB(0, 1), cB + hstep, voffB); PG8_STAGE(PG8_SA(0, 1), cA + hstep, voffA);
        if (wr == 1) PG8_BAR;
        PG8_WAIT_V(4); PG8_BAR;
        PG8_STAGE(PG8_SB(1, 0), cB + kstep, voffB); PG8_STAGE(PG8_SA(1, 0), cA + kstep, voffA); PG8_STAGE(PG8_SB(1, 1), cB + hstep + kstep, voffB);
        PG8_WAIT_V(6); PG8_BAR;
    }
    for (;;) {
        const bool has_next = S.next(ui + 1, nxt);
        const char* nA = has_next ? (const char*)g.A + (size_t)nxt.pm * tstep : cA; const char* nB = has_next ? (const char*)g.Bt + (size_t)nxt.pn * tstep : cB;
        for (int t = 0; t < nt; t += 2) {
            const bool last = (t == nt - 2);
            const char* a1 = cA + (size_t)(t + 1) * kstep;
            const char* a2 = last ? nA : cA + (size_t)(t + 2) * kstep; const char* b2 = last ? nB : cB + (size_t)(t + 2) * kstep;
            const char* a3 = a2 + kstep; const char* b3 = b2 + kstep;
            if (last && has_next) S.a_ready(nxt);
            if constexpr (SP2) {
            PG8_LDB(B0, 0, 0); PG8_LDB(B1, 0, 1); PG8_SCHED; PG8_LDA(At, 0, 0); PG8_STAGE(PG8_SA(1, 1), a1 + hstep, voffA);
            PG8_WAIT_V(8); PG8_WAIT_L(0); PG8_BAR; PG8_MMA(0, 0, At, B0); PG8_MMA(0, 1, At, B1); PG8_BAR; PG8_SCHED;
            PG8_LDA(At, 0, 1); PG8_STAGE(PG8_SB(0, 0), b2, voffB); PG8_STAGE(PG8_SB(0, 1), b2 + hstep, voffB); PG8_STAGE(PG8_SA(0, 0), a2, voffA);
            PG8_WAIT_V(8); PG8_WAIT_L(0); PG8_BAR; PG8_MMA(1, 0, At, B0); PG8_MMA(1, 1, At, B1); PG8_BAR; PG8_SCHED;
            PG8_LDB(B0, 1, 0); PG8_LDB(B1, 1, 1); PG8_SCHED; PG8_LDA(At, 1, 0); PG8_STAGE(PG8_SA(0, 1), a2 + hstep, voffA);
            PG8_WAIT_V(8); PG8_WAIT_L(0); PG8_BAR; PG8_MMA(0, 0, At, B0); PG8_MMA(0, 1, At, B1); PG8_BAR; PG8_SCHED;
            PG8_LDA(At, 1, 1); PG8_STAGE(PG8_SB(1, 0), b3, voffB); PG8_STAGE(PG8_SB(1, 1), b3 + hstep, voffB); PG8_STAGE(PG8_SA(1, 0), a3, voffA);
            PG8_WAIT_V(8); PG8_WAIT_L(0); PG8_BAR; PG8_MMA(1, 0, At, B0); PG8_MMA(1, 1, At, B1); PG8_BAR; PG8_SCHED;
            } else {
            PG8_LDB(B0, 0, 0); PG8_SCHED; PG8_LDA(At, 0, 0); PG8_STAGE(PG8_SA(1, 1), a1 + hstep, voffA);
            PG8_WAIT_L(8); PG8_BAR; PG8_WAIT_L(0); PG8_MMA(0, 0, At, B0); PG8_BAR; PG8_SCHED;
            PG8_LDB(B1, 0, 1); PG8_STAGE(PG8_SB(0, 0), b2, voffB);
            PG8_BAR; PG8_WAIT_L(0); PG8_MMA(0, 1, At, B1); PG8_BAR;
            PG8_LDA(At, 0, 1); PG8_STAGE(PG8_SA(0, 0), a2, voffA);
            PG8_BAR; PG8_WAIT_L(0); PG8_MMA(1, 0, At, B0); PG8_BAR; PG8_SCHED;
            PG8_STAGE(PG8_SB(0, 1), b2 + hstep, voffB);
            PG8_WAIT_V(6); PG8_BAR; PG8_MMA(1, 1, At, B1); PG8_BAR;
            PG8_LDB(B0, 1, 0); PG8_SCHED; PG8_LDA(At, 1, 0); PG8_STAGE(PG8_SA(0, 1), a2 + hstep, voffA);
            PG8_WAIT_L(8); PG8_BAR; PG8_WAIT_L(0); PG8_MMA(0, 0, At, B0); PG8_BAR; PG8_SCHED;
            PG8_LDB(B1, 1, 1); PG8_STAGE(PG8_SB(1, 0), b3, voffB);
            PG8_BAR; PG8_WAIT_L(0); PG8_MMA(0, 1, At, B1); PG8_BAR;
            PG8_LDA(At, 1, 1); PG8_STAGE(PG8_SA(1, 0), a3, voffA);
            PG8_BAR; PG8_WAIT_L(0); PG8_MMA(1, 0, At, B0); PG8_BAR; PG8_SCHED;
            PG8_STAGE(PG8_SB(1, 1), b3 + hstep, voffB);
            PG8_WAIT_V(6); PG8_BAR; PG8_MMA(1, 1, At, B1); PG8_BAR;
            }
        }
        if constexpr (ALIGN_EPI) { if (wr == 0) PG8_BAR; }
        if constexpr (!Epi::AFTER_DRAIN) { E(acc, cur, wr, wc, fr, fq); S.done(cur); }
        if (!has_next) break;
#pragma unroll
        for (int a = 0; a < 2; ++a)
#pragma unroll
            for (int b = 0; b < 2; ++b)
#pragma unroll
                for (int m = 0; m < 4; ++m)
#pragma unroll
                    for (int n = 0; n < 2; ++n) acc[a][b][m][n] = (f32x4){0.f, 0.f, 0.f, 0.f};
        cur = nxt; cA = nA; cB = nB; ++ui;
        if constexpr (ALIGN_EPI) { if (wr == 1) PG8_BAR; }
    }
    PG8_WAIT_V(0);
    if constexpr (!ALIGN_EPI) { if (wr == 0) PG8_BAR; }
    PG8_BAR;
    if constexpr (Epi::AFTER_DRAIN) { E.fused(acc, cur, wr, wc, fr, fq, lds, wid, lane); S.done(cur); }
#undef PG8_SA
#undef PG8_SB
#undef PG8_STAGE
#undef PG8_LDA
#undef PG8_LDB
#undef PG8_MMA
#undef PG8_WAIT_V
#undef PG8_WAIT_L
#undef PG8_BAR
#undef PG8_SCHED
}
}
#define GAS __attribute__((address_space(1)))
#define LAS __attribute__((address_space(3)))
typedef unsigned short bf16;
typedef unsigned v4u __attribute__((ext_vector_type(4)));
typedef float f32x4 __attribute__((ext_vector_type(4)));
typedef short bf16x8 __attribute__((ext_vector_type(8)));
typedef GAS unsigned gu32;
typedef GAS unsigned long long gu64;
#define RLX_AGENT __ATOMIC_RELAXED, __HIP_MEMORY_SCOPE_AGENT
#define LDS_WAIT() asm volatile("s_waitcnt lgkmcnt(0)" ::: "memory")
#define VM_WAIT() asm volatile("s_waitcnt vmcnt(0)" ::: "memory")
__device__ __forceinline__ unsigned long long rt() { return __builtin_amdgcn_s_memrealtime(); }
__device__ __forceinline__ unsigned f2bf(float f) { unsigned u = __builtin_bit_cast(unsigned, f); return (u + 0x7fffu + ((u >> 16) & 1u)) >> 16; }
__device__ __forceinline__ unsigned pk2(float lo, float hi) { return f2bf(lo) | (f2bf(hi) << 16); }

#define XB_TMO      128
#define XB_XCNT(j)  (256  + 64 * (j))
#define XB_XSUB(j)  (1280 + 64 * (j))
#define XB_XGEN(j)  (2304 + 64 * (j))
#define XB_TOP      3328
#define XB_TOPGEN   3392
#define XCD_BAR_WORDS 3456
#define XB_SPIN_CAP (1u << 18)

__device__ __forceinline__ unsigned xb_ld(unsigned* p)              { return __hip_atomic_load(p, __ATOMIC_RELAXED, __HIP_MEMORY_SCOPE_AGENT); }
__device__ __forceinline__ unsigned xb_add(unsigned* p, unsigned v) { return __hip_atomic_fetch_add(p, v, __ATOMIC_RELAXED, __HIP_MEMORY_SCOPE_AGENT); }
__device__ __forceinline__ unsigned xb_xcc_id() { return (unsigned)__builtin_amdgcn_s_getreg((3 << 11) | 20) & 0xFu; }
#define XB_SPIN(cond, bar) do { unsigned _sp = 0; while (cond) { __builtin_amdgcn_s_sleep(1); \
    if ((++_sp & 255u) == 0u) { if (xb_ld(&(bar)[XB_TMO])) break; if (_sp > XB_SPIN_CAP) { atomicAdd(&(bar)[XB_TMO], 1u); break; } } } } while (0)

struct XcdBarrier {
    unsigned* bar; unsigned x;
    volatile LAS unsigned* st;
};

__device__ __forceinline__ XcdBarrier xcd_barrier_post(unsigned* bar, volatile LAS unsigned* st) {
    XcdBarrier b; b.bar = bar; b.x = xb_xcc_id(); b.st = st;
    if (threadIdx.x == 0) (void)xb_add(&bar[XB_XCNT(b.x)], 1u);
    return b;
}
__device__ __forceinline__ void xcd_barrier_complete(unsigned* bar, unsigned x, unsigned& nloc, unsigned& nx) {
    const unsigned G = gridDim.x * gridDim.y * gridDim.z;
    unsigned sum, cnt, mine, sp = 0u;
    for (;;) {
        sum = 0u; cnt = 0u; mine = 0u;
#pragma unroll
        for (unsigned j = 0; j < 16; ++j) { const unsigned c = xb_ld(&bar[XB_XCNT(j)]); sum += c; cnt += (c > 0u) ? 1u : 0u; mine = (j == x) ? c : mine; }
        if (sum == G) break;
        __builtin_amdgcn_s_sleep(1);
        if ((++sp & 255u) == 0u) { if (xb_ld(&bar[XB_TMO])) break; if (sp > XB_SPIN_CAP) { atomicAdd(&bar[XB_TMO], 1u); break; } }
    }
    nloc = mine > 0u ? mine : 1u; nx = cnt > 0u ? cnt : 1u;
}

__device__ __forceinline__ void xcd_barrier(const XcdBarrier& b) {
    asm volatile("s_waitcnt vmcnt(0)" ::: "memory");
    __syncthreads();
    if (threadIdx.x == 0) {
        unsigned* bar = b.bar;
        __builtin_amdgcn_s_waitcnt(0);
        unsigned nloc = b.st[0], nx = b.st[1];
        if (nloc == 0u) { xcd_barrier_complete(bar, b.x, nloc, nx); b.st[0] = nloc; b.st[1] = nx; }
        const unsigned old = xb_add(&bar[XB_XSUB(b.x)], 1u);
        const unsigned gen = old / nloc;
        if (old + 1u == (gen + 1u) * nloc) {
            __builtin_amdgcn_fence(__ATOMIC_RELEASE, "agent");
            asm volatile("s_waitcnt vmcnt(0)" ::: "memory");
            const unsigned og = xb_add(&bar[XB_TOP], 1u);
            const unsigned tg = og / nx;
            if (og + 1u == (tg + 1u) * nx) xb_add(&bar[XB_TOPGEN], 1u);
            else XB_SPIN(xb_ld(&bar[XB_TOPGEN]) == tg, bar);
            __builtin_amdgcn_fence(__ATOMIC_ACQUIRE, "agent");
            xb_add(&bar[XB_XGEN(b.x)], 1u);
            asm volatile("s_waitcnt vmcnt(0)" ::: "memory");
        } else {
            XB_SPIN(xb_ld(&bar[XB_XGEN(b.x)]) == gen, bar);
            __builtin_amdgcn_fence(__ATOMIC_ACQUIRE, "agent");
            asm volatile("s_waitcnt vmcnt(0)" ::: "memory");
        }
    }
    __syncthreads();
}


constexpr size_t MiB = 1u << 20;
constexpr size_t WS_CTL = 0, CTL_ZERO_BYTES = 1 * MiB;
constexpr size_t WS_BIAS = 1 * MiB, WS_LAM = 1 * MiB + 4096, WS_RMEM = 1 * MiB + 8192, WS_R0 = 1 * MiB + 65536;
constexpr size_t WS_SS1 = 2 * MiB, WS_SS2 = 4 * MiB, WS_SS3 = 6 * MiB;
constexpr size_t WS_WIN = 8 * MiB, WS_WOUT = 14 * MiB, WS_WCQ = 16 * MiB, WS_WCKV = 18 * MiB, WS_WCO = 22 * MiB, WS_WUP = 24 * MiB, WS_WDOWN = 36 * MiB;
constexpr size_t WS_MEMB = 42 * MiB, WS_MKB = 44 * MiB, WS_MVB = 46 * MiB;
constexpr size_t WS_XB = 48 * MiB, WS_ZCONV = 82 * MiB, WS_QB = 132 * MiB, WS_KB = 149 * MiB, WS_VB = 166 * MiB, WS_MIX = 184 * MiB;
constexpr size_t WS_X1 = 218 * MiB, WS_X1B = 284 * MiB, WS_QC = 317 * MiB, WS_OC = 350 * MiB, WS_X2 = 383 * MiB, WS_X2B = 449 * MiB;
constexpr size_t WS_UPB = 482 * MiB, WS_ACT = 661 * MiB, WS_X3 = 751 * MiB, WS_DPART = 817 * MiB, WS_END = 826 * MiB;
constexpr size_t WS_SSS1 = 1 * MiB + 256 * 1024, WS_SSS2 = WS_SSS1 + 32768, WS_SSS3 = WS_SSS2 + 32768;
constexpr int CW_BAR = 4096;
constexpr int DP_STRIDE = 132;

constexpr int RING_OFF = 0, RING_BYTES = 131072;
constexpr int LDSCTL_OFF = RING_BYTES, MISC_OFF = LDSCTL_OFF + 320;
constexpr int LDS_BYTES = 147456;
constexpr int NWAVES = 8;

__device__ __forceinline__ float wave_sum(float v) {
#pragma unroll
    for (int o = 1; o < 64; o <<= 1) v += __shfl_xor(v, o);
    return v;
}
__device__ __forceinline__ float wave_max(float v) {
#pragma unroll
    for (int o = 1; o < 64; o <<= 1) v = fmaxf(v, __shfl_xor(v, o));
    return v;
}
__device__ __forceinline__ float bf_lo(unsigned w) { return __uint_as_float(w << 16); }
__device__ __forceinline__ float bf_hi(unsigned w) { return __uint_as_float(w & 0xffff0000u); }
__device__ __forceinline__ void unpack8(const v4u w, float (&f)[8]) { f[0] = bf_lo(w.x); f[1] = bf_hi(w.x); f[2] = bf_lo(w.y); f[3] = bf_hi(w.y); f[4] = bf_lo(w.z); f[5] = bf_hi(w.z); f[6] = bf_lo(w.w); f[7] = bf_hi(w.w); }
__device__ __forceinline__ v4u pack8f(const float (&f)[8]) { v4u o; o.x = pk2(f[0], f[1]); o.y = pk2(f[2], f[3]); o.z = pk2(f[4], f[5]); o.w = pk2(f[6], f[7]); return o; }
template <int CTRL> __device__ __forceinline__ float dppf(float x) { return __int_as_float(__builtin_amdgcn_update_dpp(0, __float_as_int(x), CTRL, 0xF, 0xF, true)); }
__device__ __forceinline__ float ex2(float x) { return __builtin_amdgcn_exp2f(x); }
__device__ __forceinline__ int t5_bucket(int n) {
    if (n < 16) return n;
    const int b = 16 + (int)(__log2f((float)n * 0.0625f) * (16.0f / 3.0f));
    return b < 31 ? b : 31;
}

__device__ __host__ __forceinline__ int up_orig(int np) { const int t = np >> 8, j = np & 255; return j < 128 ? 128 * t + j : DFF + 128 * t + (j - 128); }
template <bool UPPERM = false> __device__ __forceinline__ void transpose_item(const float* W, int K, int N, bf16* WT, const float* ksc, LAS float* scr, int item, int lane) {
    const int nblk = N / 32, kb = item / nblk, nb = item % nblk, k0 = 64 * kb, n0 = 32 * nb; const int ns0 = UPPERM ? up_orig(n0) : n0;
#pragma unroll 8
    for (int i = 0; i < 32; ++i) { const int kk = 2 * i + (lane >> 5); const float sc = ksc ? ksc[k0 + kk] : 1.0f; scr[kk * 33 + (lane & 31)] = W[(size_t)(k0 + kk) * N + ns0 + (lane & 31)] * sc; }
    LDS_WAIT(); asm volatile("" ::: "memory");
    const int c = lane & 7;
#pragma unroll
    for (int j = 0; j < 4; ++j) { const int n = (lane >> 3) + 8 * j; const LAS float* s = scr + (8 * c) * 33 + n;
        v4u o; o.x = pk2(s[0 * 33], s[1 * 33]); o.y = pk2(s[2 * 33], s[3 * 33]); o.z = pk2(s[4 * 33], s[5 * 33]); o.w = pk2(s[6 * 33], s[7 * 33]);
        *(GAS v4u*)(WT + (size_t)(n0 + n) * K + k0 + 8 * c) = o; }
    LDS_WAIT(); asm volatile("" ::: "memory");
}
__device__ __forceinline__ void rms_row(const float* xrow, bf16* orow, float* rout, int lane) {
    const GAS f32x4* xr = (const GAS f32x4*)xrow + lane;
    f32x4 v[4]; float s = 0.f;
#pragma unroll
    for (int j = 0; j < 4; ++j) { v[j] = xr[64 * j]; s += (v[j].x * v[j].x + v[j].y * v[j].y) + (v[j].z * v[j].z + v[j].w * v[j].w); }
    s = wave_sum(s);
    if (lane == 0) *rout = 1.0f / sqrtf(s * (1.0f / 1024.0f) + EPS);
    GAS unsigned long long* o8 = (GAS unsigned long long*)orow + lane;
#pragma unroll
    for (int j = 0; j < 4; ++j) o8[64 * j] = (unsigned long long)pk2(v[j].x, v[j].y) | ((unsigned long long)pk2(v[j].z, v[j].w) << 32);
}
struct Ptrs {
    const float* in[32]; float* out; unsigned char* ws;
};
#define WSP(T, off) ((T*)(P.ws + (off)))

__device__ __forceinline__ void p0_prologue(const Ptrs& P, LAS unsigned char* lds, int wave, int lane, int G) {
    LAS float* scr = (LAS float*)(lds + RING_OFF + wave * 16384);
    const int gw = blockIdx.x * NWAVES + wave, NGW = G * NWAVES;
    constexpr int I_IN = 16 * 96, I_OUT = 16 * 32, I_CQ = 16 * 32, I_CKV = 16 * 64, I_CO = 16 * 32, I_UP = 16 * 176, I_DOWN = 44 * 32;
    constexpr int NITEMS = I_IN + I_OUT + I_CQ + I_CKV + I_CO + I_UP + I_DOWN;
    for (int it = gw; it < NITEMS; it += NGW) {
        int r = it;
        if (r < I_IN) { transpose_item(P.in[12], 1024, 3072, WSP(bf16, WS_WIN), P.in[11], scr, r, lane); continue; } r -= I_IN;
        if (r < I_OUT) { transpose_item(P.in[20], 1024, 1024, WSP(bf16, WS_WOUT), nullptr, scr, r, lane); continue; } r -= I_OUT;
        if (r < I_CQ) { transpose_item(P.in[23], 1024, 1024, WSP(bf16, WS_WCQ), P.in[21], scr, r, lane); continue; } r -= I_CQ;
        if (r < I_CKV) { transpose_item(P.in[24], 1024, 2048, WSP(bf16, WS_WCKV), P.in[22], scr, r, lane); continue; } r -= I_CKV;
        if (r < I_CO) { transpose_item(P.in[25], 1024, 1024, WSP(bf16, WS_WCO), nullptr, scr, r, lane); continue; } r -= I_CO;
        if (r < I_UP) { transpose_item<true>(P.in[27], 1024, 5632, WSP(bf16, WS_WUP), P.in[26], scr, r, lane); continue; } r -= I_UP;
        transpose_item(P.in[30], 2816, 1024, WSP(bf16, WS_WDOWN), nullptr, scr, r, lane);
    }
    bf16* xb = WSP(bf16, WS_XB); float* r0 = WSP(float, WS_R0);
    for (int m = gw; m < MT; m += NGW) {
        if (m < MREAL) { const float* src = m < MP ? P.in[0] + (size_t)m * DM : P.in[1] + (size_t)(m - MP) * DM; rms_row(src, xb + (size_t)m * DM, r0 + m, lane); }
        else { GAS unsigned long long* o8 = (GAS unsigned long long*)(xb + (size_t)m * DM) + lane;
#pragma unroll
            for (int j = 0; j < 4; ++j) o8[64 * j] = 0ull;
            if (lane == 0) r0[m] = 0.f; }
    }
    bf16* memb = WSP(bf16, WS_MEMB); float* rmem = WSP(float, WS_RMEM);
    for (int m = gw; m < NB * NMEM; m += NGW) rms_row(P.in[2] + (size_t)m * DM, memb + (size_t)m * DM, rmem + m, lane);
    if (blockIdx.x == 0) {
        float* bt = WSP(float, WS_BIAS);
        for (int idx = threadIdx.x; idx < 4 * DP_STRIDE; idx += NWAVES * 64) { const int h = idx / DP_STRIDE, n = idx % DP_STRIDE; const int bk = n < 128 ? t5_bucket(n) : 31; bt[idx] = P.in[10][bk * 4 + h] * LOG2E; }
        if (wave == 0) { const float a = wave_sum(P.in[15][lane] * P.in[16][lane]), b = wave_sum(P.in[17][lane] * P.in[18][lane]);
            if (lane == 0) *WSP(float, WS_LAM) = expf(a) - expf(b) + LAM_INIT; }
    }
}

__device__ __forceinline__ void p_convmix(const Ptrs& P, int wave, int lane, int G) {
    const int gw = blockIdx.x * NWAVES + wave, NGW = G * NWAVES;
    const bf16* zc = WSP(const bf16, WS_ZCONV); bf16* mix = WSP(bf16, WS_MIX);
    const int ch = lane * 8;
    float w0[8], w1[8], w2[8], bb[8];
#pragma unroll
    for (int i = 0; i < 8; ++i) { w0[i] = P.in[13][ch + i]; w1[i] = P.in[13][512 + ch + i]; w2[i] = P.in[13][1024 + ch + i]; bb[i] = P.in[14][ch + i]; }
    constexpr int NPI = MP / 16;
    for (int it = gw; it < NPI + DB; it += NGW) {
        float p2[8], p1[8];
        int row0, nrow, t0, bidx; const bool prompt = it < NPI;
        if (prompt) { row0 = it * 16; nrow = 16; t0 = row0 % SEQ; bidx = row0 / SEQ;
            if (t0 == 0) {
#pragma unroll
                for (int i = 0; i < 8; ++i) { p2[i] = 0.f; p1[i] = 0.f; } }
            else { float c[8], u[8];
                unpack8(*(const GAS v4u*)(zc + (size_t)(row0 - 2) * 1536 + 512 + ch), c); unpack8(*(const GAS v4u*)(zc + (size_t)(row0 - 2) * 1536 + 1024 + ch), u);
#pragma unroll
                for (int i = 0; i < 8; ++i) p2[i] = c[i] * u[i];
                unpack8(*(const GAS v4u*)(zc + (size_t)(row0 - 1) * 1536 + 512 + ch), c); unpack8(*(const GAS v4u*)(zc + (size_t)(row0 - 1) * 1536 + 1024 + ch), u);
#pragma unroll
                for (int i = 0; i < 8; ++i) p1[i] = c[i] * u[i]; } }
        else { bidx = it - NPI; row0 = MP + bidx * DS; nrow = DS; t0 = 0;
            const float* st = P.in[6] + (size_t)bidx * 2 * DCONV;
#pragma unroll
            for (int i = 0; i < 8; ++i) { p2[i] = st[ch + i]; p1[i] = st[DCONV + ch + i]; } }
        for (int r = 0; r < nrow; ++r) {
            const size_t row = (size_t)(row0 + r);
            float bv[8], c[8], u[8], pre[8], y[8];
            unpack8(*(const GAS v4u*)(zc + row * 1536 + ch), bv); unpack8(*(const GAS v4u*)(zc + row * 1536 + 512 + ch), c); unpack8(*(const GAS v4u*)(zc + row * 1536 + 1024 + ch), u);
#pragma unroll
            for (int i = 0; i < 8; ++i) { pre[i] = c[i] * u[i]; y[i] = bv[i] * (bb[i] + w0[i] * p2[i] + w1[i] * p1[i] + w2[i] * pre[i]); }
            *(GAS v4u*)(mix + row * 1024 + ch) = pack8f(y);
            const int t = t0 + r;
            if (prompt) { if (t >= SEQ - 2) { float* o = P.out + O_CMP + (size_t)(bidx * 2 + (t - (SEQ - 2))) * DCONV + ch; *(f32x4*)o = (f32x4){pre[0], pre[1], pre[2], pre[3]}; *(f32x4*)(o + 4) = (f32x4){pre[4], pre[5], pre[6], pre[7]}; } }
            else { if (t >= DS - 2) { float* o = P.out + O_CMS + (size_t)(bidx * 2 + (t - (DS - 2))) * DCONV + ch; *(f32x4*)o = (f32x4){pre[0], pre[1], pre[2], pre[3]}; *(f32x4*)(o + 4) = (f32x4){pre[4], pre[5], pre[6], pre[7]}; } }
#pragma unroll
            for (int i = 0; i < 8; ++i) { p2[i] = p1[i]; p1[i] = pre[i]; }
        }
    }
}

__device__ __forceinline__ void p_convffn(const Ptrs& P, int wave, int lane, int G) {
    const int gw = blockIdx.x * NWAVES + wave, NGW = G * NWAVES;
    const bf16* up = WSP(const bf16, WS_UPB); bf16* act = WSP(bf16, WS_ACT);
    constexpr int NPI = MP / 16, NCH = 6;
    for (int it = NPI * NCH + gw; it < (NPI + DB) * NCH; it += NGW) {
        const int rb = it / NCH, cc = it % NCH; const int cg = cc * 64 + lane;
        if (cg < DFF / 8) {
            const int ch = cg * 8;
            float wg0[8], wg1[8], wg2[8], bg[8], wu0[8], wu1[8], wu2[8], bu[8];
#pragma unroll
            for (int i = 0; i < 8; ++i) { wg0[i] = P.in[28][ch + i]; wg1[i] = P.in[28][DUP + ch + i]; wg2[i] = P.in[28][2 * DUP + ch + i]; bg[i] = P.in[29][ch + i];
                wu0[i] = P.in[28][DFF + ch + i]; wu1[i] = P.in[28][DUP + DFF + ch + i]; wu2[i] = P.in[28][2 * DUP + DFF + ch + i]; bu[i] = P.in[29][DFF + ch + i]; }
            float g2[8], g1[8], u2[8], u1[8];
            int row0, nrow, t0, bidx; const bool prompt = rb < NPI;
            if (prompt) { row0 = rb * 16; nrow = 16; t0 = row0 % SEQ; bidx = row0 / SEQ;
                if (t0 == 0) {
#pragma unroll
                    for (int i = 0; i < 8; ++i) { g2[i] = 0.f; g1[i] = 0.f; u2[i] = 0.f; u1[i] = 0.f; } }
                else { unpack8(*(const GAS v4u*)(up + (size_t)(row0 - 2) * DUP + ch), g2); unpack8(*(const GAS v4u*)(up + (size_t)(row0 - 2) * DUP + DFF + ch), u2);
                    unpack8(*(const GAS v4u*)(up + (size_t)(row0 - 1) * DUP + ch), g1); unpack8(*(const GAS v4u*)(up + (size_t)(row0 - 1) * DUP + DFF + ch), u1); } }
            else { bidx = rb - NPI; row0 = MP + bidx * DS; nrow = DS; t0 = 0;
                const float* st = P.in[7] + (size_t)bidx * 2 * DUP;
#pragma unroll
                for (int i = 0; i < 8; ++i) { g2[i] = st[ch + i]; u2[i] = st[DFF + ch + i]; g1[i] = st[DUP + ch + i]; u1[i] = st[DUP + DFF + ch + i]; } }
            for (int r = 0; r < nrow; ++r) {
                const size_t row = (size_t)(row0 + r);
                float g0[8], u0[8], a[8];
                unpack8(*(const GAS v4u*)(up + row * DUP + ch), g0); unpack8(*(const GAS v4u*)(up + row * DUP + DFF + ch), u0);
#pragma unroll
                for (int i = 0; i < 8; ++i) { const float gc = bg[i] + wg0[i] * g2[i] + wg1[i] * g1[i] + wg2[i] * g0[i]; const float uc = bu[i] + wu0[i] * u2[i] + wu1[i] * u1[i] + wu2[i] * u0[i];
                    a[i] = gc / (1.0f + __expf(-gc)) * uc; }
                *(GAS v4u*)(act + row * DFF + ch) = pack8f(a);
                const int t = t0 + r; const int tl = prompt ? SEQ - 2 : DS - 2;
                if (t >= tl) { float* o = P.out + (prompt ? O_CFP : O_CFS) + (size_t)(bidx * 2 + (t - tl)) * DUP + ch;
                    *(f32x4*)o = (f32x4){g0[0], g0[1], g0[2], g0[3]}; *(f32x4*)(o + 4) = (f32x4){g0[4], g0[5], g0[6], g0[7]};
                    *(f32x4*)(o + DFF) = (f32x4){u0[0], u0[1], u0[2], u0[3]}; *(f32x4*)(o + DFF + 4) = (f32x4){u0[4], u0[5], u0[6], u0[7]}; }
#pragma unroll
                for (int i = 0; i < 8; ++i) { g2[i] = g1[i]; g1[i] = g0[i]; u2[i] = u1[i]; u1[i] = u0[i]; }
            }
        }
    }
}

__device__ __forceinline__ void p_final(const Ptrs& P, int wave, int lane, int G) {
    const int gw = blockIdx.x * NWAVES + wave, NGW = G * NWAVES;
    const float* x3 = WSP(const float, WS_X3); const float* ss = WSP(const float, WS_SS3); const float* w = P.in[31];
    f32x4 wv[4];
#pragma unroll
    for (int j = 0; j < 4; ++j) wv[j] = *((const f32x4*)w + lane + 64 * j);
    for (int m = gw; m < MREAL; m += NGW) {
        const float tot = m < MP ? wave_sum(lane < 16 ? ss[(size_t)m * 16 + lane] : 0.f) : wave_sum(WSP(const float, WS_SSS3)[(size_t)(m - MP) * 64 + lane]);
        const float rs = 1.0f / sqrtf(tot * (1.0f / 1024.0f) + EPS);
        const GAS f32x4* xr = (const GAS f32x4*)(x3 + (size_t)m * DM) + lane;
        GAS f32x4* o = (GAS f32x4*)(P.out + (m < MP ? O_Y + (size_t)m * DM : O_YS + (size_t)(m - MP) * DM)) + lane;
#pragma unroll
        for (int j = 0; j < 4; ++j) o[64 * j] = xr[64 * j] * rs * wv[j];
    }
}

__device__ __forceinline__ void p_dattn_naive(const Ptrs& P, LAS unsigned char* lds, int wave, int lane, int G) {
    const int gw = blockIdx.x * NWAVES + wave, NGW = G * NWAVES;
    const bf16* qb = WSP(const bf16, WS_QB); const bf16* kb = WSP(const bf16, WS_KB); const bf16* vb = WSP(const bf16, WS_VB); bf16* mix = WSP(bf16, WS_MIX);
    const float* bt = WSP(const float, WS_BIAS); const float lam = *WSP(const float, WS_LAM);
    LAS float* qs = (LAS float*)(lds + wave * 1024); LAS float* ps = qs + 128;
    for (int it = gw; it < MP * NH; it += NGW) {
        const int m = it >> 2, h = it & 3, b = m / SEQ, t = m % SEQ;
        { const unsigned w = *(const GAS unsigned*)(qb + (size_t)m * 512 + h * 128 + 2 * lane); qs[2 * lane] = bf_lo(w); qs[2 * lane + 1] = bf_hi(w); }
        LDS_WAIT(); asm volatile("" ::: "memory");
        float m1 = -1e30f, m2 = -1e30f, l1 = 0.f, l2 = 0.f, o1x = 0.f, o1y = 0.f, o2x = 0.f, o2y = 0.f;
        for (int k0 = 0; k0 <= t; k0 += 64) {
            const int key = k0 + lane; const bool valid = key <= t; const int kc = valid ? key : t;
            const bf16* kr = kb + (size_t)(b * SEQ + kc) * 512 + h * 128;
            float s1 = 0.f, s2 = 0.f;
#pragma unroll
            for (int c = 0; c < 16; ++c) { float kf[8]; unpack8(*(const GAS v4u*)(kr + c * 8), kf);
#pragma unroll
                for (int i = 0; i < 8; ++i) { if (c < 8) s1 += kf[i] * qs[c * 8 + i]; else s2 += kf[i] * qs[c * 8 + i]; } }
            const int rel = t - kc; const float bias = bt[h * DP_STRIDE + (rel < 128 ? rel : 128)];
            s1 = valid ? s1 + bias : -1e30f; s2 = valid ? s2 + bias : -1e30f;
            const float mn1 = fmaxf(m1, wave_max(s1)), mn2 = fmaxf(m2, wave_max(s2));
            const float a1 = ex2(m1 - mn1), a2 = ex2(m2 - mn2);
            const float p1 = valid ? ex2(s1 - mn1) : 0.f, p2 = valid ? ex2(s2 - mn2) : 0.f;
            l1 = l1 * a1 + wave_sum(p1); l2 = l2 * a2 + wave_sum(p2); m1 = mn1; m2 = mn2;
            o1x *= a1; o1y *= a1; o2x *= a2; o2y *= a2;
            ps[lane] = p1; ps[64 + lane] = p2;
            LDS_WAIT(); asm volatile("" ::: "memory");
            const int nk = (t - k0 + 1) < 64 ? (t - k0 + 1) : 64;
            const bf16* vr = vb + (size_t)(b * SEQ + k0) * 512 + h * 128 + 2 * lane;
            for (int kk = 0; kk < nk; ++kk) { const float pa = ps[kk], pb = ps[64 + kk]; const unsigned w = *(const GAS unsigned*)(vr + (size_t)kk * 512); const float vx = bf_lo(w), vy = bf_hi(w);
                o1x += pa * vx; o1y += pa * vy; o2x += pb * vx; o2y += pb * vy; }
            LDS_WAIT(); asm volatile("" ::: "memory");
        }
        const float ax = o1x / l1 - lam * (o2x / l2), ay = o1y / l1 - lam * (o2y / l2);
        const float ssq = wave_sum(ax * ax + ay * ay);
        const float rn = (1.0f - LAM_INIT) / sqrtf(ssq * (1.0f / 128.0f) + EPS);
        const float wx = P.in[19][2 * lane], wy = P.in[19][2 * lane + 1];
        *(GAS unsigned*)(mix + (size_t)m * 1024 + 512 + h * 128 + 2 * lane) = pk2(ax * rn * wx, ay * rn * wy);
    }
}

template <bool SAMPLE> __device__ __forceinline__ void p_xattn_naive(const Ptrs& P, LAS unsigned char* lds, int wave, int lane, int G) {
    const int gw = blockIdx.x * NWAVES + wave, NGW = G * NWAVES;
    const bf16* qc = WSP(const bf16, WS_QC); bf16* oc = WSP(bf16, WS_OC);
    const bf16* mkb = WSP(const bf16, WS_MKB); const bf16* mvb = WSP(const bf16, WS_MVB);
    LAS float* qs = (LAS float*)(lds + wave * 2048); LAS float* ps = qs + 256;
    const int nit = (SAMPLE ? MS : MP) * MHEADS;
    for (int it = gw; it < nit; it += NGW) {
        const int mr = it >> 2, h = it & 3; const int m = SAMPLE ? MP + mr : mr; const int b = SAMPLE ? mr / DS : mr / SEQ;
        { const unsigned long long w = *(const GAS unsigned long long*)(qc + (size_t)m * 1024 + h * 256 + 4 * lane);
          qs[4 * lane] = bf_lo((unsigned)w); qs[4 * lane + 1] = bf_hi((unsigned)w); qs[4 * lane + 2] = bf_lo((unsigned)(w >> 32)); qs[4 * lane + 3] = bf_hi((unsigned)(w >> 32)); }
        LDS_WAIT(); asm volatile("" ::: "memory");
        float s[4];
#pragma unroll
        for (int c = 0; c < 4; ++c) {
            const int key = c * 64 + lane; float acc = 0.f;
            if (SAMPLE) { const float* kr = P.in[8] + ((size_t)(b * NMEM + key) * MHEADS + h) * MDH;
#pragma unroll 8
                for (int d = 0; d < 64; ++d) { const f32x4 kv = *(const GAS f32x4*)(kr + 4 * d); acc += kv.x * qs[4 * d] + kv.y * qs[4 * d + 1] + kv.z * qs[4 * d + 2] + kv.w * qs[4 * d + 3]; } }
            else { const bf16* kr = mkb + (size_t)(b * NMEM + key) * 1024 + h * 256;
#pragma unroll 8
                for (int d = 0; d < 32; ++d) { float kf[8]; unpack8(*(const GAS v4u*)(kr + 8 * d), kf);
#pragma unroll
                    for (int i = 0; i < 8; ++i) acc += kf[i] * qs[8 * d + i]; } }
            s[c] = acc;
        }
        const float mx = wave_max(fmaxf(fmaxf(s[0], s[1]), fmaxf(s[2], s[3])));
        float lsum = 0.f;
#pragma unroll
        for (int c = 0; c < 4; ++c) { const float p = ex2(s[c] - mx); ps[c * 64 + lane] = p; lsum += p; }
        lsum = wave_sum(lsum);
        LDS_WAIT(); asm volatile("" ::: "memory");
        float o[4] = {0.f, 0.f, 0.f, 0.f};
        for (int key = 0; key < NMEM; ++key) {
            const float p = ps[key];
            if (SAMPLE) { const f32x4 v = *(const GAS f32x4*)(P.in[9] + ((size_t)(b * NMEM + key) * MHEADS + h) * MDH + 4 * lane); o[0] += p * v.x; o[1] += p * v.y; o[2] += p * v.z; o[3] += p * v.w; }
            else { const unsigned long long w = *(const GAS unsigned long long*)(mvb + (size_t)(b * NMEM + key) * 1024 + h * 256 + 4 * lane);
                o[0] += p * bf_lo((unsigned)w); o[1] += p * bf_hi((unsigned)w); o[2] += p * bf_lo((unsigned)(w >> 32)); o[3] += p * bf_hi((unsigned)(w >> 32)); }
        }
        const float il = 1.0f / lsum;
        *(GAS unsigned long long*)(oc + (size_t)m * 1024 + h * 256 + 4 * lane) = (unsigned long long)pk2(o[0] * il, o[1] * il) | ((unsigned long long)pk2(o[2] * il, o[3] * il) << 32);
        LDS_WAIT(); asm volatile("" ::: "memory");
    }
}

__device__ __forceinline__ void p_xattn_sample(const Ptrs& P, LAS unsigned char* lds, int wave, int lane, int G, int wgoff) {
    const bf16* qc = WSP(const bf16, WS_QC); bf16* oc = WSP(bf16, WS_OC);
    LAS float* part = (LAS float*)lds;
    LAS float* stat = part + 8 * 4 * 256;
    int vb = (int)blockIdx.x - wgoff; if (vb < 0) vb += G;
    for (int it = vb; it < DB * MHEADS; it += G) {
        const int bs = it >> 2, h = it & 3;
        float qv[4][4];
#pragma unroll
        for (int t = 0; t < 4; ++t) { const unsigned long long w = *(const GAS unsigned long long*)(qc + (size_t)(MP + bs * DS + t) * 1024 + h * 256 + 4 * lane);
            qv[t][0] = bf_lo((unsigned)w); qv[t][1] = bf_hi((unsigned)w); qv[t][2] = bf_lo((unsigned)(w >> 32)); qv[t][3] = bf_hi((unsigned)(w >> 32)); }
        const float* kbase = P.in[8] + ((size_t)(bs * NMEM + wave * 32) * MHEADS + h) * MDH + 4 * lane;
        const float* vbase = P.in[9] + ((size_t)(bs * NMEM + wave * 32) * MHEADS + h) * MDH + 4 * lane;
        float mm[4], ll[4], acc[4][4];
#pragma unroll
        for (int t = 0; t < 4; ++t) { mm[t] = -1e30f; ll[t] = 0.f;
#pragma unroll
            for (int d = 0; d < 4; ++d) acc[t][d] = 0.f; }
#pragma unroll 1
        for (int kb = 0; kb < 4; ++kb) {
            f32x4 Kr[8], Vr[8];
#pragma unroll
            for (int j = 0; j < 8; ++j) { Kr[j] = *(const GAS f32x4*)(kbase + (size_t)(kb * 8 + j) * MHEADS * MDH); Vr[j] = *(const GAS f32x4*)(vbase + (size_t)(kb * 8 + j) * MHEADS * MDH); }
            float s[8][4];
#pragma unroll
            for (int j = 0; j < 8; ++j)
#pragma unroll
                for (int t = 0; t < 4; ++t) s[j][t] = Kr[j].x * qv[t][0] + Kr[j].y * qv[t][1] + Kr[j].z * qv[t][2] + Kr[j].w * qv[t][3];
#pragma unroll
            for (int j = 0; j < 8; ++j)
#pragma unroll
                for (int t = 0; t < 4; ++t) { float a = s[j][t]; a += dppf<0xB1>(a); a += dppf<0x4E>(a); a += dppf<0x141>(a); a += dppf<0x140>(a); a += __shfl_xor(a, 16); a += __shfl_xor(a, 32); s[j][t] = a; }
#pragma unroll
            for (int t = 0; t < 4; ++t) { float mx = s[0][t];
#pragma unroll
                for (int j = 1; j < 8; ++j) mx = fmaxf(mx, s[j][t]);
                const float mn = fmaxf(mm[t], mx); const float al = ex2(mm[t] - mn); mm[t] = mn; ll[t] *= al;
#pragma unroll
                for (int d = 0; d < 4; ++d) acc[t][d] *= al;
#pragma unroll
                for (int j = 0; j < 8; ++j) { const float p = ex2(s[j][t] - mn); ll[t] += p; acc[t][0] += p * Vr[j].x; acc[t][1] += p * Vr[j].y; acc[t][2] += p * Vr[j].z; acc[t][3] += p * Vr[j].w; } }
        }
        __syncthreads();
#pragma unroll
        for (int t = 0; t < 4; ++t) { *(LAS f32x4*)(part + (wave * 4 + t) * 256 + 4 * lane) = (f32x4){acc[t][0], acc[t][1], acc[t][2], acc[t][3]}; if (lane == 0) { stat[(wave * 4 + t) * 2] = mm[t]; stat[(wave * 4 + t) * 2 + 1] = ll[t]; } }
        __syncthreads();
        if (wave < 4) { const int t = wave; float M = -1e30f;
#pragma unroll
            for (int w2 = 0; w2 < 8; ++w2) M = fmaxf(M, stat[(w2 * 4 + t) * 2]);
            float L = 0.f; f32x4 o = (f32x4){0.f, 0.f, 0.f, 0.f};
#pragma unroll
            for (int w2 = 0; w2 < 8; ++w2) { const float fsc = ex2(stat[(w2 * 4 + t) * 2] - M); L += fsc * stat[(w2 * 4 + t) * 2 + 1]; o = o + *(const LAS f32x4*)(part + (w2 * 4 + t) * 256 + 4 * lane) * fsc; }
            const float il = 1.0f / L;
            *(GAS unsigned long long*)(oc + (size_t)(MP + bs * DS + t) * 1024 + h * 256 + 4 * lane) = (unsigned long long)pk2(o[0] * il, o[1] * il) | ((unsigned long long)pk2(o[2] * il, o[3] * il) << 32); }
    }
    __syncthreads();
}

template <int U> __device__ __forceinline__ void dec_step(const f32x4* K, const f32x4* V, const float (&qv)[4][4], float (&mm)[4], float (&ll)[4], float (&accA)[4][4], float (&accB)[4][4],
                                         const bool nearb, const float b31, const float* bth, const int relb) {
    float s[U][4];
#pragma unroll
    for (int u = 0; u < U; ++u)
#pragma unroll
        for (int t = 0; t < 4; ++t) s[u][t] = K[u].x * qv[t][0] + K[u].y * qv[t][1] + K[u].z * qv[t][2] + K[u].w * qv[t][3];
#pragma unroll
    for (int u = 0; u < U; ++u)
#pragma unroll
        for (int t = 0; t < 4; ++t) s[u][t] += dppf<0xB1>(s[u][t]);
#pragma unroll
    for (int u = 0; u < U; ++u)
#pragma unroll
        for (int t = 0; t < 4; ++t) s[u][t] += dppf<0x4E>(s[u][t]);
#pragma unroll
    for (int u = 0; u < U; ++u)
#pragma unroll
        for (int t = 0; t < 4; ++t) s[u][t] += dppf<0x141>(s[u][t]);
#pragma unroll
    for (int u = 0; u < U; ++u)
#pragma unroll
        for (int t = 0; t < 4; ++t) s[u][t] += dppf<0x140>(s[u][t]);
    if (!nearb) {
#pragma unroll
        for (int u = 0; u < U; ++u)
#pragma unroll
            for (int t = 0; t < 4; ++t) s[u][t] += b31;
    } else {
#pragma unroll
        for (int u = 0; u < U; ++u)
#pragma unroll
            for (int t = 0; t < 4; ++t) { const int rel = relb - 2 * u + t; s[u][t] += bth[rel < 128 ? rel : 128]; }
    }
    float mx[4]; bool grow = false;
#pragma unroll
    for (int t = 0; t < 4; ++t) { mx[t] = s[0][t];
#pragma unroll
        for (int u = 1; u < U; ++u) mx[t] = fmaxf(mx[t], s[u][t]);
        grow = grow || (mx[t] > mm[t] + 8.0f); }
    if (__any(grow)) {
#pragma unroll
        for (int t = 0; t < 4; ++t) { const float mn = fmaxf(mm[t], mx[t]); const float al = ex2(mm[t] - mn); const float alo = __shfl_xor(al, 16); ll[t] *= al; mm[t] = mn;
#pragma unroll
            for (int d = 0; d < 4; ++d) { accA[t][d] *= al; accB[t][d] *= alo; } }
    }
    float p[U][4], po[U][4];
#pragma unroll
    for (int u = 0; u < U; ++u)
#pragma unroll
        for (int t = 0; t < 4; ++t) p[u][t] = ex2(s[u][t] - mm[t]);
#pragma unroll
    for (int u = 0; u < U; ++u)
#pragma unroll
        for (int t = 0; t < 4; ++t) po[u][t] = __shfl_xor(p[u][t], 16);
#pragma unroll
    for (int u = 0; u < U; ++u)
#pragma unroll
        for (int t = 0; t < 4; ++t) { ll[t] += p[u][t];
            accA[t][0] += p[u][t] * V[u].x; accA[t][1] += p[u][t] * V[u].y; accA[t][2] += p[u][t] * V[u].z; accA[t][3] += p[u][t] * V[u].w;
            accB[t][0] += po[u][t] * V[u].x; accB[t][1] += po[u][t] * V[u].y; accB[t][2] += po[u][t] * V[u].z; accB[t][3] += po[u][t] * V[u].w; }
}
constexpr int DEC_U = 4, DEC_R = 8;
template <int MODE> __device__ __forceinline__ void p_decode_split(const Ptrs& P, int wave, int lane, int G) {
    const int gw = blockIdx.x * NWAVES + wave, NGW = G * NWAVES;
    const bf16* qb = WSP(const bf16, WS_QB); const float* bt = WSP(const float, WS_BIAS); float* dpart = MODE == 0 ? WSP(float, WS_DPART) : WSP(float, WS_END + 16 * MiB);
    const float* ck = P.in[3]; const float* cv = P.in[4]; const int* ptab = (const int*)P.in[5];
    const int kq = lane >> 5, l32 = lane & 31, mp = (lane >> 4) & 1, off = 4 * l32;
    for (int it = gw; it < DB * NH * 16; it += NGW) {
        const int bh = it >> 4, chunk = it & 15, bs = bh >> 2, h = bh & 3;
        float qv[4][4];
#pragma unroll
        for (int t = 0; t < 4; ++t) { const unsigned long long w = *(const GAS unsigned long long*)(qb + (size_t)(MP + bs * DS + t) * 512 + h * 128 + off);
            qv[t][0] = bf_lo((unsigned)w); qv[t][1] = bf_hi((unsigned)w); qv[t][2] = bf_lo((unsigned)(w >> 32)); qv[t][3] = bf_hi((unsigned)(w >> 32)); }
        const float* bth = bt + h * DP_STRIDE; const float b31 = bth[128];
        const int j0 = chunk * 512;
        float mm[4], ll[4], accA[4][4], accB[4][4];
#pragma unroll
        for (int t = 0; t < 4; ++t) { mm[t] = -1e30f; ll[t] = 0.f;
#pragma unroll
            for (int d = 0; d < 4; ++d) { accA[t][d] = 0.f; accB[t][d] = 0.f; } }
        f32x4 Kb[DEC_R], Vb[DEC_R];
        const int pgv = ptab[bs * NPAGES + chunk * 4 + (lane & 3)];
        const int pg0 = __builtin_amdgcn_readlane(pgv, 0), pg1 = MODE == 2 ? pg0 : __builtin_amdgcn_readlane(pgv, 1), pg2 = MODE == 2 ? pg0 : __builtin_amdgcn_readlane(pgv, 2), pg3 = MODE == 2 ? pg0 : __builtin_amdgcn_readlane(pgv, 3);
#define DEC_PG(k_) ((k_) == 0 ? pg0 : (k_) == 1 ? pg1 : (k_) == 2 ? pg2 : pg3)
#define DEC_CBASE(c_) ((((size_t)DEC_PG((2 * DEC_R * (c_)) >> 7) * PAGE + (MODE == 2 ? 0 : ((2 * DEC_R * (c_)) & 127)) + kq) * NH + h) * 128 + off)
        { const size_t gb = DEC_CBASE(0);
#pragma unroll
          for (int j = 0; j < DEC_R; ++j) { Kb[j] = *(const GAS f32x4*)(ck + gb + (size_t)j * 1024); Vb[j] = *(const GAS f32x4*)(cv + gb + (size_t)j * 1024); } }
        constexpr int NCYC = 256 / DEC_R;
        for (int c = 0; c < NCYC; ++c) {
            const bool more = c + 1 < NCYC;
            const size_t gn = more ? DEC_CBASE(c + 1) : 0;
            const bool nearb = (j0 + 2 * DEC_R * c + 2 * DEC_R - 1 + 128 > PAST);
            const int relg = PAST - (j0 + 2 * DEC_R * c + kq);
#pragma unroll
            for (int j = 0; j < DEC_R; j += DEC_U) {
                if (MODE == 1) {
#pragma unroll
                    for (int u = 0; u < DEC_U; ++u) { accA[0][0] += Kb[j + u].x + Vb[j + u].x; accA[0][1] += Kb[j + u].y + Vb[j + u].y; accA[0][2] += Kb[j + u].z + Vb[j + u].z; accA[0][3] += Kb[j + u].w + Vb[j + u].w; } }
                else dec_step<DEC_U>(&Kb[j], &Vb[j], qv, mm, ll, accA, accB, nearb, b31, bth, relg - 2 * j);
                if (more) {
#pragma unroll
                    for (int u = 0; u < DEC_U; ++u) { Kb[j + u] = *(const GAS f32x4*)(ck + gn + (size_t)(j + u) * 1024); Vb[j + u] = *(const GAS f32x4*)(cv + gn + (size_t)(j + u) * 1024); } }
            }
        }
#undef DEC_CBASE
#undef DEC_PG
        float Mx[4];
#pragma unroll
        for (int t = 0; t < 4; ++t) { const float M = fmaxf(mm[t], __shfl_xor(mm[t], 32)); const float f = ex2(mm[t] - M); Mx[t] = M; const float fo = __shfl_xor(f, 16);
            float l = ll[t] * f; l += __shfl_xor(l, 32); ll[t] = l;
#pragma unroll
            for (int d = 0; d < 4; ++d) { float a = accA[t][d] * f; a += __shfl_xor(a, 32); accA[t][d] = a; float bq = accB[t][d] * fo; bq += __shfl_xor(bq, 32); accB[t][d] = bq; } }
        if (kq == 0) {
#pragma unroll
            for (int t = 0; t < 4; ++t) {
                float* pa = dpart + ((size_t)it * 8 + mp * 4 + t) * DP_STRIDE; float* pb = dpart + ((size_t)it * 8 + (1 - mp) * 4 + t) * DP_STRIDE;
                *(f32x4*)(pa + off) = (f32x4){accA[t][0], accA[t][1], accA[t][2], accA[t][3]};
                *(f32x4*)(pb + off) = (f32x4){accB[t][0], accB[t][1], accB[t][2], accB[t][3]};
                if ((lane & 15) == 0) { pa[128] = Mx[t]; pa[129] = ll[t]; }
            }
        }
    }
}
__device__ __forceinline__ void p_decode_combine(const Ptrs& P, int wave, int lane, int G) {
    const int gw = blockIdx.x * NWAVES + wave, NGW = G * NWAVES;
    const bf16* qb = WSP(const bf16, WS_QB); const float* bt = WSP(const float, WS_BIAS); const float* dpart = WSP(const float, WS_DPART); bf16* mix = WSP(bf16, WS_MIX);
    const float lam = *WSP(const float, WS_LAM);
    for (int it = gw; it < DB * NH * DS; it += NGW) {
        const int t = it & 3, bh = it >> 2, bs = bh >> 2, h = bh & 3; const int row = MP + bs * DS + t;
        float res[2][2];
#pragma unroll
        for (int map = 0; map < 2; ++map) {
            const float* pbase = dpart + ((size_t)bh * 16 * 8 + map * 4 + t) * DP_STRIDE;
            float mc = -1e30f, lc = 0.f;
            if (lane < 16) { mc = pbase[(size_t)lane * 8 * DP_STRIDE + 128]; lc = pbase[(size_t)lane * 8 * DP_STRIDE + 129]; }
            const float qd = __uint_as_float((unsigned)qb[(size_t)row * 512 + h * 128 + map * 64 + lane] << 16);
            float sn[4];
#pragma unroll
            for (int i = 0; i < 4; ++i) { const float kd = P.out[O_KS + (size_t)(bs * DS + i) * 512 + h * 128 + map * 64 + lane]; const float s = wave_sum(qd * kd);
                sn[i] = (i <= t) ? s + bt[h * DP_STRIDE + (t - i >= 0 ? t - i : 0)] : -1e30f; }
            float M = wave_max(mc); M = fmaxf(fmaxf(M, sn[0]), fmaxf(fmaxf(sn[1], sn[2]), sn[3]));
            const float wc = ex2(mc - M);
            float L = wave_sum(wc * lc); float pn[4];
#pragma unroll
            for (int i = 0; i < 4; ++i) { pn[i] = (i <= t) ? ex2(sn[i] - M) : 0.f; L += pn[i]; }
            float ox = 0.f, oy = 0.f;
            for (int c = 0; c < 16; ++c) { const float w = __shfl(wc, c); ox += w * pbase[(size_t)c * 8 * DP_STRIDE + lane]; oy += w * pbase[(size_t)c * 8 * DP_STRIDE + 64 + lane]; }
#pragma unroll
            for (int i = 0; i < 4; ++i) { const float* vr = P.out + O_VS + (size_t)(bs * DS + i) * 512 + h * 128; ox += pn[i] * vr[lane]; oy += pn[i] * vr[64 + lane]; }
            res[map][0] = ox / L; res[map][1] = oy / L;
        }
        const float ax = res[0][0] - lam * res[1][0], ay = res[0][1] - lam * res[1][1];
        const float ssq = wave_sum(ax * ax + ay * ay);
        const float rn = (1.0f - LAM_INIT) / sqrtf(ssq * (1.0f / 128.0f) + EPS);
        bf16* o = mix + (size_t)row * 1024 + 512 + h * 128;
        o[lane] = (bf16)f2bf(ax * rn * P.in[19][lane]); o[64 + lane] = (bf16)f2bf(ay * rn * P.in[19][64 + lane]);
    }
}


namespace fa {
typedef short bf16x8 __attribute__((ext_vector_type(8)));
typedef float f32x16 __attribute__((ext_vector_type(16)));
typedef short v4i16_t __attribute__((ext_vector_type(4)));
constexpr int KS = 272, VS = 320, KT_BYTES = 64 * KS, VT_BYTES = 64 * VS, STAGE = KT_BYTES + VT_BYTES;
constexpr int TBL_OFF = 2 * STAGE;
constexpr float THR = 8.0f;
static_assert(TBL_OFF + 132 * 4 <= RING_BYTES && 65536 <= TBL_OFF, "fa LDS map");
__device__ __forceinline__ float swap_max(float x) { auto rr = __builtin_amdgcn_permlane32_swap(__float_as_uint(x), __float_as_uint(x), false, false); return fmaxf(__uint_as_float(rr[0]), __uint_as_float(rr[1])); }
__device__ __forceinline__ float swap_sum(float x) { auto rr = __builtin_amdgcn_permlane32_swap(__float_as_uint(x), __float_as_uint(x), false, false); return __uint_as_float(rr[0]) + __uint_as_float(rr[1]); }
__device__ __forceinline__ unsigned cvtpk(float lo, float hi) { unsigned r; asm volatile("v_cvt_pk_bf16_f32 %0, %1, %2" : "=v"(r) : "v"(lo), "v"(hi)); return r; }
__device__ __forceinline__ bf16x8 pack_p(const f32x16& p, int base) { v4u w; w.x = cvtpk(p[base], p[base + 1]); w.y = cvtpk(p[base + 2], p[base + 3]); w.z = cvtpk(p[base + 4], p[base + 5]); w.w = cvtpk(p[base + 6], p[base + 7]); return __builtin_bit_cast(bf16x8, w); }
__device__ __forceinline__ bf16x8 vfrag(const LAS unsigned char* p) {
    const v4i16_t lo = __builtin_amdgcn_ds_read_tr16_b64_v4i16((LAS v4i16_t*)p), hi = __builtin_amdgcn_ds_read_tr16_b64_v4i16((LAS v4i16_t*)(p + 8 * VS));
    return (bf16x8){lo[0], lo[1], lo[2], lo[3], hi[0], hi[1], hi[2], hi[3]};
}

__device__ __forceinline__ void dattn_flash(const Ptrs& P, LAS unsigned char* lds, int wave, int lane, int G) {
    const int tid = threadIdx.x;
    const bf16* qb = WSP(const bf16, WS_QB); const bf16* kb = WSP(const bf16, WS_KB); const bf16* vb = WSP(const bf16, WS_VB); bf16* mix = WSP(bf16, WS_MIX);
    const float* bt = WSP(const float, WS_BIAS); const float lam = *WSP(const float, WS_LAM);
    const int r32 = lane & 31, hi = lane >> 5, c = wave & 1, rg = wave >> 1;
    const int bx = blockIdx.x; const int vcu = (G % 8 == 0) ? (bx % 8) * (G / 8) + bx / 8 : bx;
    LAS float* tbl = (LAS float*)(lds + TBL_OFF);
    LAS float* ex = (LAS float*)lds;
    const int srow = tid >> 4, sch = tid & 15;
    const unsigned kl = srow * KS + sch * 16, vl = KT_BYTES + srow * VS + sch * 16;
    const unsigned kfo = r32 * KS + (c * 64 + hi * 8) * 2;
    const unsigned vfo = KT_BYTES + (4 * hi + ((lane & 15) >> 2)) * VS + (16 * ((lane >> 4) & 1) + 4 * (lane & 3)) * 2;
    for (int item = vcu; item < 256; item += G) {
        const int bh = item >> 4, pi = item & 15, b = bh >> 2, h = bh & 3;
        const size_t rowbase = (size_t)b * SEQ;
        __syncthreads();
        if (tid < 132) tbl[tid] = bt[h * DP_STRIDE + tid];
        for (int half = 0; half < 2; ++half) {
            const int qblk = half == 0 ? pi : 31 - pi;
            const int q0 = qblk * 128, NT = (q0 + 128) >> 6, tnear = (q0 >> 6) - 2;
            const int qpos = q0 + 32 * rg + r32;
            bf16x8 qr[4];
            { const bf16* qp = qb + (rowbase + qpos) * 512 + h * 128 + c * 64 + hi * 8;
#pragma unroll
              for (int dc = 0; dc < 4; ++dc) qr[dc] = *(const GAS bf16x8*)(qp + dc * 16); }
            const bf16* kg = kb + (rowbase + srow) * 512 + h * 128 + sch * 8; const bf16* vg = vb + (rowbase + srow) * 512 + h * 128 + sch * 8;
            v4u kst[2], vst[2];
#define FA_LOADG(t_) do { _Pragma("unroll") for (int i_ = 0; i_ < 2; ++i_) { kst[i_] = *(const GAS v4u*)(kg + ((size_t)(t_) * 64 + 32 * i_) * 512); vst[i_] = *(const GAS v4u*)(vg + ((size_t)(t_) * 64 + 32 * i_) * 512); } } while (0)
#define FA_STORE(so_) do { _Pragma("unroll") for (int i_ = 0; i_ < 2; ++i_) { *(LAS v4u*)(lds + (so_) + kl + i_ * 32 * KS) = kst[i_]; *(LAS v4u*)(lds + (so_) + vl + i_ * 32 * VS) = vst[i_]; } } while (0)
            FA_LOADG(0); FA_STORE(0);
            __syncthreads();
            const float b31 = tbl[128];
            float m = -1e30f, l = 0.f;
            f32x16 o[4];
#pragma unroll
            for (int k = 0; k < 4; ++k)
#pragma unroll
                for (int r = 0; r < 16; ++r) o[k][r] = 0.f;
            for (int t = 0; t < NT; ++t) {
                const int st = (t & 1) * STAGE;
                if (t + 1 < NT) FA_LOADG(t + 1);
                f32x16 p0, p1;
#pragma unroll
                for (int r = 0; r < 16; ++r) { p0[r] = 0.f; p1[r] = 0.f; }
                const LAS unsigned char* kbp = lds + st + kfo;
#pragma unroll
                for (int dc = 0; dc < 4; ++dc) {
                    const bf16x8 a0 = *(const LAS bf16x8*)(kbp + dc * 32), a1 = *(const LAS bf16x8*)(kbp + 32 * KS + dc * 32);
                    p0 = __builtin_amdgcn_mfma_f32_32x32x16_bf16(a0, qr[dc], p0, 0, 0, 0);
                    p1 = __builtin_amdgcn_mfma_f32_32x32x16_bf16(a1, qr[dc], p1, 0, 0, 0);
                }
                if (t < tnear) {
#pragma unroll
                    for (int r = 0; r < 16; ++r) { p0[r] += b31; p1[r] += b31; }
                } else {
                    const int rb = qpos - t * 64 - 4 * hi;
#pragma unroll
                    for (int r = 0; r < 16; ++r) {
                        const int rel0 = rb - ((r & 3) + 8 * (r >> 2)), rel1 = rel0 - 32;
                        const float b0 = tbl[rel0 < 0 ? 0 : (rel0 < 128 ? rel0 : 128)], b1 = tbl[rel1 < 0 ? 0 : (rel1 < 128 ? rel1 : 128)];
                        p0[r] = rel0 < 0 ? -1e30f : p0[r] + b0; p1[r] = rel1 < 0 ? -1e30f : p1[r] + b1;
                    }
                }
                float mx = fmaxf(p0[0], p1[0]);
#pragma unroll
                for (int r = 1; r < 16; ++r) mx = fmaxf(mx, fmaxf(p0[r], p1[r]));
                mx = swap_max(mx);
                if (__any(mx > m + THR)) {
                    const float mn = fmaxf(m, mx); const float al = ex2(m - mn); l *= al; m = mn;
#pragma unroll
                    for (int k = 0; k < 4; ++k)
#pragma unroll
                        for (int r = 0; r < 16; ++r) o[k][r] *= al;
                }
                float ls = 0.f;
#pragma unroll
                for (int r = 0; r < 16; ++r) { p0[r] = ex2(p0[r] - m); p1[r] = ex2(p1[r] - m); ls += p0[r] + p1[r]; }
                l += ls;
                bf16x8 pa[4]; pa[0] = pack_p(p0, 0); pa[1] = pack_p(p0, 8); pa[2] = pack_p(p1, 0); pa[3] = pack_p(p1, 8);
                const LAS unsigned char* vbp = lds + st + vfo;
#pragma unroll
                for (int s = 0; s < 4; ++s)
#pragma unroll
                    for (int k = 0; k < 4; ++k) {
                        const bf16x8 vf = vfrag(vbp + (16 * s) * VS + k * 64);
                        o[k] = __builtin_amdgcn_mfma_f32_32x32x16_bf16(vf, pa[s], o[k], 0, 0, 0);
                    }
                if (t + 1 < NT) FA_STORE(((t + 1) & 1) * STAGE);
                __syncthreads();
            }
#undef FA_LOADG
#undef FA_STORE
            l = swap_sum(l);
            const float il = 1.0f / l;
            if (c == 1) {
#pragma unroll
                for (int k = 0; k < 4; ++k)
#pragma unroll
                    for (int r = 0; r < 16; ++r) ex[(rg * 64 + k * 16 + r) * 64 + lane] = o[k][r] * il;
            }
            __syncthreads();
            if (c == 0) {
                float ssq = 0.f;
#pragma unroll
                for (int k = 0; k < 4; ++k)
#pragma unroll
                    for (int r = 0; r < 16; ++r) { const float a = o[k][r] * il - lam * ex[(rg * 64 + k * 16 + r) * 64 + lane]; o[k][r] = a; ssq += a * a; }
                ssq = swap_sum(ssq);
                const float rn = (1.0f - LAM_INIT) / sqrtf(ssq * (1.0f / 128.0f) + EPS);
                bf16* orow = mix + (rowbase + qpos) * 1024 + 512 + h * 128;
#pragma unroll
                for (int k = 0; k < 4; ++k)
#pragma unroll
                    for (int g = 0; g < 4; ++g) {
                        const int dv0 = 32 * k + 8 * g + 4 * hi;
                        const f32x4 w = *(const GAS f32x4*)(P.in[19] + dv0);
                        const unsigned long long pk = (unsigned long long)pk2(o[k][4 * g] * rn * w.x, o[k][4 * g + 1] * rn * w.y) | ((unsigned long long)pk2(o[k][4 * g + 2] * rn * w.z, o[k][4 * g + 3] * rn * w.w) << 32);
                        *(GAS unsigned long long*)(orow + dv0) = pk;
                    }
            }
            __syncthreads();
        }
    }
}
}


namespace fx {
using fa::bf16x8; using fa::f32x16; using fa::v4i16_t;
constexpr int KS = 528, VS = 576, TK = 32, KT_BYTES = TK * KS, VT_BYTES = TK * VS, STAGE = KT_BYTES + VT_BYTES;
static_assert(2 * STAGE <= RING_BYTES, "fx LDS map");
__device__ __forceinline__ bf16x8 vfrag(const LAS unsigned char* p) {
    const v4i16_t lo = __builtin_amdgcn_ds_read_tr16_b64_v4i16((LAS v4i16_t*)p), hi = __builtin_amdgcn_ds_read_tr16_b64_v4i16((LAS v4i16_t*)(p + 8 * VS));
    return (bf16x8){lo[0], lo[1], lo[2], lo[3], hi[0], hi[1], hi[2], hi[3]};
}
__device__ __forceinline__ void xattn_flash(const Ptrs& P, LAS unsigned char* lds, int wave, int lane, int G) {
    const int tid = threadIdx.x;
    const bf16* qc = WSP(const bf16, WS_QC); const bf16* mkb = WSP(const bf16, WS_MKB); const bf16* mvb = WSP(const bf16, WS_MVB); bf16* oc = WSP(bf16, WS_OC);
    const int r32 = lane & 31, hi = lane >> 5, dvh = wave & 1, rg = wave >> 1;
    const int bx = blockIdx.x; const int vcu = (G % 8 == 0) ? (bx % 8) * (G / 8) + bx / 8 : bx;
    const int srow = tid >> 5, sch = tid & 31;
    const unsigned kl = srow * KS + sch * 16, vl = KT_BYTES + srow * VS + sch * 16;
    const unsigned kfo = r32 * KS + (hi * 8) * 2;
    const unsigned vfo = KT_BYTES + (4 * hi + ((lane & 15) >> 2)) * VS + (128 * dvh + 16 * ((lane >> 4) & 1) + 4 * (lane & 3)) * 2;
    constexpr int NT = NMEM / TK;
    const int nmy = vcu < 512 ? (512 - vcu + G - 1) / G : 0;
    const int ntl = nmy * NT;
    if (ntl == 0) return;
    v4u ks0[2], vs0[2], ks1[2], vs1[2];
#define FX_SRC(g_, kp_, vp_) const int un_ = vcu + ((g_) >> 3) * G, bh_ = un_ >> 5; const size_t ro_ = ((size_t)(bh_ >> 2) * NMEM + ((g_) & 7) * TK + srow) * 1024 + (bh_ & 3) * 256 + sch * 8; const bf16* kp_ = mkb + ro_; const bf16* vp_ = mvb + ro_;
#define FX_LOADG(g_, KS_, VS_) do { FX_SRC(g_, kp_, vp_) _Pragma("unroll") for (int i_ = 0; i_ < 2; ++i_) { KS_[i_] = *(const GAS v4u*)(kp_ + (size_t)(16 * i_) * 1024); VS_[i_] = *(const GAS v4u*)(vp_ + (size_t)(16 * i_) * 1024); } } while (0)
#define FX_STORE(so_, KS_, VS_) do { _Pragma("unroll") for (int i_ = 0; i_ < 2; ++i_) { *(LAS v4u*)(lds + (so_) + kl + i_ * 16 * KS) = KS_[i_]; *(LAS v4u*)(lds + (so_) + vl + i_ * 16 * VS) = VS_[i_]; } } while (0)
    float m = -1e30f, l = 0.f;
    f32x16 o[4];
    bf16x8 qr[16];
    size_t row = 0; int hcur = 0;
#define FX_TILE(g_, st_) do { \
        if (((g_) & 7) == 0) { const int un_ = vcu + ((g_) >> 3) * G, bh_ = un_ >> 5; hcur = bh_ & 3; row = (size_t)(bh_ >> 2) * SEQ + (un_ & 31) * 128 + 32 * rg + r32; \
            const bf16* qp_ = qc + row * 1024 + hcur * 256 + hi * 8; _Pragma("unroll") for (int dc = 0; dc < 16; ++dc) qr[dc] = *(const GAS bf16x8*)(qp_ + dc * 16); \
            m = -1e30f; l = 0.f; _Pragma("unroll") for (int k = 0; k < 4; ++k) _Pragma("unroll") for (int r = 0; r < 16; ++r) o[k][r] = 0.f; } \
        f32x16 p0; _Pragma("unroll") for (int r = 0; r < 16; ++r) p0[r] = 0.f; \
        const LAS unsigned char* kbp = lds + (st_) + kfo; \
        _Pragma("unroll") for (int dc = 0; dc < 16; ++dc) { const bf16x8 a0 = *(const LAS bf16x8*)(kbp + dc * 32); p0 = __builtin_amdgcn_mfma_f32_32x32x16_bf16(a0, qr[dc], p0, 0, 0, 0); } \
        float mx = p0[0]; _Pragma("unroll") for (int r = 1; r < 16; ++r) mx = fmaxf(mx, p0[r]); mx = fa::swap_max(mx); \
        if (__any(mx > m + fa::THR)) { const float mn = fmaxf(m, mx); const float al = ex2(m - mn); l *= al; m = mn; \
            _Pragma("unroll") for (int k = 0; k < 4; ++k) _Pragma("unroll") for (int r = 0; r < 16; ++r) o[k][r] *= al; } \
        float ls = 0.f; _Pragma("unroll") for (int r = 0; r < 16; ++r) { p0[r] = ex2(p0[r] - m); ls += p0[r]; } l += ls; \
        bf16x8 pa[2]; pa[0] = fa::pack_p(p0, 0); pa[1] = fa::pack_p(p0, 8); \
        const LAS unsigned char* vbp = lds + (st_) + vfo; \
        _Pragma("unroll") for (int s = 0; s < 2; ++s) _Pragma("unroll") for (int k = 0; k < 4; ++k) { const bf16x8 vf = vfrag(vbp + (16 * s) * VS + k * 64); o[k] = __builtin_amdgcn_mfma_f32_32x32x16_bf16(vf, pa[s], o[k], 0, 0, 0); } \
        if (((g_) & 7) == 7) { const float lt = fa::swap_sum(l); const float il = 1.0f / lt; bf16* orow = oc + row * 1024 + hcur * 256 + 128 * dvh; \
            _Pragma("unroll") for (int k = 0; k < 4; ++k) _Pragma("unroll") for (int gq = 0; gq < 4; ++gq) { const int dv0 = 32 * k + 8 * gq + 4 * hi; \
                const unsigned long long pk = (unsigned long long)pk2(o[k][4 * gq] * il, o[k][4 * gq + 1] * il) | ((unsigned long long)pk2(o[k][4 * gq + 2] * il, o[k][4 * gq + 3] * il) << 32); \
                *(GAS unsigned long long*)(orow + dv0) = pk; } } \
    } while (0)
    __syncthreads();
    FX_LOADG(0, ks0, vs0);
    if (ntl > 1) FX_LOADG(1, ks1, vs1);
    FX_STORE(0, ks0, vs0);
    __syncthreads();
    for (int g = 0; g < ntl; g += 2) {
        if (g + 2 < ntl) FX_LOADG(g + 2, ks0, vs0);
        FX_TILE(g, 0);
        FX_STORE(STAGE, ks1, vs1);
        __syncthreads();
        if (g + 3 < ntl) FX_LOADG(g + 3, ks1, vs1);
        FX_TILE(g + 1, STAGE);
        if (g + 2 < ntl) FX_STORE(0, ks0, vs0);
        __syncthreads();
    }
#undef FX_SRC
#undef FX_LOADG
#undef FX_STORE
#undef FX_TILE
}
}


__device__ __forceinline__ float sss_total(const float* sss, int srow, int fq) {
    const f32x4* sp = (const f32x4*)(sss + (size_t)srow * 64 + fq * 16);
    const f32x4 a = sp[0], b = sp[1], c = sp[2], d = sp[3];
    float t = ((a[0] + a[1]) + (a[2] + a[3])) + ((b[0] + b[1]) + (b[2] + b[3])) + ((c[0] + c[1]) + (c[2] + c[3])) + ((d[0] + d[1]) + (d[2] + d[3]));
    t += __shfl_xor(t, 16); t += __shfl_xor(t, 32); return t;
}
struct SIn {
    const float* r0; bf16* zconv; bf16* qb; bf16* kb; bf16* vb; float* out;
    __device__ __forceinline__ int arow(int i) const { return i; }
    __device__ __forceinline__ void put(int srow, int col, f32x4 v, int fq, int cb) const {
        const size_t row = (size_t)MP + srow; v = v * r0[row];
        if (col < 1536) { *(GAS unsigned long long*)(zconv + row * 1536 + col) = (unsigned long long)pk2(v[0], v[1]) | ((unsigned long long)pk2(v[2], v[3]) << 32); }
        else if (col < 2048) { v = v * QSC; *(GAS unsigned long long*)(qb + row * 512 + (col - 1536)) = (unsigned long long)pk2(v[0], v[1]) | ((unsigned long long)pk2(v[2], v[3]) << 32); }
        else { const bool isk = col < 2560; const int c = col - (isk ? 2048 : 2560);
            *(GAS unsigned long long*)((isk ? kb : vb) + row * 512 + c) = (unsigned long long)pk2(v[0], v[1]) | ((unsigned long long)pk2(v[2], v[3]) << 32);
            *(f32x4*)(out + (isk ? O_KS : O_VS) + (size_t)srow * 512 + c) = v; }
    }
};
template <bool RESBF> struct SRes {
    const void* res; float* xo; bf16* xob; float* sss;
    __device__ __forceinline__ int arow(int i) const { return i; }
    __device__ __forceinline__ void put(int srow, int col, f32x4 v, int fq, int cb) const {
        f32x4 r;
        if (RESBF) { const unsigned long long w = *(const GAS unsigned long long*)((const bf16*)res + (size_t)srow * 1024 + col); r = (f32x4){bf_lo((unsigned)w), bf_hi((unsigned)w), bf_lo((unsigned)(w >> 32)), bf_hi((unsigned)(w >> 32))}; }
        else r = *(const f32x4*)((const float*)res + (size_t)srow * 1024 + col);
        const f32x4 o = r + v;
        if (xo) *(f32x4*)(xo + (size_t)srow * 1024 + col) = o;
        if (xob) *(GAS unsigned long long*)(xob + (size_t)srow * 1024 + col) = (unsigned long long)pk2(o[0], o[1]) | ((unsigned long long)pk2(o[2], o[3]) << 32);
        float sq = (o[0] * o[0] + o[1] * o[1]) + (o[2] * o[2] + o[3] * o[3]);
        sq += __shfl_xor(sq, 16); sq += __shfl_xor(sq, 32);
        if (fq == 0) sss[(size_t)srow * 64 + cb] = sq;
    }
};
struct SScale {
    const float* sss; bf16* O; int ldc; float cs;
    __device__ __forceinline__ int arow(int i) const { return i; }
    __device__ __forceinline__ void put(int srow, int col, f32x4 v, int fq, int cb) const {
        const float tot = sss_total(sss, srow, fq);
        v = v * (cs / sqrtf(tot * (1.0f / 1024.0f) + EPS));
        *(GAS unsigned long long*)(O + (size_t)srow * ldc + col) = (unsigned long long)pk2(v[0], v[1]) | ((unsigned long long)pk2(v[2], v[3]) << 32);
    }
};
constexpr size_t WS_HALO = WS_DPART;
constexpr int BL_OFF = LDSCTL_OFF + 512;
static_assert(BL_OFF + 8192 <= LDS_BYTES && WS_DPART + 128 * 5632 * 4 <= WS_END, "EpiUp buffers");
struct SUp {
    const float* sss; bf16* O;
    __device__ __forceinline__ int arow(int i) const { return i; }
    __device__ __forceinline__ void put(int srow, int col, f32x4 v, int fq, int cb) const {
        const float tot = sss_total(sss, srow, fq);
        v = v * (1.0f / sqrtf(tot * (1.0f / 1024.0f) + EPS));
        *(GAS unsigned long long*)(O + (size_t)srow * DUP + up_orig(col)) = (unsigned long long)pk2(v[0], v[1]) | ((unsigned long long)pk2(v[2], v[3]) << 32);
    }
};
struct SHalo {
    const float* ss; float* HB;
    __device__ __forceinline__ int arow(int i) const { const int r = 256 * (i >> 1) - 2 + (i & 1); return r < 0 ? 0 : r; }
    __device__ __forceinline__ void put(int hidx, int col, f32x4 v, int fq, int cb) const {
        const f32x4 s4 = *(const f32x4*)(ss + (size_t)arow(hidx) * 16 + fq * 4);
        float tot = (s4[0] + s4[1]) + (s4[2] + s4[3]); tot += __shfl_xor(tot, 16); tot += __shfl_xor(tot, 32);
        *(f32x4*)(HB + (size_t)hidx * DUP + col) = v * (1.0f / sqrtf(tot * (1.0f / 1024.0f) + EPS));
    }
};
template <int CTRL> __device__ __forceinline__ f32x4 dpp4(const f32x4 v) { return (f32x4){dppf<CTRL>(v[0]), dppf<CTRL>(v[1]), dppf<CTRL>(v[2]), dppf<CTRL>(v[3])}; }
struct EpiUp {
    static constexpr bool PERM = true, AFTER_DRAIN = false;
    const float* ss; const float* cw; const float* cb; const float* HB; bf16* act; float* out; LAS float* bl;
    __device__ __forceinline__ void operator()(const f32x4 (&acc)[2][2][4][2], const pg8::Unit& u, int wr, int wc, int fr, int fq) const {
        const int pn = u.pn, pm = u.pm, jc = wc * 32 + 8 * fq;
        float rs[2][4];
#pragma unroll
        for (int ai = 0; ai < 2; ++ai)
#pragma unroll
            for (int m = 0; m < 4; ++m) rs[ai][m] = ss[pm * 256 + ai * 128 + wr * 64 + m * 16 + fr];
        if (fr >= 14) {
#pragma unroll
            for (int ai = 0; ai < 2; ++ai)
#pragma unroll
                for (int bj = 0; bj < 2; ++bj)
#pragma unroll
                    for (int n = 0; n < 2; ++n) *(LAS f32x4*)(bl + ((ai * 2 + wr) * 2 + (fr - 14)) * 256 + bj * 128 + jc + 4 * n) = acc[ai][bj][3][n] * rs[ai][3];
        }
        asm volatile("s_waitcnt lgkmcnt(0)\n\ts_barrier" ::: "memory");
#pragma unroll
        for (int n = 0; n < 2; ++n) {
            const int gcol = 128 * pn + jc + 4 * n, ucol = DFF + gcol;
            const f32x4 wg0 = *(const f32x4*)(cw + gcol), wg1 = *(const f32x4*)(cw + DUP + gcol), wg2 = *(const f32x4*)(cw + 2 * DUP + gcol), bg = *(const f32x4*)(cb + gcol);
            const f32x4 wu0 = *(const f32x4*)(cw + ucol), wu1 = *(const f32x4*)(cw + DUP + ucol), wu2 = *(const f32x4*)(cw + 2 * DUP + ucol), bu = *(const f32x4*)(cb + ucol);
#pragma unroll
            for (int ai = 0; ai < 2; ++ai) {
                const int B = ai * 2 + wr;
                f32x4 pg = (f32x4){0.f, 0.f, 0.f, 0.f}, pu = pg;
                if (fr >= 14) {
                    if (B >= 1) { const LAS float* bp = bl + ((B - 1) * 2 + (fr - 14)) * 256 + jc + 4 * n; pg = *(const LAS f32x4*)bp; pu = *(const LAS f32x4*)(bp + 128); }
                    else if ((pm & 15) != 0) { const float* hp = HB + (size_t)(pm * 2 + (fr - 14)) * DUP + pn * 256 + jc + 4 * n; pg = *(const f32x4*)hp; pu = *(const f32x4*)(hp + 128); }
                }
                f32x4 lg1 = dpp4<0x121>(pg), lg2 = dpp4<0x122>(pg), lu1 = dpp4<0x121>(pu), lu2 = dpp4<0x122>(pu);
#pragma unroll
                for (int m = 0; m < 4; ++m) {
                    const f32x4 g0 = acc[ai][0][m][n] * rs[ai][m], u0 = acc[ai][1][m][n] * rs[ai][m];
                    const f32x4 sg1 = dpp4<0x121>(g0), sg2 = dpp4<0x122>(g0), su1 = dpp4<0x121>(u0), su2 = dpp4<0x122>(u0);
                    const f32x4 g1 = fr >= 1 ? sg1 : lg1, g2 = fr >= 2 ? sg2 : lg2, u1 = fr >= 1 ? su1 : lu1, u2 = fr >= 2 ? su2 : lu2;
                    const f32x4 gc = bg + wg0 * g2 + wg1 * g1 + wg2 * g0, uc = bu + wu0 * u2 + wu1 * u1 + wu2 * u0;
                    f32x4 a;
#pragma unroll
                    for (int i = 0; i < 4; ++i) a[i] = gc[i] * uc[i] * __builtin_amdgcn_rcpf(1.0f + ex2(-LOG2E * gc[i]));
                    const size_t row = (size_t)pm * 256 + ai * 128 + wr * 64 + m * 16 + fr;
                    *(GAS unsigned long long*)(act + row * DFF + gcol) = (unsigned long long)pk2(a[0], a[1]) | ((unsigned long long)pk2(a[2], a[3]) << 32);
                    if (m == 3 && B == 3 && (pm & 15) == 15 && fr >= 14) {
                        float* o = out + O_CFP + (size_t)((pm >> 4) * 2 + (fr - 14)) * DUP; *(f32x4*)(o + gcol) = g0; *(f32x4*)(o + ucol) = u0; }
                    lg1 = sg1; lg2 = sg2; lu1 = su1; lu2 = su2;
                }
            }
        }
    }
};
template <class SE> __device__ __forceinline__ void sgemm(const bf16* A, const bf16* Bt, int N, int K, const SE& E, LAS unsigned char* lds, int wave, int lane, int G, int wgoff) {
    const int fr = lane & 15, fq = lane >> 4;
    const int ncb = N >> 6, nunits = 2 * ncb;
    const int kper = K >> 3, nks = kper >> 5, kw0 = wave * kper;
    int vb = (int)blockIdx.x - wgoff; if (vb < 0) vb += G;
    for (int u = vb; u < nunits; u += G) {
        const int rbk = u & 1, cbk = u >> 1;
        const bf16* ap[4]; const bf16* bp[4];
#pragma unroll
        for (int i = 0; i < 4; ++i) { ap[i] = A + (size_t)E.arow(rbk * 64 + i * 16 + fr) * K + kw0 + fq * 8; bp[i] = Bt + (size_t)(cbk * 64 + i * 16 + fr) * K + kw0 + fq * 8; }
        f32x4 acc[4][4];
#pragma unroll
        for (int i = 0; i < 4; ++i)
#pragma unroll
            for (int j = 0; j < 4; ++j) acc[i][j] = (f32x4){0.f, 0.f, 0.f, 0.f};
        for (int c0 = 0; c0 < nks; c0 += 4) {
            bf16x8 af[4][4], bfr[4][4];
#pragma unroll
            for (int s = 0; s < 4; ++s) if (c0 + s < nks) {
#pragma unroll
                for (int i = 0; i < 4; ++i) { af[s][i] = *(const GAS bf16x8*)(ap[i] + (c0 + s) * 32); bfr[s][i] = *(const GAS bf16x8*)(bp[i] + (c0 + s) * 32); } }
#pragma unroll
            for (int s = 0; s < 4; ++s) if (c0 + s < nks) {
#pragma unroll
                for (int i = 0; i < 4; ++i)
#pragma unroll
                    for (int j = 0; j < 4; ++j) acc[i][j] = __builtin_amdgcn_mfma_f32_16x16x32_bf16(bfr[s][j], af[s][i], acc[i][j], 0, 0, 0); }
        }
#pragma unroll
        for (int i = 0; i < 4; ++i)
#pragma unroll
            for (int j = 0; j < 4; ++j) *(LAS f32x4*)(lds + (size_t)(((wave * 16 + i * 4 + j) * 64 + lane) * 16)) = acc[i][j];
        __syncthreads();
#pragma unroll
        for (int tt = 0; tt < 2; ++tt) {
            const int tile = 2 * wave + tt, ti = tile >> 2, tj = tile & 3;
            f32x4 v = *(const LAS f32x4*)(lds + (size_t)(((0 * 16 + tile) * 64 + lane) * 16));
#pragma unroll
            for (int w2 = 1; w2 < 8; ++w2) v = v + *(const LAS f32x4*)(lds + (size_t)(((w2 * 16 + tile) * 64 + lane) * 16));
            E.put(rbk * 64 + ti * 16 + fr, cbk * 64 + tj * 16 + 4 * fq, v, fq, cbk * 4 + tj);
        }
        __syncthreads();
    }
}

constexpr int N_PHASES = 12;
#ifndef PROBE_REPS
#define PROBE_REPS {1,1,1,1,1,1,1,1,1,1,1,1}
#endif
constexpr int REPS[N_PHASES] = PROBE_REPS;
struct Args { const float* in[32]; float* out; unsigned char* ws; int ph_lo, ph_hi; };
__global__ void __launch_bounds__(NWAVES * 64, 2) mega_fwd(Args args) {
    extern __shared__ __attribute__((aligned(16))) unsigned char lds[];
    LAS unsigned char* L = (LAS unsigned char*)lds;
    volatile LAS unsigned* MISC = (volatile LAS unsigned*)(L + MISC_OFF);
    const int tid = threadIdx.x, lane = tid & 63, wave = __builtin_amdgcn_readfirstlane(tid >> 6);
    const int G = gridDim.x;
    Ptrs P;
#pragma unroll
    for (int i = 0; i < 32; ++i) P.in[i] = args.in[i];
    P.out = args.out; P.ws = args.ws;
    for (int u = tid; u < (LDS_BYTES - LDSCTL_OFF) / 4; u += NWAVES * 64) ((LAS unsigned*)(L + LDSCTL_OFF))[u] = 0u;
    __syncthreads();
    gu32* ctl = (gu32*)(P.ws + WS_CTL);
    XcdBarrier bar; bar.bar = (unsigned*)(ctl + CW_BAR); bar.x = 0; bar.st = nullptr;
#if !MK_PER_PHASE
    bar = xcd_barrier_post((unsigned*)(ctl + CW_BAR), MISC + 8);
#endif
    const int lo = args.ph_lo, hi = args.ph_hi;
#define IN(k) (lo <= (k) && (k) < hi)
#define SEAM(k) do { if (IN(k) && IN((k) + 1)) xcd_barrier(bar); } while (0)

    if (IN(0)) _Pragma("unroll") for (int rr_ = 0; rr_ < REPS[0]; ++rr_) { if (rr_) xcd_barrier(bar); p0_prologue(P, L, wave, lane, G); }
    SEAM(0);
    if (IN(1)) _Pragma("unroll") for (int rr_ = 0; rr_ < REPS[1]; ++rr_) { if (rr_) xcd_barrier(bar);
        { pg8::Gemm g{WSP(const bf16, WS_XB), WSP(const bf16, WS_WIN), MP, DIN, DM}; pg8::StaticOrder S; S.init(MP, DIN, G, (int)blockIdx.x);
          pg8::EpiIn E{WSP(const float, WS_R0), WSP(bf16, WS_ZCONV), WSP(bf16, WS_QB), WSP(bf16, WS_KB), WSP(bf16, WS_VB), P.out};
          pg8::gemm_phase<pg8::EpiIn, pg8::StaticOrder, true, true>(L + RING_OFF, g, S, E); }
        { SIn SE{WSP(const float, WS_R0), WSP(bf16, WS_ZCONV), WSP(bf16, WS_QB), WSP(bf16, WS_KB), WSP(bf16, WS_VB), P.out};
          sgemm<SIn>(WSP(const bf16, WS_XB) + (size_t)MP * DM, WSP(const bf16, WS_WIN), DIN, DM, SE, L + RING_OFF, wave, lane, G, 32); }
        { pg8::Gemm g{WSP(const bf16, WS_MEMB), WSP(const bf16, WS_WCKV), NB * NMEM, 2 * DM, DM}; pg8::StaticOrder S; S.init(NB * NMEM, 2 * DM, G, (int)blockIdx.x);
          pg8::EpiMem E{WSP(const float, WS_RMEM), WSP(bf16, WS_MKB), WSP(bf16, WS_MVB), P.out};
          pg8::gemm_phase<pg8::EpiMem, pg8::StaticOrder, true, true>(L + RING_OFF, g, S, E); }
    }
    SEAM(1);
    if (IN(2)) {
        const bool g1 = ((blockIdx.x >> 3) & 1) == 0;
        if (g1) { p_decode_split<0>(P, wave, lane, G); p_convmix(P, wave, lane, G); }
        fa::dattn_flash(P, L, wave, lane, G);
        if (!g1) { p_convmix(P, wave, lane, G); p_decode_split<0>(P, wave, lane, G); }
    }
    SEAM(2);
    if (IN(3)) _Pragma("unroll") for (int rr_ = 0; rr_ < REPS[3]; ++rr_) { if (rr_) xcd_barrier(bar); p_decode_combine(P, wave, lane, G); }
    SEAM(3);
    if (IN(4)) _Pragma("unroll") for (int rr_ = 0; rr_ < REPS[4]; ++rr_) { if (rr_) xcd_barrier(bar); pg8::Gemm g{WSP(const bf16, WS_MIX), WSP(const bf16, WS_WOUT), MP, DM, DM}; pg8::StaticOrder S; S.init(MP, DM, G, (int)blockIdx.x);
        pg8::EpiRes<false> E{P.in[0], nullptr, WSP(bf16, WS_X1B), WSP(float, WS_SS1)};
        pg8::gemm_phase<pg8::EpiRes<false>, pg8::StaticOrder, true, true>(L + RING_OFF, g, S, E);
        SRes<false> SE{P.in[1], nullptr, WSP(bf16, WS_X1B) + (size_t)MP * DM, WSP(float, WS_SSS1)};
        sgemm<SRes<false>>(WSP(const bf16, WS_MIX) + (size_t)MP * DM, WSP(const bf16, WS_WOUT), DM, DM, SE, L + RING_OFF, wave, lane, G, 0); }
    SEAM(4);
    if (IN(5)) _Pragma("unroll") for (int rr_ = 0; rr_ < REPS[5]; ++rr_) { if (rr_) xcd_barrier(bar); pg8::Gemm g{WSP(const bf16, WS_X1B), WSP(const bf16, WS_WCQ), MP, DM, DM}; pg8::StaticOrder S; S.init(MP, DM, G, (int)blockIdx.x);
        pg8::EpiScale E{WSP(const float, WS_SS1), WSP(bf16, WS_QC), DM, CQSC};
        pg8::gemm_phase<pg8::EpiScale, pg8::StaticOrder, true, true>(L + RING_OFF, g, S, E);
        SScale SE{WSP(const float, WS_SSS1), WSP(bf16, WS_QC) + (size_t)MP * DM, DM, CQSC};
        sgemm<SScale>(WSP(const bf16, WS_X1B) + (size_t)MP * DM, WSP(const bf16, WS_WCQ), DM, DM, SE, L + RING_OFF, wave, lane, G, 0); }
    SEAM(5);
    if (IN(6)) _Pragma("unroll") for (int rr_ = 0; rr_ < REPS[6]; ++rr_) { if (rr_) xcd_barrier(bar); p_xattn_sample(P, L, wave, lane, G, 0); fx::xattn_flash(P, L, wave, lane, G); }
    SEAM(6);
    if (IN(7)) _Pragma("unroll") for (int rr_ = 0; rr_ < REPS[7]; ++rr_) { if (rr_) xcd_barrier(bar); pg8::Gemm g{WSP(const bf16, WS_OC), WSP(const bf16, WS_WCO), MP, DM, DM}; pg8::StaticOrder S; S.init(MP, DM, G, (int)blockIdx.x);
        pg8::EpiRes<true> E{WSP(const bf16, WS_X1B), nullptr, WSP(bf16, WS_X2B), WSP(float, WS_SS2)};
        pg8::gemm_phase<pg8::EpiRes<true>, pg8::StaticOrder, true, true>(L + RING_OFF, g, S, E);
        SRes<true> SE{WSP(const bf16, WS_X1B) + (size_t)MP * DM, nullptr, WSP(bf16, WS_X2B) + (size_t)MP * DM, WSP(float, WS_SSS2)};
        sgemm<SRes<true>>(WSP(const bf16, WS_OC) + (size_t)MP * DM, WSP(const bf16, WS_WCO), DM, DM, SE, L + RING_OFF, wave, lane, G, 0); }
    SEAM(7);
    if (IN(8)) _Pragma("unroll") for (int rr_ = 0; rr_ < REPS[8]; ++rr_) { if (rr_) xcd_barrier(bar);
        { const float* ss2 = WSP(const float, WS_SS2); float* r2 = WSP(float, WS_R0);
          for (int row = blockIdx.x * (NWAVES * 64) + tid; row < MP; row += G * NWAVES * 64) { const f32x4* sp = (const f32x4*)(ss2 + (size_t)row * 16); const f32x4 s0 = sp[0], s1 = sp[1], s2 = sp[2], s3 = sp[3];
              const float tot = ((s0[0] + s0[1]) + (s0[2] + s0[3])) + ((s1[0] + s1[1]) + (s1[2] + s1[3])) + ((s2[0] + s2[1]) + (s2[2] + s2[3])) + ((s3[0] + s3[1]) + (s3[2] + s3[3]));
              r2[row] = 1.0f / sqrtf(tot * (1.0f / 1024.0f) + EPS); } }
        SHalo SH{WSP(const float, WS_SS2), WSP(float, WS_HALO)};
        sgemm<SHalo>(WSP(const bf16, WS_X2B), WSP(const bf16, WS_WUP), DUP, DM, SH, L + RING_OFF, wave, lane, G, 0);
        SUp SE{WSP(const float, WS_SSS2), WSP(bf16, WS_UPB) + (size_t)MP * DUP};
        sgemm<SUp>(WSP(const bf16, WS_X2B) + (size_t)MP * DM, WSP(const bf16, WS_WUP), DUP, DM, SE, L + RING_OFF, wave, lane, G, 176); }
    SEAM(8);
    if (IN(9)) _Pragma("unroll") for (int rr_ = 0; rr_ < REPS[9]; ++rr_) { if (rr_) xcd_barrier(bar); pg8::Gemm g{WSP(const bf16, WS_X2B), WSP(const bf16, WS_WUP), MP, DUP, DM}; pg8::StaticOrder S; S.init(MP, DUP, G, (int)blockIdx.x);
        EpiUp E{WSP(const float, WS_R0), P.in[28], P.in[29], WSP(const float, WS_HALO), WSP(bf16, WS_ACT), P.out, (LAS float*)(L + BL_OFF)};
        pg8::gemm_phase<EpiUp, pg8::StaticOrder, true, true>(L + RING_OFF, g, S, E);
        p_convffn(P, wave, lane, G); }
    SEAM(9);
    if (IN(10)) _Pragma("unroll") for (int rr_ = 0; rr_ < REPS[10]; ++rr_) { if (rr_) xcd_barrier(bar); pg8::Gemm g{WSP(const bf16, WS_ACT), WSP(const bf16, WS_WDOWN), MP, DM, DFF}; pg8::StaticOrder S; S.init(MP, DM, G, (int)blockIdx.x);
        pg8::EpiRes<true> E{WSP(const bf16, WS_X2B), WSP(float, WS_X3), nullptr, WSP(float, WS_SS3)};
        pg8::gemm_phase<pg8::EpiRes<true>, pg8::StaticOrder, true, true>(L + RING_OFF, g, S, E);
        SRes<true> SE{WSP(const bf16, WS_X2B) + (size_t)MP * DM, WSP(float, WS_X3) + (size_t)MP * DM, nullptr, WSP(float, WS_SSS3)};
        sgemm<SRes<true>>(WSP(const bf16, WS_ACT) + (size_t)MP * DFF, WSP(const bf16, WS_WDOWN), DM, DFF, SE, L + RING_OFF, wave, lane, G, 0); }
    SEAM(10);
    if (IN(11)) _Pragma("unroll") for (int rr_ = 0; rr_ < REPS[11]; ++rr_) { if (rr_) xcd_barrier(bar); p_final(P, wave, lane, G); }
#undef IN
#undef SEAM
}

extern "C" void kernel_launch(void* const* d_in, const int* in_sizes, int n_in, void* d_out, int out_size, void* d_ws, size_t ws_size, hipStream_t stream) {
    static int grid = 0;
    if (grid == 0) {
        if (n_in != 32 || out_size != (int)O_END || ws_size < WS_END) { fprintf(stderr, "kernel_launch: unexpected shapes: n_in %d out %d ws %zu\n", n_in, out_size, ws_size); grid = -1; return; }
        int dev = 0, cus = 0, per_cu = 0;
        if (hipGetDevice(&dev) != hipSuccess || hipDeviceGetAttribute(&cus, hipDeviceAttributeMultiprocessorCount, dev) != hipSuccess) { grid = -1; return; }
        if (hipFuncSetAttribute((const void*)mega_fwd, hipFuncAttributeMaxDynamicSharedMemorySize, LDS_BYTES) != hipSuccess) { fprintf(stderr, "kernel_launch: hipFuncSetAttribute failed\n"); grid = -1; return; }
        if (hipOccupancyMaxActiveBlocksPerMultiprocessor(&per_cu, (const void*)mega_fwd, NWAVES * 64, LDS_BYTES) != hipSuccess || per_cu < 1) fprintf(stderr, "kernel_launch: occupancy query reports %d\n", per_cu);
        (void)hipGetLastError();
        grid = cus;
    }
    if (grid < 0) return;
    if (hipMemsetAsync((char*)d_ws + WS_CTL, 0, CTL_ZERO_BYTES, stream) != hipSuccess) return;
    Args a{};
    for (int i = 0; i < 32; ++i) a.in[i] = (const float*)d_in[i];
    a.out = (float*)d_out; a.ws = (unsigned char*)d_ws;
#if MK_PER_PHASE
    for (int p = 0; p < N_PHASES; ++p) { a.ph_lo = p; a.ph_hi = p + 1; hipLaunchKernelGGL(mega_fwd, dim3(grid), dim3(NWAVES * 64), LDS_BYTES, stream, a); }
#else
    a.ph_lo = 0; a.ph_hi = N_PHASES; hipLaunchKernelGGL(mega_fwd, dim3(grid), dim3(NWAVES * 64), LDS_BYTES, stream, a);
#endif
}
```

```cpp
#include <hip/hip_runtime.h>
#include <cstdio>
#include <cstdint>

#ifndef MK_PER_PHASE
#define MK_PER_PHASE 0
#endif

constexpr int DM = 1024, NB = 4, SEQ = 4096, MP = NB * SEQ;
constexpr int DB = 32, DS = 4, MS = DB * DS;
constexpr int MREAL = MP + MS, MT = 16640;
constexpr int PAST = 8192, PAGE = 128, NPAGES = PAST / PAGE;
constexpr int DCONV = 512, NH = 4, HDK = 64, HDV = 128, DATT = 512, DIN = 3072;
constexpr int NMEM = 256, MHEADS = 4, MDH = 256, DFF = 2816, DUP = 2 * DFF;
constexpr float EPS = 1e-6f, LOG2E = 1.4426950408889634f;
constexpr float QSC = 0.125f * LOG2E;
constexpr float CQSC = 0.0625f * LOG2E;
constexpr float LAM_INIT = 0.2f;
constexpr size_t O_Y = 0, O_YS = 16777216, O_KP = 16908288, O_VP = 25296896, O_KS = 33685504, O_VS = 33751040,
                 O_CMP = 33816576, O_CMS = 33820672, O_CFP = 33853440, O_CFS = 33898496, O_MK = 34258944, O_MV = 35307520, O_END = 36356096;
namespace pg8 {
#define PG8_LAS __attribute__((address_space(3)))
typedef unsigned short bf16_t;
typedef short bf16x8 __attribute__((ext_vector_type(8)));
typedef float f32x4 __attribute__((ext_vector_type(4)));
typedef unsigned u32x4 __attribute__((ext_vector_type(4)));
constexpr int BM = 256, BK = 64, HALF = 128, HTB = HALF * BK * 2  , STAGE_BYTES = 8 * HTB, NXCD = 8, WGM = 8;

__host__ __device__ __forceinline__ int lds_byte(int r, int c) { const int st = (r >> 4) * 2 + (c >> 5), rr = r & 15, cc = c & 31, ob = rr * 64 + cc * 2; return st * 1024 + (ob ^ (((ob >> 9) & 1) << 5)); }
__host__ __device__ __forceinline__ void stage_rc(int b, int& R, int& C) { const int st = b / 1024, sb = b % 1024, swz = sb ^ (((sb >> 9) & 1) << 5); R = (st >> 1) * 16 + swz / 64; C = (st & 1) * 32 + (swz % 64) / 2; }
__host__ __device__ __forceinline__ int perm32(int rho) { const int n = rho >> 4, i = rho & 15; return 8 * (i >> 2) + 4 * n + (i & 3); }

struct Unit { int pm, pn; };
struct Gemm { const bf16_t* A; const bf16_t* Bt; int M, N, K; };

struct StaticOrder {
    int nM, nN, nwg, G, c;
    __host__ __device__ void init(int M, int N, int G_, int c_) { nM = M / BM; nN = N / BM; nwg = nM * nN; G = G_; c = c_; }
    __host__ __device__ __forceinline__ bool next(int i, Unit& u) const {
        const long L = (long)i * G + c; if (L >= nwg) return false;
        int wgid = (int)L; { const int q = nwg / NXCD, r = nwg % NXCD, xcd = wgid % NXCD, off = wgid / NXCD; wgid = (xcd < r ? xcd * (q + 1) : r * (q + 1) + (xcd - r) * q) + off; }
        const int nig = WGM * nN, gid = wgid / nig, fm = gid * WGM, gsz = (nM - fm) < WGM ? (nM - fm) : WGM;
        u.pm = fm + ((wgid % nig) % gsz); u.pn = (wgid % nig) / gsz; return true;
    }
    __device__ __forceinline__ void a_ready(const Unit&) const {}
    __device__ __forceinline__ void done(const Unit&) const {}
};

__device__ __forceinline__ unsigned cvt_pk_bf16(float lo, float hi) { unsigned r; asm volatile("v_cvt_pk_bf16_f32 %0, %1, %2" : "=v"(r) : "v"(lo), "v"(hi)); return r; }
__device__ __forceinline__ u32x4 pack8(const f32x4 a, const f32x4 b) { u32x4 w; w.x = cvt_pk_bf16(a[0], a[1]); w.y = cvt_pk_bf16(a[2], a[3]); w.z = cvt_pk_bf16(b[0], b[1]); w.w = cvt_pk_bf16(b[2], b[3]); return w; }
__device__ __forceinline__ float dot4(const f32x4 a) { return (a[0] * a[0] + a[1] * a[1]) + (a[2] * a[2] + a[3] * a[3]); }

struct EpiIn {
    static constexpr bool PERM = true, AFTER_DRAIN = false;
    const float* r0; bf16_t* zconv; bf16_t* qb; bf16_t* kb; bf16_t* vb; float* out;
    __device__ __forceinline__ void operator()(const f32x4 (&acc)[2][2][4][2], const Unit& u, int wr, int wc, int fr, int fq) const {
        const int pn = u.pn;
        float rsv[2][4];
#pragma unroll
        for (int ai = 0; ai < 2; ++ai)
#pragma unroll
            for (int m = 0; m < 4; ++m) rsv[ai][m] = r0[u.pm * BM + ai * HALF + wr * 64 + m * 16 + fr];
#pragma unroll
        for (int ai = 0; ai < 2; ++ai)
#pragma unroll
            for (int m = 0; m < 4; ++m) {
                const int row = u.pm * BM + ai * HALF + wr * 64 + m * 16 + fr;
                {
                    const float rs = rsv[ai][m];
#pragma unroll
                    for (int bj = 0; bj < 2; ++bj) {
                        const int col = pn * BM + bj * HALF + wc * 32 + 8 * fq;
                        const f32x4 v0 = acc[ai][bj][m][0] * rs, v1 = acc[ai][bj][m][1] * rs;
                        if (pn < 6) { *(u32x4*)(zconv + (size_t)row * 1536 + col) = pack8(v0, v1); }
                        else if (pn < 8) { *(u32x4*)(qb + (size_t)row * 512 + (col - 1536)) = pack8(v0 * QSC, v1 * QSC); }
                        else { const bool isk = pn < 10; const int c = col - (isk ? 2048 : 2560);
                            *(u32x4*)((isk ? kb : vb) + (size_t)row * 512 + c) = pack8(v0, v1);
                            float* o = out + (isk ? O_KP : O_VP) + (size_t)row * 512 + c;
                            *(f32x4*)o = v0; *(f32x4*)(o + 4) = v1; }
                    }
                }
            }
    }
};
struct EpiMem {
    static constexpr bool PERM = true, AFTER_DRAIN = false;
    const float* rmem; bf16_t* mkb; bf16_t* mvb; float* out;
    __device__ __forceinline__ void operator()(const f32x4 (&acc)[2][2][4][2], const Unit& u, int wr, int wc, int fr, int fq) const {
        const int pn = u.pn; const bool isk = pn < 4;
#pragma unroll
        for (int ai = 0; ai < 2; ++ai)
#pragma unroll
            for (int m = 0; m < 4; ++m) {
                const int row = u.pm * BM + ai * HALF + wr * 64 + m * 16 + fr;
                const float rs = rmem[row];
#pragma unroll
                for (int bj = 0; bj < 2; ++bj) {
                    const int col = (pn & 3) * BM + bj * HALF + wc * 32 + 8 * fq;
                    const f32x4 v0 = acc[ai][bj][m][0] * rs, v1 = acc[ai][bj][m][1] * rs;
                    *(u32x4*)((isk ? mkb : mvb) + (size_t)row * 1024 + col) = pack8(v0, v1);
                    float* o = out + (isk ? O_MK : O_MV) + (size_t)row * 1024 + col;
                    *(f32x4*)o = v0; *(f32x4*)(o + 4) = v1;
                }
            }
    }
};
template <bool RESBF> struct EpiRes {
    static_assert(RESBF, "the residual stream is bf16");
    static constexpr bool PERM = true, AFTER_DRAIN = false;
    const void* res; float* xo; bf16_t* xob; float* ss;
    __device__ __forceinline__ void operator()(const f32x4 (&acc)[2][2][4][2], const Unit& u, int wr, int wc, int fr, int fq) const {
        const int pn = u.pn;
#pragma unroll
        for (int ai = 0; ai < 2; ++ai) {
        u32x4 rv[4][2];
#pragma unroll
            for (int m = 0; m < 4; ++m)
#pragma unroll
                for (int bj = 0; bj < 2; ++bj) rv[m][bj] = *(const u32x4*)((const bf16_t*)res + (size_t)(u.pm * BM + ai * HALF + wr * 64 + m * 16 + fr) * 1024 + pn * BM + bj * HALF + wc * 32 + 8 * fq);
#pragma unroll
            for (int m = 0; m < 4; ++m) {
                const int row = u.pm * BM + ai * HALF + wr * 64 + m * 16 + fr;
                float sq = 0.f;
#pragma unroll
                for (int bj = 0; bj < 2; ++bj) {
                    const int col = pn * BM + bj * HALF + wc * 32 + 8 * fq;
                    const u32x4 w = rv[m][bj];
                    const f32x4 a = (f32x4){__uint_as_float(w.x << 16), __uint_as_float(w.x & 0xffff0000u), __uint_as_float(w.y << 16), __uint_as_float(w.y & 0xffff0000u)};
                    const f32x4 b = (f32x4){__uint_as_float(w.z << 16), __uint_as_float(w.z & 0xffff0000u), __uint_as_float(w.w << 16), __uint_as_float(w.w & 0xffff0000u)};
                    const f32x4 o0 = a + acc[ai][bj][m][0], o1 = b + acc[ai][bj][m][1];
                    if (xo) { float* xp = xo + (size_t)row * 1024 + col; *(f32x4*)xp = o0; *(f32x4*)(xp + 4) = o1; }
                    if (xob) *(u32x4*)(xob + (size_t)row * 1024 + col) = pack8(o0, o1);
                    sq += dot4(o0) + dot4(o1);
                }
                sq += __shfl_xor(sq, 16); sq += __shfl_xor(sq, 32);
                if (fq == 0) ss[(size_t)row * 16 + pn * 4 + wc] = sq;
            }
        }
    }
};
#define PG8_LASF __attribute__((address_space(3))) float
struct EpiScale {
    static constexpr bool PERM = true, AFTER_DRAIN = false;
    const PG8_LASF* rl; bf16_t* O; int ldc;
    __device__ __forceinline__ void operator()(const f32x4 (&acc)[2][2][4][2], const Unit& u, int wr, int wc, int fr, int fq) const {
        const int pn = u.pn;
#pragma unroll
        for (int ai = 0; ai < 2; ++ai)
#pragma unroll
            for (int m = 0; m < 4; ++m) {
                const int trow = ai * HALF + wr * 64 + m * 16 + fr; const int row = u.pm * BM + trow;
                const float rs = rl[trow];
#pragma unroll
                for (int bj = 0; bj < 2; ++bj) {
                    const int col = pn * BM + bj * HALF + wc * 32 + 8 * fq;
                    *(u32x4*)(O + (size_t)row * ldc + col) = pack8(acc[ai][bj][m][0] * rs, acc[ai][bj][m][1] * rs);
                }
            }
    }
};
template <class E, class = void> struct aperm_v { static constexpr bool value = false; };
template <class E> struct aperm_v<E, decltype((void)E::APERM)> { static constexpr bool value = E::APERM; };
template <class Epi, class Sched, bool ALIGN_EPI = false, bool SP2 = false>
__device__ __forceinline__ void gemm_phase(PG8_LAS unsigned char* lds, const Gemm g, const Sched& S, const Epi& E) {
    const int tid = threadIdx.x, wid = __builtin_amdgcn_readfirstlane(tid >> 6), lane = tid & 63, wr = wid >> 2, wc = wid & 3, fr = lane & 15, fq = lane >> 4;
    const int K = g.K, nt = K / BK;
    unsigned voffA[2], voffB[2];
#pragma unroll
    for (int i = 0; i < 2; ++i) { int R, C; stage_rc(tid * 16 + i * 8192, R, C); const int Rb = Epi::PERM ? ((R & ~31) + perm32(R & 31)) : R;
        const int Ra = aperm_v<Epi>::value ? ((R & 64) | ((R & 15) << 2) | ((R >> 4) & 3)) : R;
        voffA[i] = (unsigned)(Ra * K + C) * 2u; voffB[i] = (unsigned)(Rb * K + C) * 2u; }
    const size_t kstep = (size_t)(BK * 2);
    const size_t hstep = (size_t)HALF * K * 2;
    const size_t tstep = 2 * hstep;
    const unsigned ldsw = (unsigned)wid * 1024u;
    const int aoff = lds_byte(wr * 64 + fr, fq * 8), boff = lds_byte(wc * 32 + fr, fq * 8);
#define PG8_SA(b, h) (((b) * 2 + (h)) * HTB)
#define PG8_SB(b, h) ((4 + (b) * 2 + (h)) * HTB)
#define PG8_STAGE(bufoff, gbase, voff) do { _Pragma("unroll") for (int _i = 0; _i < 2; ++_i) \
        __builtin_amdgcn_global_load_lds((const unsigned*)((const char*)(gbase) + (voff)[_i]), (PG8_LAS unsigned*)(lds + (bufoff) + ldsw + _i * 8192), 16, 0, 0); } while (0)
#define PG8_LDA(dst, b, h) do { _Pragma("unroll") for (int m = 0; m < 4; ++m) _Pragma("unroll") for (int k = 0; k < 2; ++k) dst[m][k] = *(const PG8_LAS bf16x8*)(lds + PG8_SA(b, h) + aoff + m * 2048 + k * 1024); } while (0)
#define PG8_LDB(dst, b, h) do { _Pragma("unroll") for (int n = 0; n < 2; ++n) _Pragma("unroll") for (int k = 0; k < 2; ++k) dst[n][k] = *(const PG8_LAS bf16x8*)(lds + PG8_SB(b, h) + boff + n * 2048 + k * 1024); } while (0)
#define PG8_MMA(ai, bj, At, Bt) do { __builtin_amdgcn_s_setprio(1); _Pragma("unroll") for (int m = 0; m < 4; ++m) _Pragma("unroll") for (int n = 0; n < 2; ++n) _Pragma("unroll") for (int k = 0; k < 2; ++k) \
        acc[ai][bj][m][n] = __builtin_amdgcn_mfma_f32_16x16x32_bf16(Bt[n][k], At[m][k], acc[ai][bj][m][n], 0, 0, 0); __builtin_amdgcn_s_setprio(0); } while (0)
#define PG8_WAIT_V(n) asm volatile("s_waitcnt vmcnt(" #n ")" ::: "memory")
#define PG8_WAIT_L(n) asm volatile("s_waitcnt lgkmcnt(" #n ")" ::: "memory")
#define PG8_BAR __builtin_amdgcn_s_barrier()
#define PG8_SCHED __builtin_amdgcn_sched_barrier(0)
    Unit cur, nxt; int ui = 0;
    if (!S.next(0, cur)) return;
    f32x4 acc[2][2][4][2];
#pragma unroll
    for (int a = 0; a < 2; ++a)
#pragma unroll
        for (int b = 0; b < 2; ++b)
#pragma unroll
            for (int m = 0; m < 4; ++m)
#pragma unroll
                for (int n = 0; n < 2; ++n) acc[a][b][m][n] = (f32x4){0.f, 0.f, 0.f, 0.f};
    bf16x8 At[4][2], B0[2][2], B1[2][2];
    const char* cA = (const char*)g.A + (size_t)cur.pm * tstep; const char* cB = (const char*)g.Bt + (size_t)cur.pn * tstep;
    S.a_ready(cur);
    if constexpr (SP2) {
        PG8_STAGE(PG8_SB(0, 0), cB, voffB); PG8_STAGE(PG8_SB(0, 1), cB + hstep, voffB); PG8_STAGE(PG8_SA(0, 0), cA, voffA); PG8_STAGE(PG8_SA(0, 1), cA + hstep, voffA);
        if (wr == 1) PG8_BAR;
        PG8_WAIT_V(2); PG8_BAR;
        PG8_STAGE(PG8_SB(1, 0), cB + kstep, voffB); PG8_STAGE(PG8_SA(1, 0), cA + kstep, voffA); PG8_STAGE(PG8_SB(1, 1), cB + hstep + kstep, voffB);
        PG8_WAIT_V(6); PG8_BAR;
    } else {
        PG8_STAGE(PG8_SB(0, 0), cB, voffB); PG8_STAGE(PG8_SA(0, 0), cA, voffA); PG8_STAGE(PG8_SB(0, 1), cB + hstep, voffB); PG8_STAGE(PG8_SA(0, 1), cA + hstep, voffA);
        if (wr == 1) PG8_BAR;
        PG8_WAIT_V(4); PG8_BAR;
        PG8_STAGE(PG8_SB(1, 0), cB + kstep, voffB); PG8_STAGE(PG8_SA(1, 0), cA + kstep, voffA); PG8_STAGE(PG8_SB(1, 1), cB + hstep + kstep, voffB);
        PG8_WAIT_V(6); PG8_BAR;
    }
    for (;;) {
        const bool has_next = S.next(ui + 1, nxt);
        const char* nA = has_next ? (const char*)g.A + (size_t)nxt.pm * tstep : cA; const char* nB = has_next ? (const char*)g.Bt + (size_t)nxt.pn * tstep : cB;
        for (int t = 0; t < nt; t += 2) {
            const bool last = (t == nt - 2);
            const char* a1 = cA + (size_t)(t + 1) * kstep;
            const char* a2 = last ? nA : cA + (size_t)(t + 2) * kstep; const char* b2 = last ? nB : cB + (size_t)(t + 2) * kstep;
            const char* a3 = a2 + kstep; const char* b3 = b2 + kstep;
            if (last && has_next) S.a_ready(nxt);
            if constexpr (SP2) {
            PG8_LDB(B0, 0, 0); PG8_LDB(B1, 0, 1); PG8_SCHED; PG8_LDA(At, 0, 0); PG8_STAGE(PG8_SA(1, 1), a1 + hstep, voffA);
            PG8_WAIT_V(8); PG8_WAIT_L(0); PG8_BAR; PG8_MMA(0, 0, At, B0); PG8_MMA(0, 1, At, B1); PG8_BAR; PG8_SCHED;
            PG8_LDA(At, 0, 1); PG8_STAGE(PG8_SB(0, 0), b2, voffB); PG8_STAGE(PG8_SB(0, 1), b2 + hstep, voffB); PG8_STAGE(PG8_SA(0, 0), a2, voffA);
            PG8_WAIT_V(8); PG8_WAIT_L(0); PG8_BAR; PG8_MMA(1, 0, At, B0); PG8_MMA(1, 1, At, B1); PG8_BAR; PG8_SCHED;
            PG8_LDB(B0, 1, 0); PG8_LDB(B1, 1, 1); PG8_SCHED; PG8_LDA(At, 1, 0); PG8_STAGE(PG8_SA(0, 1), a2 + hstep, voffA);
            PG8_WAIT_V(8); PG8_WAIT_L(0); PG8_BAR; PG8_MMA(0, 0, At, B0); PG8_MMA(0, 1, At, B1); PG8_BAR; PG8_SCHED;
            PG8_LDA(At, 1, 1); PG8_STAGE(PG8_SB(1, 0), b3, voffB); PG8_STAGE(PG8_SB(1, 1), b3 + hstep, voffB); PG8_STAGE(PG8_SA(1, 0), a3, voffA);
            PG8_WAIT_V(8); PG8_WAIT_L(0); PG8_BAR; PG8_MMA(1, 0, At, B0); PG8_MMA(1, 1, At, B1); PG8_BAR; PG8_SCHED;
            } else {
            PG8_LDB(B0, 0, 0); PG8_SCHED; PG8_LDA(At, 0, 0); PG8_STAGE(PG8_SA(1, 1), a1 + hstep, voffA);
            PG8_WAIT_L(8); PG8_BAR; PG8_WAIT_L(0); PG8_MMA(0, 0, At, B0); PG8_BAR; PG8_SCHED;
            PG8_LDB(B1, 0, 1); PG8_STAGE(PG8_SB(0, 0), b2, voffB);
            PG8_BAR; PG8_WAIT_L(0); PG8_MMA(0, 1, At, B1); PG8_BAR;
            PG8_LDA(At, 0, 1); PG8_STAGE(PG8_SA(0, 0), a2, voffA);
            PG8_BAR; PG8_WAIT_L(0); PG8_MMA(1, 0, At, B0); PG8_BAR; PG8_SCHED;
            PG8_STAGE(PG8_SB(0, 1), b2 + hstep, voffB);
            PG8_WAIT_V(6); PG8_BAR; PG8_MMA(1, 1, At, B1); PG8_BAR;
            PG8_LDB(B0, 1, 0); PG8_SCHED; PG8_LDA(At, 1, 0); PG8_STAGE(PG8_SA(0, 1), a2 + hstep, voffA);
            PG8_WAIT_L(8); PG8_BAR; PG8_WAIT_L(0); PG8_MMA(0, 0, At, B0); PG8_BAR; PG8_SCHED;
            PG8_LDB(B1, 1, 1); PG8_STAGE(PG8_SB(1, 0), b3, voffB);
            PG8_BAR; PG8_WAIT_L(0); PG8_MMA(0, 1, At, B1); PG8_BAR;
            PG8_LDA(At, 1, 1); PG8_STAGE(PG8_SA(1, 0), a3, voffA);
            PG8_BAR; PG8_WAIT_L(0); PG8_MMA(1, 0, At, B0); PG8_BAR; PG8_SCHED;
            PG8_STAGE(PG8_SB(1, 1), b3 + hstep, voffB);
            PG8_WAIT_V(6); PG8_BAR; PG8_MMA(1, 1, At, B1); PG8_BAR;
            }
        }
        if constexpr (ALIGN_EPI) { if (wr == 0) PG8_BAR; }
        if constexpr (!Epi::AFTER_DRAIN) { E(acc, cur, wr, wc, fr, fq); S.done(cur); }
        if (!has_next) break;
#pragma unroll
        for (int a = 0; a < 2; ++a)
#pragma unroll
            for (int b = 0; b < 2; ++b)
#pragma unroll
                for (int m = 0; m < 4; ++m)
#pragma unroll
                    for (int n = 0; n < 2; ++n) acc[a][b][m][n] = (f32x4){0.f, 0.f, 0.f, 0.f};
        cur = nxt; cA = nA; cB = nB; ++ui;
        if constexpr (ALIGN_EPI) { if (wr == 1) PG8_BAR; }
    }
    PG8_WAIT_V(0);
    if constexpr (!ALIGN_EPI) { if (wr == 0) PG8_BAR; }
    PG8_BAR;
    if constexpr (Epi::AFTER_DRAIN) { E.fused(acc, cur, wr, wc, fr, fq, lds, wid, lane); S.done(cur); }
#undef PG8_SA
#undef PG8_SB
#undef PG8_STAGE
#undef PG8_LDA
#undef PG8_LDB
#undef PG8_MMA
#undef PG8_WAIT_V
#undef PG8_WAIT_L
#undef PG8_BAR
#undef PG8_SCHED
}
}
#define GAS __attribute__((address_space(1)))
#define LAS __attribute__((address_space(3)))
typedef unsigned short bf16;
typedef unsigned v4u __attribute__((ext_vector_type(4)));
typedef float f32x4 __attribute__((ext_vector_type(4)));
typedef short bf16x8 __attribute__((ext_vector_type(8)));
typedef GAS unsigned gu32;
typedef GAS unsigned long long gu64;
#define RLX_AGENT __ATOMIC_RELAXED, __HIP_MEMORY_SCOPE_AGENT
#define LDS_WAIT() asm volatile("s_waitcnt lgkmcnt(0)" ::: "memory")
#define VM_WAIT() asm volatile("s_waitcnt vmcnt(0)" ::: "memory")
__device__ __forceinline__ unsigned long long rt() { return __builtin_amdgcn_s_memrealtime(); }
__device__ __forceinline__ unsigned f2bf(float f) { unsigned u = __builtin_bit_cast(unsigned, f); return (u + 0x7fffu + ((u >> 16) & 1u)) >> 16; }
__device__ __forceinline__ unsigned pk2(float lo, float hi) { return f2bf(lo) | (f2bf(hi) << 16); }

#define XB_TMO      128
#define XB_XCNT(j)  (256  + 64 * (j))
#define XB_XSUB(j)  (1280 + 64 * (j))
#define XB_XGEN(j)  (2304 + 64 * (j))
#define XB_TOP      3328
#define XB_TOPGEN   3392
#define XCD_BAR_WORDS 3456
#define XB_SPIN_CAP (1u << 18)

__device__ __forceinline__ unsigned xb_ld(unsigned* p)              { return __hip_atomic_load(p, __ATOMIC_RELAXED, __HIP_MEMORY_SCOPE_AGENT); }
__device__ __forceinline__ unsigned xb_add(unsigned* p, unsigned v) { return __hip_atomic_fetch_add(p, v, __ATOMIC_RELAXED, __HIP_MEMORY_SCOPE_AGENT); }
__device__ __forceinline__ unsigned xb_xcc_id() { return (unsigned)__builtin_amdgcn_s_getreg((3 << 11) | 20) & 0xFu; }
#define XB_SPIN(cond, bar) do { unsigned _sp = 0; while (cond) { __builtin_amdgcn_s_sleep(1); \
    if ((++_sp & 255u) == 0u) { if (xb_ld(&(bar)[XB_TMO])) break; if (_sp > XB_SPIN_CAP) { atomicAdd(&(bar)[XB_TMO], 1u); break; } } } } while (0)

struct XcdBarrier {
    unsigned* bar; unsigned x;
    volatile LAS unsigned* st;
};

__device__ __forceinline__ XcdBarrier xcd_barrier_post(unsigned* bar, volatile LAS unsigned* st) {
    XcdBarrier b; b.bar = bar; b.x = xb_xcc_id(); b.st = st;
    if (threadIdx.x == 0) (void)xb_add(&bar[XB_XCNT(b.x)], 1u);
    return b;
}
__device__ __forceinline__ void xcd_barrier_complete(unsigned* bar, unsigned x, unsigned& nloc, unsigned& nx) {
    const unsigned G = gridDim.x * gridDim.y * gridDim.z;
    unsigned sum, cnt, mine, sp = 0u;
    for (;;) {
        sum = 0u; cnt = 0u; mine = 0u;
#pragma unroll
        for (unsigned j = 0; j < 16; ++j) { const unsigned c = xb_ld(&bar[XB_XCNT(j)]); sum += c; cnt += (c > 0u) ? 1u : 0u; mine = (j == x) ? c : mine; }
        if (sum == G) break;
        __builtin_amdgcn_s_sleep(1);
        if ((++sp & 255u) == 0u) { if (xb_ld(&bar[XB_TMO])) break; if (sp > XB_SPIN_CAP) { atomicAdd(&bar[XB_TMO], 1u); break; } }
    }
    nloc = mine > 0u ? mine : 1u; nx = cnt > 0u ? cnt : 1u;
}

__device__ __forceinline__ void xcd_barrier(const XcdBarrier& b) {
    asm volatile("s_waitcnt vmcnt(0)" ::: "memory");
    __syncthreads();
    if (threadIdx.x == 0) {
        unsigned* bar = b.bar;
        __builtin_amdgcn_s_waitcnt(0);
        unsigned nloc = b.st[0], nx = b.st[1];
        if (nloc == 0u) { xcd_barrier_complete(bar, b.x, nloc, nx); b.st[0] = nloc; b.st[1] = nx; }
        const unsigned old = xb_add(&bar[XB_XSUB(b.x)], 1u);
        const unsigned gen = old / nloc;
        if (old + 1u == (gen + 1u) * nloc) {
            __builtin_amdgcn_fence(__ATOMIC_RELEASE, "agent");
            asm volatile("s_waitcnt vmcnt(0)" ::: "memory");
            const unsigned og = xb_add(&bar[XB_TOP], 1u);
            const unsigned tg = og / nx;
            if (og + 1u == (tg + 1u) * nx) xb_add(&bar[XB_TOPGEN], 1u);
            else XB_SPIN(xb_ld(&bar[XB_TOPGEN]) == tg, bar);
            __builtin_amdgcn_fence(__ATOMIC_ACQUIRE, "agent");
            xb_add(&bar[XB_XGEN(b.x)], 1u);
            asm volatile("s_waitcnt vmcnt(0)" ::: "memory");
        } else {
            XB_SPIN(xb_ld(&bar[XB_XGEN(b.x)]) == gen, bar);
            __builtin_amdgcn_fence(__ATOMIC_ACQUIRE, "agent");
            asm volatile("s_waitcnt vmcnt(0)" ::: "memory");
        }
    }
    __syncthreads();
}


constexpr size_t MiB = 1u << 20;
constexpr size_t WS_CTL = 0, CTL_ZERO_BYTES = 1 * MiB;
constexpr size_t WS_BIAS = 1 * MiB, WS_LAM = 1 * MiB + 4096, WS_RMEM = 1 * MiB + 8192, WS_R0 = 1 * MiB + 65536;
constexpr size_t WS_SS1 = 2 * MiB, WS_SS2 = 4 * MiB, WS_SS3 = 6 * MiB;
constexpr size_t WS_WIN = 8 * MiB, WS_WOUT = 14 * MiB, WS_WCQ = 16 * MiB, WS_WCKV = 18 * MiB, WS_WCO = 22 * MiB, WS_WUP = 24 * MiB, WS_WDOWN = 36 * MiB;
constexpr size_t WS_MEMB = 42 * MiB, WS_MKB = 44 * MiB, WS_MVB = 46 * MiB;
constexpr size_t WS_XB = 48 * MiB, WS_ZCONV = 82 * MiB, WS_QB = 132 * MiB, WS_KB = 149 * MiB, WS_VB = 166 * MiB, WS_MIX = 184 * MiB;
constexpr size_t WS_X1 = 218 * MiB, WS_X1B = 284 * MiB, WS_QC = 317 * MiB, WS_OC = 350 * MiB, WS_X2 = 383 * MiB, WS_X2B = 449 * MiB;
constexpr size_t WS_UPB = 482 * MiB, WS_ACT = 661 * MiB, WS_X3 = 751 * MiB, WS_DPART = 817 * MiB, WS_END = 826 * MiB;
constexpr size_t WS_SSS1 = 1 * MiB + 256 * 1024, WS_SSS2 = WS_SSS1 + 32768, WS_SSS3 = WS_SSS2 + 32768;
constexpr int CW_BAR = 4096;
constexpr int DP_STRIDE = 132;

constexpr int RING_OFF = 0, RING_BYTES = 131072;
constexpr int LDSCTL_OFF = RING_BYTES, MISC_OFF = LDSCTL_OFF + 320;
constexpr int LDS_BYTES = 147456;
constexpr int NWAVES = 8;

__device__ __forceinline__ float wave_sum(float v) {
#pragma unroll
    for (int o = 1; o < 64; o <<= 1) v += __shfl_xor(v, o);
    return v;
}
__device__ __forceinline__ float wave_max(float v) {
#pragma unroll
    for (int o = 1; o < 64; o <<= 1) v = fmaxf(v, __shfl_xor(v, o));
    return v;
}
__device__ __forceinline__ float bf_lo(unsigned w) { return __uint_as_float(w << 16); }
__device__ __forceinline__ float bf_hi(unsigned w) { return __uint_as_float(w & 0xffff0000u); }
__device__ __forceinline__ void unpack8(const v4u w, float (&f)[8]) { f[0] = bf_lo(w.x); f[1] = bf_hi(w.x); f[2] = bf_lo(w.y); f[3] = bf_hi(w.y); f[4] = bf_lo(w.z); f[5] = bf_hi(w.z); f[6] = bf_lo(w.w); f[7] = bf_hi(w.w); }
__device__ __forceinline__ v4u pack8f(const float (&f)[8]) { v4u o; o.x = pk2(f[0], f[1]); o.y = pk2(f[2], f[3]); o.z = pk2(f[4], f[5]); o.w = pk2(f[6], f[7]); return o; }
template <int CTRL> __device__ __forceinline__ float dppf(float x) { return __int_as_float(__builtin_amdgcn_update_dpp(0, __float_as_int(x), CTRL, 0xF, 0xF, true)); }
__device__ __forceinline__ float ex2(float x) { return __builtin_amdgcn_exp2f(x); }
__device__ __forceinline__ int t5_bucket(int n) {
    if (n < 16) return n;
    const int b = 16 + (int)(__log2f((float)n * 0.0625f) * (16.0f / 3.0f));
    return b < 31 ? b : 31;
}

__device__ __host__ __forceinline__ int up_orig(int np) { const int t = np >> 8, j = np & 255; return j < 128 ? 128 * t + j : DFF + 128 * t + (j - 128); }
template <bool UPPERM = false> __device__ __forceinline__ void transpose_item(const float* W, int K, int N, bf16* WT, const float* ksc, LAS float* scr, int item, int lane) {
    const int nblk = N / 32, kb = item / nblk, nb = item % nblk, k0 = 64 * kb, n0 = 32 * nb; const int ns0 = UPPERM ? up_orig(n0) : n0;
#pragma unroll 8
    for (int i = 0; i < 32; ++i) { const int kk = 2 * i + (lane >> 5); const float sc = ksc ? ksc[k0 + kk] : 1.0f; scr[kk * 33 + (lane & 31)] = W[(size_t)(k0 + kk) * N + ns0 + (lane & 31)] * sc; }
    LDS_WAIT(); asm volatile("" ::: "memory");
    const int c = lane & 7;
#pragma unroll
    for (int j = 0; j < 4; ++j) { const int n = (lane >> 3) + 8 * j; const LAS float* s = scr + (8 * c) * 33 + n;
        v4u o; o.x = pk2(s[0 * 33], s[1 * 33]); o.y = pk2(s[2 * 33], s[3 * 33]); o.z = pk2(s[4 * 33], s[5 * 33]); o.w = pk2(s[6 * 33], s[7 * 33]);
        *(GAS v4u*)(WT + (size_t)(n0 + n) * K + k0 + 8 * c) = o; }
    LDS_WAIT(); asm volatile("" ::: "memory");
}
__device__ __forceinline__ void rms_row(const float* xrow, bf16* orow, float* rout, int lane) {
    const GAS f32x4* xr = (const GAS f32x4*)xrow + lane;
    f32x4 v[4]; float s = 0.f;
#pragma unroll
    for (int j = 0; j < 4; ++j) { v[j] = xr[64 * j]; s += (v[j].x * v[j].x + v[j].y * v[j].y) + (v[j].z * v[j].z + v[j].w * v[j].w); }
    s = wave_sum(s);
    if (lane == 0) *rout = 1.0f / sqrtf(s * (1.0f / 1024.0f) + EPS);
    GAS unsigned long long* o8 = (GAS unsigned long long*)orow + lane;
#pragma unroll
    for (int j = 0; j < 4; ++j) o8[64 * j] = (unsigned long long)pk2(v[j].x, v[j].y) | ((unsigned long long)pk2(v[j].z, v[j].w) << 32);
}
struct Ptrs {
    const float* in[32]; float* out; unsigned char* ws;
};
#define WSP(T, off) ((T*)(P.ws + (off)))

__device__ __forceinline__ void p0_prologue(const Ptrs& P, LAS unsigned char* lds, int wave, int lane, int G) {
    LAS float* scr = (LAS float*)(lds + RING_OFF + wave * 16384);
    const int gw = blockIdx.x * NWAVES + wave, NGW = G * NWAVES;
    constexpr int I_IN = 16 * 96, I_OUT = 16 * 32, I_CQ = 16 * 32, I_CKV = 16 * 64, I_CO = 16 * 32, I_UP = 16 * 176, I_DOWN = 44 * 32;
    constexpr int NITEMS = I_IN + I_OUT + I_CQ + I_CKV + I_CO + I_UP + I_DOWN;
    for (int it = gw; it < NITEMS; it += NGW) {
        int r = it;
        if (r < I_IN) { transpose_item(P.in[12], 1024, 3072, WSP(bf16, WS_WIN), P.in[11], scr, r, lane); continue; } r -= I_IN;
        if (r < I_OUT) { transpose_item(P.in[20], 1024, 1024, WSP(bf16, WS_WOUT), nullptr, scr, r, lane); continue; } r -= I_OUT;
        if (r < I_CQ) { transpose_item(P.in[23], 1024, 1024, WSP(bf16, WS_WCQ), P.in[21], scr, r, lane); continue; } r -= I_CQ;
        if (r < I_CKV) { transpose_item(P.in[24], 1024, 2048, WSP(bf16, WS_WCKV), P.in[22], scr, r, lane); continue; } r -= I_CKV;
        if (r < I_CO) { transpose_item(P.in[25], 1024, 1024, WSP(bf16, WS_WCO), nullptr, scr, r, lane); continue; } r -= I_CO;
        if (r < I_UP) { transpose_item<true>(P.in[27], 1024, 5632, WSP(bf16, WS_WUP), P.in[26], scr, r, lane); continue; } r -= I_UP;
        transpose_item(P.in[30], 2816, 1024, WSP(bf16, WS_WDOWN), nullptr, scr, r, lane);
    }
    bf16* xb = WSP(bf16, WS_XB); float* r0 = WSP(float, WS_R0);
    for (int m = gw; m < MT; m += NGW) {
        if (m < MREAL) { const float* src = m < MP ? P.in[0] + (size_t)m * DM : P.in[1] + (size_t)(m - MP) * DM; rms_row(src, xb + (size_t)m * DM, r0 + m, lane); }
        else { GAS unsigned long long* o8 = (GAS unsigned long long*)(xb + (size_t)m * DM) + lane;
#pragma unroll
            for (int j = 0; j < 4; ++j) o8[64 * j] = 0ull;
            if (lane == 0) r0[m] = 0.f; }
    }
    bf16* memb = WSP(bf16, WS_MEMB); float* rmem = WSP(float, WS_RMEM);
    for (int m = gw; m < NB * NMEM; m += NGW) rms_row(P.in[2] + (size_t)m * DM, memb + (size_t)m * DM, rmem + m, lane);
    if (blockIdx.x == 0) {
        float* bt = WSP(float, WS_BIAS);
        for (int idx = threadIdx.x; idx < 4 * DP_STRIDE; idx += NWAVES * 64) { const int h = idx / DP_STRIDE, n = idx % DP_STRIDE; const int bk = n < 128 ? t5_bucket(n) : 31; bt[idx] = P.in[10][bk * 4 + h] * LOG2E; }
        if (wave == 0) { const float a = wave_sum(P.in[15][lane] * P.in[16][lane]), b = wave_sum(P.in[17][lane] * P.in[18][lane]);
            if (lane == 0) *WSP(float, WS_LAM) = expf(a) - expf(b) + LAM_INIT; }
    }
}

__device__ __forceinline__ void p_convmix(const Ptrs& P, int wave, int lane, int G) {
    const int gw = blockIdx.x * NWAVES + wave, NGW = G * NWAVES;
    const bf16* zc = WSP(const bf16, WS_ZCONV); bf16* mix = WSP(bf16, WS_MIX);
    const int ch = lane * 8;
    float w0[8], w1[8], w2[8], bb[8];
#pragma unroll
    for (int i = 0; i < 8; ++i) { w0[i] = P.in[13][ch + i]; w1[i] = P.in[13][512 + ch + i]; w2[i] = P.in[13][1024 + ch + i]; bb[i] = P.in[14][ch + i]; }
    constexpr int NPI = MP / 16;
    for (int it = gw; it < NPI + DB; it += NGW) {
        float p2[8], p1[8];
        int row0, nrow, t0, bidx; const bool prompt = it < NPI;
        if (prompt) { row0 = it * 16; nrow = 16; t0 = row0 % SEQ; bidx = row0 / SEQ;
            if (t0 == 0) {
#pragma unroll
                for (int i = 0; i < 8; ++i) { p2[i] = 0.f; p1[i] = 0.f; } }
            else { float c[8], u[8];
                unpack8(*(const GAS v4u*)(zc + (size_t)(row0 - 2) * 1536 + 512 + ch), c); unpack8(*(const GAS v4u*)(zc + (size_t)(row0 - 2) * 1536 + 1024 + ch), u);
#pragma unroll
                for (int i = 0; i < 8; ++i) p2[i] = c[i] * u[i];
                unpack8(*(const GAS v4u*)(zc + (size_t)(row0 - 1) * 1536 + 512 + ch), c); unpack8(*(const GAS v4u*)(zc + (size_t)(row0 - 1) * 1536 + 1024 + ch), u);
#pragma unroll
                for (int i = 0; i < 8; ++i) p1[i] = c[i] * u[i]; } }
        else { bidx = it - NPI; row0 = MP + bidx * DS; nrow = DS; t0 = 0;
            const float* st = P.in[6] + (size_t)bidx * 2 * DCONV;
#pragma unroll
            for (int i = 0; i < 8; ++i) { p2[i] = st[ch + i]; p1[i] = st[DCONV + ch + i]; } }
        for (int r = 0; r < nrow; ++r) {
            const size_t row = (size_t)(row0 + r);
            float bv[8], c[8], u[8], pre[8], y[8];
            unpack8(*(const GAS v4u*)(zc + row * 1536 + ch), bv); unpack8(*(const GAS v4u*)(zc + row * 1536 + 512 + ch), c); unpack8(*(const GAS v4u*)(zc + row * 1536 + 1024 + ch), u);
#pragma unroll
            for (int i = 0; i < 8; ++i) { pre[i] = c[i] * u[i]; y[i] = bv[i] * (bb[i] + w0[i] * p2[i] + w1[i] * p1[i] + w2[i] * pre[i]); }
            *(GAS v4u*)(mix + row * 1024 + ch) = pack8f(y);
            const int t = t0 + r;
            if (prompt) { if (t >= SEQ - 2) { float* o = P.out + O_CMP + (size_t)(bidx * 2 + (t - (SEQ - 2))) * DCONV + ch; *(f32x4*)o = (f32x4){pre[0], pre[1], pre[2], pre[3]}; *(f32x4*)(o + 4) = (f32x4){pre[4], pre[5], pre[6], pre[7]}; } }
            else { if (t >= DS - 2) { float* o = P.out + O_CMS + (size_t)(bidx * 2 + (t - (DS - 2))) * DCONV + ch; *(f32x4*)o = (f32x4){pre[0], pre[1], pre[2], pre[3]}; *(f32x4*)(o + 4) = (f32x4){pre[4], pre[5], pre[6], pre[7]}; } }
#pragma unroll
            for (int i = 0; i < 8; ++i) { p2[i] = p1[i]; p1[i] = pre[i]; }
        }
    }
}

__device__ __forceinline__ void p_convffn(const Ptrs& P, int wave, int lane, int G) {
    const int gw = blockIdx.x * NWAVES + wave, NGW = G * NWAVES;
    const bf16* up = WSP(const bf16, WS_UPB); bf16* act = WSP(bf16, WS_ACT);
    constexpr int NPI = MP / 16, NCH = 6;
    for (int it = NPI * NCH + gw; it < (NPI + DB) * NCH; it += NGW) {
        const int rb = it / NCH, cc = it % NCH; const int cg = cc * 64 + lane;
        if (cg < DFF / 8) {
            const int ch = cg * 8;
            float wg0[8], wg1[8], wg2[8], bg[8], wu0[8], wu1[8], wu2[8], bu[8];
#pragma unroll
            for (int i = 0; i < 8; ++i) { wg0[i] = P.in[28][ch + i]; wg1[i] = P.in[28][DUP + ch + i]; wg2[i] = P.in[28][2 * DUP + ch + i]; bg[i] = P.in[29][ch + i];
                wu0[i] = P.in[28][DFF + ch + i]; wu1[i] = P.in[28][DUP + DFF + ch + i]; wu2[i] = P.in[28][2 * DUP + DFF + ch + i]; bu[i] = P.in[29][DFF + ch + i]; }
            float g2[8], g1[8], u2[8], u1[8];
            int row0, nrow, t0, bidx; const bool prompt = rb < NPI;
            if (prompt) { row0 = rb * 16; nrow = 16; t0 = row0 % SEQ; bidx = row0 / SEQ;
                if (t0 == 0) {
#pragma unroll
                    for (int i = 0; i < 8; ++i) { g2[i] = 0.f; g1[i] = 0.f; u2[i] = 0.f; u1[i] = 0.f; } }
                else { unpack8(*(const GAS v4u*)(up + (size_t)(row0 - 2) * DUP + ch), g2); unpack8(*(const GAS v4u*)(up + (size_t)(row0 - 2) * DUP + DFF + ch), u2);
                    unpack8(*(const GAS v4u*)(up + (size_t)(row0 - 1) * DUP + ch), g1); unpack8(*(const GAS v4u*)(up + (size_t)(row0 - 1) * DUP + DFF + ch), u1); } }
            else { bidx = rb - NPI; row0 = MP + bidx * DS; nrow = DS; t0 = 0;
                const float* st = P.in[7] + (size_t)bidx * 2 * DUP;
#pragma unroll
                for (int i = 0; i < 8; ++i) { g2[i] = st[ch + i]; u2[i] = st[DFF + ch + i]; g1[i] = st[DUP + ch + i]; u1[i] = st[DUP + DFF + ch + i]; } }
            for (int r = 0; r < nrow; ++r) {
                const size_t row = (size_t)(row0 + r);
                float g0[8], u0[8], a[8];
                unpack8(*(const GAS v4u*)(up + row * DUP + ch), g0); unpack8(*(const GAS v4u*)(up + row * DUP + DFF + ch), u0);
#pragma unroll
                for (int i = 0; i < 8; ++i) { const float gc = bg[i] + wg0[i] * g2[i] + wg1[i] * g1[i] + wg2[i] * g0[i]; const float uc = bu[i] + wu0[i] * u2[i] + wu1[i] * u1[i] + wu2[i] * u0[i];
                    a[i] = gc / (1.0f + __expf(-gc)) * uc; }
                *(GAS v4u*)(act + row * DFF + ch) = pack8f(a);
                const int t = t0 + r; const int tl = prompt ? SEQ - 2 : DS - 2;
                if (t >= tl) { float* o = P.out + (prompt ? O_CFP : O_CFS) + (size_t)(bidx * 2 + (t - tl)) * DUP + ch;
                    *(f32x4*)o = (f32x4){g0[0], g0[1], g0[2], g0[3]}; *(f32x4*)(o + 4) = (f32x4){g0[4], g0[5], g0[6], g0[7]};
                    *(f32x4*)(o + DFF) = (f32x4){u0[0], u0[1], u0[2], u0[3]}; *(f32x4*)(o + DFF + 4) = (f32x4){u0[4], u0[5], u0[6], u0[7]}; }
#pragma unroll
                for (int i = 0; i < 8; ++i) { g2[i] = g1[i]; g1[i] = g0[i]; u2[i] = u1[i]; u1[i] = u0[i]; }
            }
        }
    }
}

__device__ __forceinline__ void p_final(const Ptrs& P, int wave, int lane, int G) {
    const int gw = blockIdx.x * NWAVES + wave, NGW = G * NWAVES;
    const float* x3 = WSP(const float, WS_X3); const float* ss = WSP(const float, WS_SS3); const float* w = P.in[31];
    f32x4 wv[4];
#pragma unroll
    for (int j = 0; j < 4; ++j) wv[j] = *((const f32x4*)w + lane + 64 * j);
    for (int m = gw; m < MREAL; m += NGW) {
        const float tot = m < MP ? wave_sum(lane < 16 ? ss[(size_t)m * 16 + lane] : 0.f) : wave_sum(WSP(const float, WS_SSS3)[(size_t)(m - MP) * 64 + lane]);
        const float rs = 1.0f / sqrtf(tot * (1.0f / 1024.0f) + EPS);
        const GAS f32x4* xr = (const GAS f32x4*)(x3 + (size_t)m * DM) + lane;
        GAS f32x4* o = (GAS f32x4*)(P.out + (m < MP ? O_Y + (size_t)m * DM : O_YS + (size_t)(m - MP) * DM)) + lane;
#pragma unroll
        for (int j = 0; j < 4; ++j) o[64 * j] = xr[64 * j] * rs * wv[j];
    }
}

__device__ __forceinline__ void p_dattn_naive(const Ptrs& P, LAS unsigned char* lds, int wave, int lane, int G) {
    const int gw = blockIdx.x * NWAVES + wave, NGW = G * NWAVES;
    const bf16* qb = WSP(const bf16, WS_QB); const bf16* kb = WSP(const bf16, WS_KB); const bf16* vb = WSP(const bf16, WS_VB); bf16* mix = WSP(bf16, WS_MIX);
    const float* bt = WSP(const float, WS_BIAS); const float lam = *WSP(const float, WS_LAM);
    LAS float* qs = (LAS float*)(lds + wave * 1024); LAS float* ps = qs + 128;
    for (int it = gw; it < MP * NH; it += NGW) {
        const int m = it >> 2, h = it & 3, b = m / SEQ, t = m % SEQ;
        { const unsigned w = *(const GAS unsigned*)(qb + (size_t)m * 512 + h * 128 + 2 * lane); qs[2 * lane] = bf_lo(w); qs[2 * lane + 1] = bf_hi(w); }
        LDS_WAIT(); asm volatile("" ::: "memory");
        float m1 = -1e30f, m2 = -1e30f, l1 = 0.f, l2 = 0.f, o1x = 0.f, o1y = 0.f, o2x = 0.f, o2y = 0.f;
        for (int k0 = 0; k0 <= t; k0 += 64) {
            const int key = k0 + lane; const bool valid = key <= t; const int kc = valid ? key : t;
            const bf16* kr = kb + (size_t)(b * SEQ + kc) * 512 + h * 128;
            float s1 = 0.f, s2 = 0.f;
#pragma unroll
            for (int c = 0; c < 16; ++c) { float kf[8]; unpack8(*(const GAS v4u*)(kr + c * 8), kf);
#pragma unroll
                for (int i = 0; i < 8; ++i) { if (c < 8) s1 += kf[i] * qs[c * 8 + i]; else s2 += kf[i] * qs[c * 8 + i]; } }
            const int rel = t - kc; const float bias = bt[h * DP_STRIDE + (rel < 128 ? rel : 128)];
            s1 = valid ? s1 + bias : -1e30f; s2 = valid ? s2 + bias : -1e30f;
            const float mn1 = fmaxf(m1, wave_max(s1)), mn2 = fmaxf(m2, wave_max(s2));
            const float a1 = ex2(m1 - mn1), a2 = ex2(m2 - mn2);
            const float p1 = valid ? ex2(s1 - mn1) : 0.f, p2 = valid ? ex2(s2 - mn2) : 0.f;
            l1 = l1 * a1 + wave_sum(p1); l2 = l2 * a2 + wave_sum(p2); m1 = mn1; m2 = mn2;
            o1x *= a1; o1y *= a1; o2x *= a2; o2y *= a2;
            ps[lane] = p1; ps[64 + lane] = p2;
            LDS_WAIT(); asm volatile("" ::: "memory");
            const int nk = (t - k0 + 1) < 64 ? (t - k0 + 1) : 64;
            const bf16* vr = vb + (size_t)(b * SEQ + k0) * 512 + h * 128 + 2 * lane;
            for (int kk = 0; kk < nk; ++kk) { const float pa = ps[kk], pb = ps[64 + kk]; const unsigned w = *(const GAS unsigned*)(vr + (size_t)kk * 512); const float vx = bf_lo(w), vy = bf_hi(w);
                o1x += pa * vx; o1y += pa * vy; o2x += pb * vx; o2y += pb * vy; }
            LDS_WAIT(); asm volatile("" ::: "memory");
        }
        const float ax = o1x / l1 - lam * (o2x / l2), ay = o1y / l1 - lam * (o2y / l2);
        const float ssq = wave_sum(ax * ax + ay * ay);
        const float rn = (1.0f - LAM_INIT) / sqrtf(ssq * (1.0f / 128.0f) + EPS);
        const float wx = P.in[19][2 * lane], wy = P.in[19][2 * lane + 1];
        *(GAS unsigned*)(mix + (size_t)m * 1024 + 512 + h * 128 + 2 * lane) = pk2(ax * rn * wx, ay * rn * wy);
    }
}

template <bool SAMPLE> __device__ __forceinline__ void p_xattn_naive(const Ptrs& P, LAS unsigned char* lds, int wave, int lane, int G) {
    const int gw = blockIdx.x * NWAVES + wave, NGW = G * NWAVES;
    const bf16* qc = WSP(const bf16, WS_QC); bf16* oc = WSP(bf16, WS_OC);
    const bf16* mkb = WSP(const bf16, WS_MKB); const bf16* mvb = WSP(const bf16, WS_MVB);
    LAS float* qs = (LAS float*)(lds + wave * 2048); LAS float* ps = qs + 256;
    const int nit = (SAMPLE ? MS : MP) * MHEADS;
    for (int it = gw; it < nit; it += NGW) {
        const int mr = it >> 2, h = it & 3; const int m = SAMPLE ? MP + mr : mr; const int b = SAMPLE ? mr / DS : mr / SEQ;
        { const unsigned long long w = *(const GAS unsigned long long*)(qc + (size_t)m * 1024 + h * 256 + 4 * lane);
          qs[4 * lane] = bf_lo((unsigned)w); qs[4 * lane + 1] = bf_hi((unsigned)w); qs[4 * lane + 2] = bf_lo((unsigned)(w >> 32)); qs[4 * lane + 3] = bf_hi((unsigned)(w >> 32)); }
        LDS_WAIT(); asm volatile("" ::: "memory");
        float s[4];
#pragma unroll
        for (int c = 0; c < 4; ++c) {
            const int key = c * 64 + lane; float acc = 0.f;
            if (SAMPLE) { const float* kr = P.in[8] + ((size_t)(b * NMEM + key) * MHEADS + h) * MDH;
#pragma unroll 8
                for (int d = 0; d < 64; ++d) { const f32x4 kv = *(const GAS f32x4*)(kr + 4 * d); acc += kv.x * qs[4 * d] + kv.y * qs[4 * d + 1] + kv.z * qs[4 * d + 2] + kv.w * qs[4 * d + 3]; } }
            else { const bf16* kr = mkb + (size_t)(b * NMEM + key) * 1024 + h * 256;
#pragma unroll 8
                for (int d = 0; d < 32; ++d) { float kf[8]; unpack8(*(const GAS v4u*)(kr + 8 * d), kf);
#pragma unroll
                    for (int i = 0; i < 8; ++i) acc += kf[i] * qs[8 * d + i]; } }
            s[c] = acc;
        }
        const float mx = wave_max(fmaxf(fmaxf(s[0], s[1]), fmaxf(s[2], s[3])));
        float lsum = 0.f;
#pragma unroll
        for (int c = 0; c < 4; ++c) { const float p = ex2(s[c] - mx); ps[c * 64 + lane] = p; lsum += p; }
        lsum = wave_sum(lsum);
        LDS_WAIT(); asm volatile("" ::: "memory");
        float o[4] = {0.f, 0.f, 0.f, 0.f};
        for (int key = 0; key < NMEM; ++key) {
            const float p = ps[key];
            if (SAMPLE) { const f32x4 v = *(const GAS f32x4*)(P.in[9] + ((size_t)(b * NMEM + key) * MHEADS + h) * MDH + 4 * lane); o[0] += p * v.x; o[1] += p * v.y; o[2] += p * v.z; o[3] += p * v.w; }
            else { const unsigned long long w = *(const GAS unsigned long long*)(mvb + (size_t)(b * NMEM + key) * 1024 + h * 256 + 4 * lane);
                o[0] += p * bf_lo((unsigned)w); o[1] += p * bf_hi((unsigned)w); o[2] += p * bf_lo((unsigned)(w >> 32)); o[3] += p * bf_hi((unsigned)(w >> 32)); }
        }
        const float il = 1.0f / lsum;
        *(GAS unsigned long long*)(oc + (size_t)m * 1024 + h * 256 + 4 * lane) = (unsigned long long)pk2(o[0] * il, o[1] * il) | ((unsigned long long)pk2(o[2] * il, o[3] * il) << 32);
        LDS_WAIT(); asm volatile("" ::: "memory");
    }
}

__device__ __forceinline__ void p_xattn_sample(const Ptrs& P, LAS unsigned char* lds, int wave, int lane, int G, int wgoff) {
    const bf16* qc = WSP(const bf16, WS_QC); bf16* oc = WSP(bf16, WS_OC);
    LAS float* part = (LAS float*)lds;
    LAS float* stat = part + 8 * 4 * 256;
    int vb = (int)blockIdx.x - wgoff; if (vb < 0) vb += G;
    for (int it = vb; it < DB * MHEADS; it += G) {
        const int bs = it >> 2, h = it & 3;
        float qv[4][4];
#pragma unroll
        for (int t = 0; t < 4; ++t) { const unsigned long long w = *(const GAS unsigned long long*)(qc + (size_t)(MP + bs * DS + t) * 1024 + h * 256 + 4 * lane);
            qv[t][0] = bf_lo((unsigned)w); qv[t][1] = bf_hi((unsigned)w); qv[t][2] = bf_lo((unsigned)(w >> 32)); qv[t][3] = bf_hi((unsigned)(w >> 32)); }
        const float* kbase = P.in[8] + ((size_t)(bs * NMEM + wave * 32) * MHEADS + h) * MDH + 4 * lane;
        const float* vbase = P.in[9] + ((size_t)(bs * NMEM + wave * 32) * MHEADS + h) * MDH + 4 * lane;
        float mm[4], ll[4], acc[4][4];
#pragma unroll
        for (int t = 0; t < 4; ++t) { mm[t] = -1e30f; ll[t] = 0.f;
#pragma unroll
            for (int d = 0; d < 4; ++d) acc[t][d] = 0.f; }
#pragma unroll 1
        for (int kb = 0; kb < 4; ++kb) {
            f32x4 Kr[8], Vr[8];
#pragma unroll
            for (int j = 0; j < 8; ++j) { Kr[j] = *(const GAS f32x4*)(kbase + (size_t)(kb * 8 + j) * MHEADS * MDH); Vr[j] = *(const GAS f32x4*)(vbase + (size_t)(kb * 8 + j) * MHEADS * MDH); }
            float s[8][4];
#pragma unroll
            for (int j = 0; j < 8; ++j)
#pragma unroll
                for (int t = 0; t < 4; ++t) s[j][t] = Kr[j].x * qv[t][0] + Kr[j].y * qv[t][1] + Kr[j].z * qv[t][2] + Kr[j].w * qv[t][3];
#pragma unroll
            for (int j = 0; j < 8; ++j)
#pragma unroll
                for (int t = 0; t < 4; ++t) { float a = s[j][t]; a += dppf<0xB1>(a); a += dppf<0x4E>(a); a += dppf<0x141>(a); a += dppf<0x140>(a); a += __shfl_xor(a, 16); a += __shfl_xor(a, 32); s[j][t] = a; }
#pragma unroll
            for (int t = 0; t < 4; ++t) { float mx = s[0][t];
#pragma unroll
                for (int j = 1; j < 8; ++j) mx = fmaxf(mx, s[j][t]);
                const float mn = fmaxf(mm[t], mx); const float al = ex2(mm[t] - mn); mm[t] = mn; ll[t] *= al;
#pragma unroll
                for (int d = 0; d < 4; ++d) acc[t][d] *= al;
#pragma unroll
                for (int j = 0; j < 8; ++j) { const float p = ex2(s[j][t] - mn); ll[t] += p; acc[t][0] += p * Vr[j].x; acc[t][1] += p * Vr[j].y; acc[t][2] += p * Vr[j].z; acc[t][3] += p * Vr[j].w; } }
        }
        __syncthreads();
#pragma unroll
        for (int t = 0; t < 4; ++t) { *(LAS f32x4*)(part + (wave * 4 + t) * 256 + 4 * lane) = (f32x4){acc[t][0], acc[t][1], acc[t][2], acc[t][3]}; if (lane == 0) { stat[(wave * 4 + t) * 2] = mm[t]; stat[(wave * 4 + t) * 2 + 1] = ll[t]; } }
        __syncthreads();
        if (wave < 4) { const int t = wave; float M = -1e30f;
#pragma unroll
            for (int w2 = 0; w2 < 8; ++w2) M = fmaxf(M, stat[(w2 * 4 + t) * 2]);
            float L = 0.f; f32x4 o = (f32x4){0.f, 0.f, 0.f, 0.f};
#pragma unroll
            for (int w2 = 0; w2 < 8; ++w2) { const float fsc = ex2(stat[(w2 * 4 + t) * 2] - M); L += fsc * stat[(w2 * 4 + t) * 2 + 1]; o = o + *(const LAS f32x4*)(part + (w2 * 4 + t) * 256 + 4 * lane) * fsc; }
            const float il = 1.0f / L;
            *(GAS unsigned long long*)(oc + (size_t)(MP + bs * DS + t) * 1024 + h * 256 + 4 * lane) = (unsigned long long)pk2(o[0] * il, o[1] * il) | ((unsigned long long)pk2(o[2] * il, o[3] * il) << 32); }
    }
    __syncthreads();
}

template <int U> __device__ __forceinline__ void dec_step(const f32x4* K, const f32x4* V, const float (&qv)[4][4], float (&mm)[4], float (&ll)[4], float (&accA)[4][4], float (&accB)[4][4],
                                         const bool nearb, const float b31, const float* bth, const int relb) {
    float s[U][4];
#pragma unroll
    for (int u = 0; u < U; ++u)
#pragma unroll
        for (int t = 0; t < 4; ++t) s[u][t] = K[u].x * qv[t][0] + K[u].y * qv[t][1] + K[u].z * qv[t][2] + K[u].w * qv[t][3];
#pragma unroll
    for (int u = 0; u < U; ++u)
#pragma unroll
        for (int t = 0; t < 4; ++t) s[u][t] += dppf<0xB1>(s[u][t]);
#pragma unroll
    for (int u = 0; u < U; ++u)
#pragma unroll
        for (int t = 0; t < 4; ++t) s[u][t] += dppf<0x4E>(s[u][t]);
#pragma unroll
    for (int u = 0; u < U; ++u)
#pragma unroll
        for (int t = 0; t < 4; ++t) s[u][t] += dppf<0x141>(s[u][t]);
#pragma unroll
    for (int u = 0; u < U; ++u)
#pragma unroll
        for (int t = 0; t < 4; ++t) s[u][t] += dppf<0x140>(s[u][t]);
    if (!nearb) {
#pragma unroll
        for (int u = 0; u < U; ++u)
#pragma unroll
            for (int t = 0; t < 4; ++t) s[u][t] += b31;
    } else {
#pragma unroll
        for (int u = 0; u < U; ++u)
#pragma unroll
            for (int t = 0; t < 4; ++t) { const int rel = relb - 2 * u + t; s[u][t] += bth[rel < 128 ? rel : 128]; }
    }
    float mx[4]; bool grow = false;
#pragma unroll
    for (int t = 0; t < 4; ++t) { mx[t] = s[0][t];
#pragma unroll
        for (int u = 1; u < U; ++u) mx[t] = fmaxf(mx[t], s[u][t]);
        grow = grow || (mx[t] > mm[t] + 8.0f); }
    if (__any(grow)) {
#pragma unroll
        for (int t = 0; t < 4; ++t) { const float mn = fmaxf(mm[t], mx[t]); const float al = ex2(mm[t] - mn); const float alo = __shfl_xor(al, 16); ll[t] *= al; mm[t] = mn;
#pragma unroll
            for (int d = 0; d < 4; ++d) { accA[t][d] *= al; accB[t][d] *= alo; } }
    }
    float p[U][4], po[U][4];
#pragma unroll
    for (int u = 0; u < U; ++u)
#pragma unroll
        for (int t = 0; t < 4; ++t) p[u][t] = ex2(s[u][t] - mm[t]);
#pragma unroll
    for (int u = 0; u < U; ++u)
#pragma unroll
        for (int t = 0; t < 4; ++t) po[u][t] = __shfl_xor(p[u][t], 16);
#pragma unroll
    for (int u = 0; u < U; ++u)
#pragma unroll
        for (int t = 0; t < 4; ++t) { ll[t] += p[u][t];
            accA[t][0] += p[u][t] * V[u].x; accA[t][1] += p[u][t] * V[u].y; accA[t][2] += p[u][t] * V[u].z; accA[t][3] += p[u][t] * V[u].w;
            accB[t][0] += po[u][t] * V[u].x; accB[t][1] += po[u][t] * V[u].y; accB[t][2] += po[u][t] * V[u].z; accB[t][3] += po[u][t] * V[u].w; }
}
constexpr int DEC_U = 4, DEC_R = 8;
template <int MODE> __device__ __forceinline__ void p_decode_split(const Ptrs& P, int wave, int lane, int G) {
    const int gw = blockIdx.x * NWAVES + wave, NGW = G * NWAVES;
    const bf16* qb = WSP(const bf16, WS_QB); const float* bt = WSP(const float, WS_BIAS); float* dpart = MODE == 0 ? WSP(float, WS_DPART) : WSP(float, WS_END + 16 * MiB);
    const float* ck = P.in[3]; const float* cv = P.in[4]; const int* ptab = (const int*)P.in[5];
    const int kq = lane >> 5, l32 = lane & 31, mp = (lane >> 4) & 1, off = 4 * l32;
    for (int it = gw; it < DB * NH * 16; it += NGW) {
        const int bh = it >> 4, chunk = it & 15, bs = bh >> 2, h = bh & 3;
        float qv[4][4];
#pragma unroll
        for (int t = 0; t < 4; ++t) { const unsigned long long w = *(const GAS unsigned long long*)(qb + (size_t)(MP + bs * DS + t) * 512 + h * 128 + off);
            qv[t][0] = bf_lo((unsigned)w); qv[t][1] = bf_hi((unsigned)w); qv[t][2] = bf_lo((unsigned)(w >> 32)); qv[t][3] = bf_hi((unsigned)(w >> 32)); }
        const float* bth = bt + h * DP_STRIDE; const float b31 = bth[128];
        const int j0 = chunk * 512;
        float mm[4], ll[4], accA[4][4], accB[4][4];
#pragma unroll
        for (int t = 0; t < 4; ++t) { mm[t] = -1e30f; ll[t] = 0.f;
#pragma unroll
            for (int d = 0; d < 4; ++d) { accA[t][d] = 0.f; accB[t][d] = 0.f; } }
        f32x4 Kb[DEC_R], Vb[DEC_R];
        const int pgv = ptab[bs * NPAGES + chunk * 4 + (lane & 3)];
        const int pg0 = __builtin_amdgcn_readlane(pgv, 0), pg1 = MODE == 2 ? pg0 : __builtin_amdgcn_readlane(pgv, 1), pg2 = MODE == 2 ? pg0 : __builtin_amdgcn_readlane(pgv, 2), pg3 = MODE == 2 ? pg0 : __builtin_amdgcn_readlane(pgv, 3);
#define DEC_PG(k_) ((k_) == 0 ? pg0 : (k_) == 1 ? pg1 : (k_) == 2 ? pg2 : pg3)
#define DEC_CBASE(c_) ((((size_t)DEC_PG((2 * DEC_R * (c_)) >> 7) * PAGE + (MODE == 2 ? 0 : ((2 * DEC_R * (c_)) & 127)) + kq) * NH + h) * 128 + off)
        { const size_t gb = DEC_CBASE(0);
#pragma unroll
          for (int j = 0; j < DEC_R; ++j) { Kb[j] = *(const GAS f32x4*)(ck + gb + (size_t)j * 1024); Vb[j] = *(const GAS f32x4*)(cv + gb + (size_t)j * 1024); } }
        constexpr int NCYC = 256 / DEC_R;
        for (int c = 0; c < NCYC; ++c) {
            const bool more = c + 1 < NCYC;
            const size_t gn = more ? DEC_CBASE(c + 1) : 0;
            const bool nearb = (j0 + 2 * DEC_R * c + 2 * DEC_R - 1 + 128 > PAST);
            const int relg = PAST - (j0 + 2 * DEC_R * c + kq);
#pragma unroll
            for (int j = 0; j < DEC_R; j += DEC_U) {
                if (MODE == 1) {
#pragma unroll
                    for (int u = 0; u < DEC_U; ++u) { accA[0][0] += Kb[j + u].x + Vb[j + u].x; accA[0][1] += Kb[j + u].y + Vb[j + u].y; accA[0][2] += Kb[j + u].z + Vb[j + u].z; accA[0][3] += Kb[j + u].w + Vb[j + u].w; } }
                else dec_step<DEC_U>(&Kb[j], &Vb[j], qv, mm, ll, accA, accB, nearb, b31, bth, relg - 2 * j);
                if (more) {
#pragma unroll
                    for (int u = 0; u < DEC_U; ++u) { Kb[j + u] = *(const GAS f32x4*)(ck + gn + (size_t)(j + u) * 1024); Vb[j + u] = *(const GAS f32x4*)(cv + gn + (size_t)(j + u) * 1024); } }
            }
        }
#undef DEC_CBASE
#undef DEC_PG
        float Mx[4];
#pragma unroll
        for (int t = 0; t < 4; ++t) { const float M = fmaxf(mm[t], __shfl_xor(mm[t], 32)); const float f = ex2(mm[t] - M); Mx[t] = M; const float fo = __shfl_xor(f, 16);
            float l = ll[t] * f; l += __shfl_xor(l, 32); ll[t] = l;
#pragma unroll
            for (int d = 0; d < 4; ++d) { float a = accA[t][d] * f; a += __shfl_xor(a, 32); accA[t][d] = a; float bq = accB[t][d] * fo; bq += __shfl_xor(bq, 32); accB[t][d] = bq; } }
        if (kq == 0) {
#pragma unroll
            for (int t = 0; t < 4; ++t) {
                float* pa = dpart + ((size_t)it * 8 + mp * 4 + t) * DP_STRIDE; float* pb = dpart + ((size_t)it * 8 + (1 - mp) * 4 + t) * DP_STRIDE;
                *(f32x4*)(pa + off) = (f32x4){accA[t][0], accA[t][1], accA[t][2], accA[t][3]};
                *(f32x4*)(pb + off) = (f32x4){accB[t][0], accB[t][1], accB[t][2], accB[t][3]};
                if ((lane & 15) == 0) { pa[128] = Mx[t]; pa[129] = ll[t]; }
            }
        }
    }
}
__device__ __forceinline__ void p_decode_combine(const Ptrs& P, int wave, int lane, int G) {
    const int gw = blockIdx.x * NWAVES + wave, NGW = G * NWAVES;
    const bf16* qb = WSP(const bf16, WS_QB); const float* bt = WSP(const float, WS_BIAS); const float* dpart = WSP(const float, WS_DPART); bf16* mix = WSP(bf16, WS_MIX);
    const float lam = *WSP(const float, WS_LAM);
    for (int it = gw; it < DB * NH * DS; it += NGW) {
        const int t = it & 3, bh = it >> 2, bs = bh >> 2, h = bh & 3; const int row = MP + bs * DS + t;
        float res[2][2];
#pragma unroll
        for (int map = 0; map < 2; ++map) {
            const float* pbase = dpart + ((size_t)bh * 16 * 8 + map * 4 + t) * DP_STRIDE;
            float mc = -1e30f, lc = 0.f;
            if (lane < 16) { mc = pbase[(size_t)lane * 8 * DP_STRIDE + 128]; lc = pbase[(size_t)lane * 8 * DP_STRIDE + 129]; }
            const float qd = __uint_as_float((unsigned)qb[(size_t)row * 512 + h * 128 + map * 64 + lane] << 16);
            float sn[4];
#pragma unroll
            for (int i = 0; i < 4; ++i) { const float kd = P.out[O_KS + (size_t)(bs * DS + i) * 512 + h * 128 + map * 64 + lane]; const float s = wave_sum(qd * kd);
                sn[i] = (i <= t) ? s + bt[h * DP_STRIDE + (t - i >= 0 ? t - i : 0)] : -1e30f; }
            float M = wave_max(mc); M = fmaxf(fmaxf(M, sn[0]), fmaxf(fmaxf(sn[1], sn[2]), sn[3]));
            const float wc = ex2(mc - M);
            float L = wave_sum(wc * lc); float pn[4];
#pragma unroll
            for (int i = 0; i < 4; ++i) { pn[i] = (i <= t) ? ex2(sn[i] - M) : 0.f; L += pn[i]; }
            float ox = 0.f, oy = 0.f;
            for (int c = 0; c < 16; ++c) { const float w = __shfl(wc, c); ox += w * pbase[(size_t)c * 8 * DP_STRIDE + lane]; oy += w * pbase[(size_t)c * 8 * DP_STRIDE + 64 + lane]; }
#pragma unroll
            for (int i = 0; i < 4; ++i) { const float* vr = P.out + O_VS + (size_t)(bs * DS + i) * 512 + h * 128; ox += pn[i] * vr[lane]; oy += pn[i] * vr[64 + lane]; }
            res[map][0] = ox / L; res[map][1] = oy / L;
        }
        const float ax = res[0][0] - lam * res[1][0], ay = res[0][1] - lam * res[1][1];
        const float ssq = wave_sum(ax * ax + ay * ay);
        const float rn = (1.0f - LAM_INIT) / sqrtf(ssq * (1.0f / 128.0f) + EPS);
        bf16* o = mix + (size_t)row * 1024 + 512 + h * 128;
        o[lane] = (bf16)f2bf(ax * rn * P.in[19][lane]); o[64 + lane] = (bf16)f2bf(ay * rn * P.in[19][64 + lane]);
    }
}


namespace fa {
typedef short bf16x8 __attribute__((ext_vector_type(8)));
typedef float f32x16 __attribute__((ext_vector_type(16)));
typedef short v4i16_t __attribute__((ext_vector_type(4)));
constexpr int KS = 272, VS = 320, KT_BYTES = 64 * KS, VT_BYTES = 64 * VS, STAGE = KT_BYTES + VT_BYTES;
constexpr int TBL_OFF = 2 * STAGE;
constexpr float THR = 8.0f;
static_assert(TBL_OFF + 132 * 4 <= RING_BYTES && 65536 <= TBL_OFF, "fa LDS map");
__device__ __forceinline__ float swap_max(float x) { auto rr = __builtin_amdgcn_permlane32_swap(__float_as_uint(x), __float_as_uint(x), false, false); return fmaxf(__uint_as_float(rr[0]), __uint_as_float(rr[1])); }
__device__ __forceinline__ float swap_sum(float x) { auto rr = __builtin_amdgcn_permlane32_swap(__float_as_uint(x), __float_as_uint(x), false, false); return __uint_as_float(rr[0]) + __uint_as_float(rr[1]); }
__device__ __forceinline__ unsigned cvtpk(float lo, float hi) { unsigned r; asm volatile("v_cvt_pk_bf16_f32 %0, %1, %2" : "=v"(r) : "v"(lo), "v"(hi)); return r; }
__device__ __forceinline__ bf16x8 pack_p(const f32x16& p, int base) { v4u w; w.x = cvtpk(p[base], p[base + 1]); w.y = cvtpk(p[base + 2], p[base + 3]); w.z = cvtpk(p[base + 4], p[base + 5]); w.w = cvtpk(p[base + 6], p[base + 7]); return __builtin_bit_cast(bf16x8, w); }
__device__ __forceinline__ bf16x8 vfrag(const LAS unsigned char* p) {
    const v4i16_t lo = __builtin_amdgcn_ds_read_tr16_b64_v4i16((LAS v4i16_t*)p), hi = __builtin_amdgcn_ds_read_tr16_b64_v4i16((LAS v4i16_t*)(p + 8 * VS));
    return (bf16x8){lo[0], lo[1], lo[2], lo[3], hi[0], hi[1], hi[2], hi[3]};
}

__device__ __forceinline__ void dattn_flash(const Ptrs& P, LAS unsigned char* lds, int wave, int lane, int G) {
    const int tid = threadIdx.x;
    const bf16* qb = WSP(const bf16, WS_QB); const bf16* kb = WSP(const bf16, WS_KB); const bf16* vb = WSP(const bf16, WS_VB); bf16* mix = WSP(bf16, WS_MIX);
    const float* bt = WSP(const float, WS_BIAS); const float lam = *WSP(const float, WS_LAM);
    const int r32 = lane & 31, hi = lane >> 5, c = wave & 1, rg = wave >> 1;
    const int bx = blockIdx.x; const int vcu = (G % 8 == 0) ? (bx % 8) * (G / 8) + bx / 8 : bx;
    LAS float* tbl = (LAS float*)(lds + TBL_OFF);
    LAS float* ex = (LAS float*)lds;
    const int srow = tid >> 4, sch = tid & 15;
    const unsigned kl = srow * KS + sch * 16, vl = KT_BYTES + srow * VS + sch * 16;
    const unsigned kfo = r32 * KS + (c * 64 + hi * 8) * 2;
    const unsigned vfo = KT_BYTES + (4 * hi + ((lane & 15) >> 2)) * VS + (16 * ((lane >> 4) & 1) + 4 * (lane & 3)) * 2;
    for (int item = vcu; item < 256; item += G) {
        const int bh = item >> 4, pi = item & 15, b = bh >> 2, h = bh & 3;
        const size_t rowbase = (size_t)b * SEQ;
        __syncthreads();
        if (tid < 132) tbl[tid] = bt[h * DP_STRIDE + tid];
        for (int half = 0; half < 2; ++half) {
            const int qblk = half == 0 ? pi : 31 - pi;
            const int q0 = qblk * 128, NT = (q0 + 128) >> 6, tnear = (q0 >> 6) - 2;
            const int qpos = q0 + 32 * rg + r32;
            bf16x8 qr[4];
            { const bf16* qp = qb + (rowbase + qpos) * 512 + h * 128 + c * 64 + hi * 8;
#pragma unroll
              for (int dc = 0; dc < 4; ++dc) qr[dc] = *(const GAS bf16x8*)(qp + dc * 16); }
            const bf16* kg = kb + (rowbase + srow) * 512 + h * 128 + sch * 8; const bf16* vg = vb + (rowbase + srow) * 512 + h * 128 + sch * 8;
            v4u kst[2], vst[2];
#define FA_LOADG(t_) do { _Pragma("unroll") for (int i_ = 0; i_ < 2; ++i_) { kst[i_] = *(const GAS v4u*)(kg + ((size_t)(t_) * 64 + 32 * i_) * 512); vst[i_] = *(const GAS v4u*)(vg + ((size_t)(t_) * 64 + 32 * i_) * 512); } } while (0)
#define FA_STORE(so_) do { _Pragma("unroll") for (int i_ = 0; i_ < 2; ++i_) { *(LAS v4u*)(lds + (so_) + kl + i_ * 32 * KS) = kst[i_]; *(LAS v4u*)(lds + (so_) + vl + i_ * 32 * VS) = vst[i_]; } } while (0)
            FA_LOADG(0); FA_STORE(0);
            __syncthreads();
            const float b31 = tbl[128];
            float m = -1e30f, l = 0.f;
            f32x16 o[4];
#pragma unroll
            for (int k = 0; k < 4; ++k)
#pragma unroll
                for (int r = 0; r < 16; ++r) o[k][r] = 0.f;
            for (int t = 0; t < NT; ++t) {
                const int st = (t & 1) * STAGE;
                if (t + 1 < NT) FA_LOADG(t + 1);
                f32x16 p0, p1;
#pragma unroll
                for (int r = 0; r < 16; ++r) { p0[r] = 0.f; p1[r] = 0.f; }
                const LAS unsigned char* kbp = lds + st + kfo;
#pragma unroll
                for (int dc = 0; dc < 4; ++dc) {
                    const bf16x8 a0 = *(const LAS bf16x8*)(kbp + dc * 32), a1 = *(const LAS bf16x8*)(kbp + 32 * KS + dc * 32);
                    p0 = __builtin_amdgcn_mfma_f32_32x32x16_bf16(a0, qr[dc], p0, 0, 0, 0);
                    p1 = __builtin_amdgcn_mfma_f32_32x32x16_bf16(a1, qr[dc], p1, 0, 0, 0);
                }
                if (t < tnear) {
#pragma unroll
                    for (int r = 0; r < 16; ++r) { p0[r] += b31; p1[r] += b31; }
                } else {
                    const int rb = qpos - t * 64 - 4 * hi;
#pragma unroll
                    for (int r = 0; r < 16; ++r) {
                        const int rel0 = rb - ((r & 3) + 8 * (r >> 2)), rel1 = rel0 - 32;
                        const float b0 = tbl[rel0 < 0 ? 0 : (rel0 < 128 ? rel0 : 128)], b1 = tbl[rel1 < 0 ? 0 : (rel1 < 128 ? rel1 : 128)];
                        p0[r] = rel0 < 0 ? -1e30f : p0[r] + b0; p1[r] = rel1 < 0 ? -1e30f : p1[r] + b1;
                    }
                }
                float mx = fmaxf(p0[0], p1[0]);
#pragma unroll
                for (int r = 1; r < 16; ++r) mx = fmaxf(mx, fmaxf(p0[r], p1[r]));
                mx = swap_max(mx);
                if (__any(mx > m + THR)) {
                    const float mn = fmaxf(m, mx); const float al = ex2(m - mn); l *= al; m = mn;
#pragma unroll
                    for (int k = 0; k < 4; ++k)
#pragma unroll
                        for (int r = 0; r < 16; ++r) o[k][r] *= al;
                }
                float ls = 0.f;
#pragma unroll
                for (int r = 0; r < 16; ++r) { p0[r] = ex2(p0[r] - m); p1[r] = ex2(p1[r] - m); ls += p0[r] + p1[r]; }
                l += ls;
                bf16x8 pa[4]; pa[0] = pack_p(p0, 0); pa[1] = pack_p(p0, 8); pa[2] = pack_p(p1, 0); pa[3] = pack_p(p1, 8);
                const LAS unsigned char* vbp = lds + st + vfo;
#pragma unroll
                for (int s = 0; s < 4; ++s)
#pragma unroll
                    for (int k = 0; k < 4; ++k) {
                        const bf16x8 vf = vfrag(vbp + (16 * s) * VS + k * 64);
                        o[k] = __builtin_amdgcn_mfma_f32_32x32x16_bf16(vf, pa[s], o[k], 0, 0, 0);
                    }
                if (t + 1 < NT) FA_STORE(((t + 1) & 1) * STAGE);
                __syncthreads();
            }
#undef FA_LOADG
#undef FA_STORE
            l = swap_sum(l);
            const float il = 1.0f / l;
            if (c == 1) {
#pragma unroll
                for (int k = 0; k < 4; ++k)
#pragma unroll
                    for (int r = 0; r < 16; ++r) ex[(rg * 64 + k * 16 + r) * 64 + lane] = o[k][r] * il;
            }
            __syncthreads();
            if (c == 0) {
                float ssq = 0.f;
#pragma unroll
                for (int k = 0; k < 4; ++k)
#pragma unroll
                    for (int r = 0; r < 16; ++r) { const float a = o[k][r] * il - lam * ex[(rg * 64 + k * 16 + r) * 64 + lane]; o[k][r] = a; ssq += a * a; }
                ssq = swap_sum(ssq);
                const float rn = (1.0f - LAM_INIT) / sqrtf(ssq * (1.0f / 128.0f) + EPS);
                bf16* orow = mix + (rowbase + qpos) * 1024 + 512 + h * 128;
#pragma unroll
                for (int k = 0; k < 4; ++k)
#pragma unroll
                    for (int g = 0; g < 4; ++g) {
                        const int dv0 = 32 * k + 8 * g + 4 * hi;
                        const f32x4 w = *(const GAS f32x4*)(P.in[19] + dv0);
                        const unsigned long long pk = (unsigned long long)pk2(o[k][4 * g] * rn * w.x, o[k][4 * g + 1] * rn * w.y) | ((unsigned long long)pk2(o[k][4 * g + 2] * rn * w.z, o[k][4 * g + 3] * rn * w.w) << 32);
                        *(GAS unsigned long long*)(orow + dv0) = pk;
                    }
            }
            __syncthreads();
        }
    }
}
}


namespace fx {
using fa::bf16x8; using fa::f32x16; using fa::v4i16_t;
constexpr int KS = 528, VS = 576, TK = 32, KT_BYTES = TK * KS, VT_BYTES = TK * VS, STAGE = KT_BYTES + VT_BYTES;
static_assert(2 * STAGE <= RING_BYTES, "fx LDS map");
__device__ __forceinline__ bf16x8 vfrag(const LAS unsigned char* p) {
    const v4i16_t lo = __builtin_amdgcn_ds_read_tr16_b64_v4i16((LAS v4i16_t*)p), hi = __builtin_amdgcn_ds_read_tr16_b64_v4i16((LAS v4i16_t*)(p + 8 * VS));
    return (bf16x8){lo[0], lo[1], lo[2], lo[3], hi[0], hi[1], hi[2], hi[3]};
}
__device__ __forceinline__ void xattn_flash(const Ptrs& P, LAS unsigned char* lds, int wave, int lane, int G) {
    const int tid = threadIdx.x;
    const bf16* qc = WSP(const bf16, WS_QC); const bf16* mkb = WSP(const bf16, WS_MKB); const bf16* mvb = WSP(const bf16, WS_MVB); bf16* oc = WSP(bf16, WS_OC);
    const int r32 = lane & 31, hi = lane >> 5, dvh = wave & 1, rg = wave >> 1;
    const int bx = blockIdx.x; const int vcu = (G % 8 == 0) ? (bx % 8) * (G / 8) + bx / 8 : bx;
    const int srow = tid >> 5, sch = tid & 31;
    const unsigned kl = srow * KS + sch * 16, vl = KT_BYTES + srow * VS + sch * 16;
    const unsigned kfo = r32 * KS + (hi * 8) * 2;
    const unsigned vfo = KT_BYTES + (4 * hi + ((lane & 15) >> 2)) * VS + (128 * dvh + 16 * ((lane >> 4) & 1) + 4 * (lane & 3)) * 2;
    constexpr int NT = NMEM / TK;
    const int nmy = vcu < 512 ? (512 - vcu + G - 1) / G : 0;
    const int ntl = nmy * NT;
    if (ntl == 0) return;
    v4u ks0[2], vs0[2], ks1[2], vs1[2];
#define FX_SRC(g_, kp_, vp_) const int un_ = vcu + ((g_) >> 3) * G, bh_ = un_ >> 5; const size_t ro_ = ((size_t)(bh_ >> 2) * NMEM + ((g_) & 7) * TK + srow) * 1024 + (bh_ & 3) * 256 + sch * 8; const bf16* kp_ = mkb + ro_; const bf16* vp_ = mvb + ro_;
#define FX_LOADG(g_, KS_, VS_) do { FX_SRC(g_, kp_, vp_) _Pragma("unroll") for (int i_ = 0; i_ < 2; ++i_) { KS_[i_] = *(const GAS v4u*)(kp_ + (size_t)(16 * i_) * 1024); VS_[i_] = *(const GAS v4u*)(vp_ + (size_t)(16 * i_) * 1024); } } while (0)
#define FX_STORE(so_, KS_, VS_) do { _Pragma("unroll") for (int i_ = 0; i_ < 2; ++i_) { *(LAS v4u*)(lds + (so_) + kl + i_ * 16 * KS) = KS_[i_]; *(LAS v4u*)(lds + (so_) + vl + i_ * 16 * VS) = VS_[i_]; } } while (0)
    float m = -1e30f, l = 0.f;
    f32x16 o[4];
    bf16x8 qr[16];
    size_t row = 0; int hcur = 0;
#define FX_TILE(g_, st_) do { \
        if (((g_) & 7) == 0) { const int un_ = vcu + ((g_) >> 3) * G, bh_ = un_ >> 5; hcur = bh_ & 3; row = (size_t)(bh_ >> 2) * SEQ + (un_ & 31) * 128 + 32 * rg + r32; \
            const bf16* qp_ = qc + row * 1024 + hcur * 256 + hi * 8; _Pragma("unroll") for (int dc = 0; dc < 16; ++dc) qr[dc] = *(const GAS bf16x8*)(qp_ + dc * 16); \
            m = -1e30f; l = 0.f; _Pragma("unroll") for (int k = 0; k < 4; ++k) _Pragma("unroll") for (int r = 0; r < 16; ++r) o[k][r] = 0.f; } \
        f32x16 p0; _Pragma("unroll") for (int r = 0; r < 16; ++r) p0[r] = 0.f; \
        const LAS unsigned char* kbp = lds + (st_) + kfo; \
        _Pragma("unroll") for (int dc = 0; dc < 16; ++dc) { const bf16x8 a0 = *(const LAS bf16x8*)(kbp + dc * 32); p0 = __builtin_amdgcn_mfma_f32_32x32x16_bf16(a0, qr[dc], p0, 0, 0, 0); } \
        float mx = p0[0]; _Pragma("unroll") for (int r = 1; r < 16; ++r) mx = fmaxf(mx, p0[r]); mx = fa::swap_max(mx); \
        if (__any(mx > m + fa::THR)) { const float mn = fmaxf(m, mx); const float al = ex2(m - mn); l *= al; m = mn; \
            _Pragma("unroll") for (int k = 0; k < 4; ++k) _Pragma("unroll") for (int r = 0; r < 16; ++r) o[k][r] *= al; } \
        float ls = 0.f; _Pragma("unroll") for (int r = 0; r < 16; ++r) { p0[r] = ex2(p0[r] - m); ls += p0[r]; } l += ls; \
        bf16x8 pa[2]; pa[0] = fa::pack_p(p0, 0); pa[1] = fa::pack_p(p0, 8); \
        const LAS unsigned char* vbp = lds + (st_) + vfo; \
        _Pragma("unroll") for (int s = 0; s < 2; ++s) _Pragma("unroll") for (int k = 0; k < 4; ++k) { const bf16x8 vf = vfrag(vbp + (16 * s) * VS + k * 64); o[k] = __builtin_amdgcn_mfma_f32_32x32x16_bf16(vf, pa[s], o[k], 0, 0, 0); } \
        if (((g_) & 7) == 7) { const float lt = fa::swap_sum(l); const float il = 1.0f / lt; bf16* orow = oc + row * 1024 + hcur * 256 + 128 * dvh; \
            _Pragma("unroll") for (int k = 0; k < 4; ++k) _Pragma("unroll") for (int gq = 0; gq < 4; ++gq) { const int dv0 = 32 * k + 8 * gq + 4 * hi; \
                const unsigned long long pk = (unsigned long long)pk2(o[k][4 * gq] * il, o[k][4 * gq + 1] * il) | ((unsigned long long)pk2(o[k][4 * gq + 2] * il, o[k][4 * gq + 3] * il) << 32); \
                *(GAS unsigned long long*)(orow + dv0) = pk; } } \
    } while (0)
    __syncthreads();
    FX_LOADG(0, ks0, vs0);
    if (ntl > 1) FX_LOADG(1, ks1, vs1);
    FX_STORE(0, ks0, vs0);
    __syncthreads();
    for (int g = 0; g < ntl; g += 2) {
        if (g + 2 < ntl) FX_LOADG(g + 2, ks0, vs0);
        FX_TILE(g, 0);
        FX_STORE(STAGE, ks1, vs1);
        __syncthreads();
        if (g + 3 < ntl) FX_LOADG(g + 3, ks1, vs1);
        FX_TILE(g + 1, STAGE);
        if (g + 2 < ntl) FX_STORE(0, ks0, vs0);
        __syncthreads();
    }
#undef FX_SRC
#undef FX_LOADG
#undef FX_STORE
#undef FX_TILE
}
}


__device__ __forceinline__ float sss_total(const float* sss, int srow, int fq) {
    const f32x4* sp = (const f32x4*)(sss + (size_t)srow * 64 + fq * 16);
    const f32x4 a = sp[0], b = sp[1], c = sp[2], d = sp[3];
    float t = ((a[0] + a[1]) + (a[2] + a[3])) + ((b[0] + b[1]) + (b[2] + b[3])) + ((c[0] + c[1]) + (c[2] + c[3])) + ((d[0] + d[1]) + (d[2] + d[3]));
    t += __shfl_xor(t, 16); t += __shfl_xor(t, 32); return t;
}
struct SIn {
    const float* r0; bf16* zconv; bf16* qb; bf16* kb; bf16* vb; float* out;
    __device__ __forceinline__ int arow(int i) const { return i; }
    __device__ __forceinline__ void put(int srow, int col, f32x4 v, int fq, int cb) const {
        const size_t row = (size_t)MP + srow; v = v * r0[row];
        if (col < 1536) { *(GAS unsigned long long*)(zconv + row * 1536 + col) = (unsigned long long)pk2(v[0], v[1]) | ((unsigned long long)pk2(v[2], v[3]) << 32); }
        else if (col < 2048) { v = v * QSC; *(GAS unsigned long long*)(qb + row * 512 + (col - 1536)) = (unsigned long long)pk2(v[0], v[1]) | ((unsigned long long)pk2(v[2], v[3]) << 32); }
        else { const bool isk = col < 2560; const int c = col - (isk ? 2048 : 2560);
            *(GAS unsigned long long*)((isk ? kb : vb) + row * 512 + c) = (unsigned long long)pk2(v[0], v[1]) | ((unsigned long long)pk2(v[2], v[3]) << 32);
            *(f32x4*)(out + (isk ? O_KS : O_VS) + (size_t)srow * 512 + c) = v; }
    }
};
template <bool RESBF> struct SRes {
    const void* res; float* xo; bf16* xob; float* sss;
    __device__ __forceinline__ int arow(int i) const { return i; }
    __device__ __forceinline__ void put(int srow, int col, f32x4 v, int fq, int cb) const {
        f32x4 r;
        if (RESBF) { const unsigned long long w = *(const GAS unsigned long long*)((const bf16*)res + (size_t)srow * 1024 + col); r = (f32x4){bf_lo((unsigned)w), bf_hi((unsigned)w), bf_lo((unsigned)(w >> 32)), bf_hi((unsigned)(w >> 32))}; }
        else r = *(const f32x4*)((const float*)res + (size_t)srow * 1024 + col);
        const f32x4 o = r + v;
        if (xo) *(f32x4*)(xo + (size_t)srow * 1024 + col) = o;
        if (xob) *(GAS unsigned long long*)(xob + (size_t)srow * 1024 + col) = (unsigned long long)pk2(o[0], o[1]) | ((unsigned long long)pk2(o[2], o[3]) << 32);
        float sq = (o[0] * o[0] + o[1] * o[1]) + (o[2] * o[2] + o[3] * o[3]);
        sq += __shfl_xor(sq, 16); sq += __shfl_xor(sq, 32);
        if (fq == 0) sss[(size_t)srow * 64 + cb] = sq;
    }
};
struct SScale {
    const float* sss; bf16* O; int ldc; float cs;
    __device__ __forceinline__ int arow(int i) const { return i; }
    __device__ __forceinline__ void put(int srow, int col, f32x4 v, int fq, int cb) const {
        const float tot = sss_total(sss, srow, fq);
        v = v * (cs / sqrtf(tot * (1.0f / 1024.0f) + EPS));
        *(GAS unsigned long long*)(O + (size_t)srow * ldc + col) = (unsigned long long)pk2(v[0], v[1]) | ((unsigned long long)pk2(v[2], v[3]) << 32);
    }
};
constexpr size_t WS_HALO = WS_DPART;
constexpr int BL_OFF = LDSCTL_OFF + 512;
static_assert(BL_OFF + 10240 <= LDS_BYTES && WS_DPART + 128 * 5632 * 4 <= WS_END, "EpiUp buffers");
struct SUp {
    const float* sss; bf16* O;
    __device__ __forceinline__ int arow(int i) const { return i; }
    __device__ __forceinline__ void put(int srow, int col, f32x4 v, int fq, int cb) const {
        const float tot = sss_total(sss, srow, fq);
        v = v * (1.0f / sqrtf(tot * (1.0f / 1024.0f) + EPS));
        *(GAS unsigned long long*)(O + (size_t)srow * DUP + up_orig(col)) = (unsigned long long)pk2(v[0], v[1]) | ((unsigned long long)pk2(v[2], v[3]) << 32);
    }
};
struct SHalo {
    const float* ss; float* HB;
    __device__ __forceinline__ int arow(int i) const { const int r = 256 * (i >> 1) - 2 + (i & 1); return r < 0 ? 0 : r; }
    __device__ __forceinline__ void put(int hidx, int col, f32x4 v, int fq, int cb) const {
        const f32x4 s4 = *(const f32x4*)(ss + (size_t)arow(hidx) * 16 + fq * 4);
        float tot = (s4[0] + s4[1]) + (s4[2] + s4[3]); tot += __shfl_xor(tot, 16); tot += __shfl_xor(tot, 32);
        *(f32x4*)(HB + (size_t)hidx * DUP + col) = v * (1.0f / sqrtf(tot * (1.0f / 1024.0f) + EPS));
    }
};
template <int CTRL> __device__ __forceinline__ f32x4 dpp4o(const f32x4 old, const f32x4 v) {
    f32x4 r;
#pragma unroll
    for (int i = 0; i < 4; ++i) r[i] = __int_as_float(__builtin_amdgcn_update_dpp(__float_as_int(old[i]), __float_as_int(v[i]), CTRL, 0xF, 0xF, false));
    return r;
}
constexpr int WL_OFF = BL_OFF + 10240;
constexpr int RL_OFF = WL_OFF + 4096;
static_assert(RL_OFF + 1024 <= LDS_BYTES, "LDS tables");
struct EpiUp {
    static constexpr bool PERM = true, AFTER_DRAIN = false, APERM = true;
    const float* r2; const float* cw; const float* cb; const float* HB; bf16* act; float* out; LAS float* bl;
    __device__ __forceinline__ void operator()(const f32x4 (&acc)[2][2][4][2], const pg8::Unit& u, int wr, int wc, int fr, int fq) const {
        const int pn = u.pn, pm = u.pm, jc = wc * 32 + 8 * fq;
        LAS float* wl = bl + (WL_OFF - BL_OFF) / 4;
        f32x4 rs[2];
#pragma unroll
        for (int ai = 0; ai < 2; ++ai) rs[ai] = *(const f32x4*)(r2 + pm * 256 + ai * 128 + wr * 64 + 4 * fr);
        const int tid = threadIdx.x, widx = tid * 2, warr = widx >> 7, wch = widx & 127;
        const float* wsrc = (warr < 6 ? cw + (size_t)(warr >> 1) * DUP : cb) + ((warr & 1) ? DFF : 0) + 128 * pn + wch;
        const float w_a = wsrc[0], w_b = wsrc[1];
        const float hv = (pm & 15) != 0 ? HB[(size_t)(pm * 2 + (tid >> 8)) * DUP + pn * 256 + (tid & 255)] : 0.f;
        wl[widx] = w_a; wl[widx + 1] = w_b; bl[(4 * 2 + (tid >> 8)) * 256 + (tid & 255)] = hv;
        if (fr == 15) {
#pragma unroll
            for (int ai = 0; ai < 2; ++ai)
#pragma unroll
                for (int bj = 0; bj < 2; ++bj)
#pragma unroll
                    for (int n = 0; n < 2; ++n) { LAS float* bp = bl + ((ai * 2 + wr) * 2) * 256 + bj * 128 + jc + 4 * n; *(LAS f32x4*)bp = acc[ai][bj][2][n] * rs[ai][2]; *(LAS f32x4*)(bp + 256) = acc[ai][bj][3][n] * rs[ai][3]; }
        }
        asm volatile("s_waitcnt lgkmcnt(0)\n\ts_barrier" ::: "memory");
#pragma unroll
        for (int n = 0; n < 2; ++n) {
            const int gcol = 128 * pn + jc + 4 * n, ucol = DFF + gcol;
            const LAS float* wp = wl + jc + 4 * n;
            const f32x4 wg0 = *(const LAS f32x4*)(wp), wu0 = *(const LAS f32x4*)(wp + 128), wg1 = *(const LAS f32x4*)(wp + 256), wu1 = *(const LAS f32x4*)(wp + 384),
                        wg2 = *(const LAS f32x4*)(wp + 512), wu2 = *(const LAS f32x4*)(wp + 640), bg = *(const LAS f32x4*)(wp + 768), bu = *(const LAS f32x4*)(wp + 896);
#pragma unroll
            for (int ai = 0; ai < 2; ++ai) {
                const int B = ai * 2 + wr;
                f32x4 ag2 = (f32x4){0.f, 0.f, 0.f, 0.f}, ag3 = ag2, au2 = ag2, au3 = ag2;
                if (fr == 0) { const LAS float* bp = bl + ((B >= 1 ? B - 1 : 4) * 2) * 256 + jc + 4 * n; ag2 = *(const LAS f32x4*)bp; ag3 = *(const LAS f32x4*)(bp + 256); au2 = *(const LAS f32x4*)(bp + 128); au3 = *(const LAS f32x4*)(bp + 384); }
                f32x4 g[4], uu[4];
#pragma unroll
                for (int m = 0; m < 4; ++m) { g[m] = acc[ai][0][m][n] * rs[ai][m]; uu[m] = acc[ai][1][m][n] * rs[ai][m]; }
                const f32x4 pg2 = dpp4o<0x111>(ag2, g[2]), pg3 = dpp4o<0x111>(ag3, g[3]), pu2 = dpp4o<0x111>(au2, uu[2]), pu3 = dpp4o<0x111>(au3, uu[3]);
#pragma unroll
                for (int m = 0; m < 4; ++m) {
                    const f32x4 g1 = m >= 1 ? g[m >= 1 ? m - 1 : 0] : pg3, g2 = m >= 2 ? g[m >= 2 ? m - 2 : 0] : (m == 1 ? pg3 : pg2);
                    const f32x4 u1 = m >= 1 ? uu[m >= 1 ? m - 1 : 0] : pu3, u2 = m >= 2 ? uu[m >= 2 ? m - 2 : 0] : (m == 1 ? pu3 : pu2);
                    const f32x4 gc = bg + wg0 * g2 + wg1 * g1 + wg2 * g[m], uc = bu + wu0 * u2 + wu1 * u1 + wu2 * uu[m];
                    f32x4 a;
#pragma unroll
                    for (int i = 0; i < 4; ++i) a[i] = gc[i] * uc[i] * __builtin_amdgcn_rcpf(1.0f + ex2(-LOG2E * gc[i]));
                    const size_t row = (size_t)pm * 256 + ai * 128 + wr * 64 + 4 * fr + m;
                    *(GAS unsigned long long*)(act + row * DFF + gcol) = (unsigned long long)pk2(a[0], a[1]) | ((unsigned long long)pk2(a[2], a[3]) << 32);
                    if (m >= 2 && B == 3 && (pm & 15) == 15 && fr == 15) {
                        float* o = out + O_CFP + (size_t)((pm >> 4) * 2 + (m - 2)) * DUP; *(f32x4*)(o + gcol) = g[m]; *(f32x4*)(o + ucol) = uu[m]; }
                }
            }
        }
    }
};
struct SMem {
    const float* rmem; bf16* mkb; bf16* mvb; float* out;
    __device__ __forceinline__ int arow(int i) const { return i; }
    __device__ __forceinline__ void put(int row, int col, f32x4 v, int fq, int cb) const {
        v = v * rmem[row]; const bool isk = col < 1024; const int c = isk ? col : col - 1024;
        *(GAS unsigned long long*)((isk ? mkb : mvb) + (size_t)row * 1024 + c) = (unsigned long long)pk2(v[0], v[1]) | ((unsigned long long)pk2(v[2], v[3]) << 32);
        *(f32x4*)(out + (isk ? O_MK : O_MV) + (size_t)row * 1024 + c) = v;
    }
};
template <class SE> __device__ __forceinline__ void sgemm(const bf16* A, const bf16* Bt, int N, int K, const SE& E, LAS unsigned char* lds, int wave, int lane, int G, int wgoff, int nrb = 2) {
    const int fr = lane & 15, fq = lane >> 4;
    const int ncb = N >> 6, nunits = nrb * ncb;
    const int kper = K >> 3, nks = kper >> 5, kw0 = wave * kper;
    int vb = (int)blockIdx.x - wgoff; if (vb < 0) vb += G;
    for (int u = vb; u < nunits; u += G) {
        const int rbk = u % nrb, cbk = u / nrb;
        const bf16* ap[4]; const bf16* bp[4];
#pragma unroll
        for (int i = 0; i < 4; ++i) { ap[i] = A + (size_t)E.arow(rbk * 64 + i * 16 + fr) * K + kw0 + fq * 8; bp[i] = Bt + (size_t)(cbk * 64 + i * 16 + fr) * K + kw0 + fq * 8; }
        f32x4 acc[4][4];
#pragma unroll
        for (int i = 0; i < 4; ++i)
#pragma unroll
            for (int j = 0; j < 4; ++j) acc[i][j] = (f32x4){0.f, 0.f, 0.f, 0.f};
        for (int c0 = 0; c0 < nks; c0 += 4) {
            bf16x8 af[4][4], bfr[4][4];
#pragma unroll
            for (int s = 0; s < 4; ++s) if (c0 + s < nks) {
#pragma unroll
                for (int i = 0; i < 4; ++i) { af[s][i] = *(const GAS bf16x8*)(ap[i] + (c0 + s) * 32); bfr[s][i] = *(const GAS bf16x8*)(bp[i] + (c0 + s) * 32); } }
#pragma unroll
            for (int s = 0; s < 4; ++s) if (c0 + s < nks) {
#pragma unroll
                for (int i = 0; i < 4; ++i)
#pragma unroll
                    for (int j = 0; j < 4; ++j) acc[i][j] = __builtin_amdgcn_mfma_f32_16x16x32_bf16(bfr[s][j], af[s][i], acc[i][j], 0, 0, 0); }
        }
#pragma unroll
        for (int i = 0; i < 4; ++i)
#pragma unroll
            for (int j = 0; j < 4; ++j) *(LAS f32x4*)(lds + (size_t)(((wave * 16 + i * 4 + j) * 64 + lane) * 16)) = acc[i][j];
        __syncthreads();
#pragma unroll
        for (int tt = 0; tt < 2; ++tt) {
            const int tile = 2 * wave + tt, ti = tile >> 2, tj = tile & 3;
            f32x4 v = *(const LAS f32x4*)(lds + (size_t)(((0 * 16 + tile) * 64 + lane) * 16));
#pragma unroll
            for (int w2 = 1; w2 < 8; ++w2) v = v + *(const LAS f32x4*)(lds + (size_t)(((w2 * 16 + tile) * 64 + lane) * 16));
            E.put(rbk * 64 + ti * 16 + fr, cbk * 64 + tj * 16 + 4 * fq, v, fq, cbk * 4 + tj);
        }
        __syncthreads();
    }
}

constexpr int N_PHASES = 12;
#ifndef PROBE_REPS
#define PROBE_REPS {1,1,1,1,1,1,1,1,1,1,1,1}
#endif
constexpr int REPS[N_PHASES] = PROBE_REPS;
struct Args { const float* in[32]; float* out; unsigned char* ws; int ph_lo, ph_hi; };
__global__ void __launch_bounds__(NWAVES * 64, 2) mega_fwd(Args args) {
    extern __shared__ __attribute__((aligned(16))) unsigned char lds[];
    LAS unsigned char* L = (LAS unsigned char*)lds;
    volatile LAS unsigned* MISC = (volatile LAS unsigned*)(L + MISC_OFF);
    const int tid = threadIdx.x, lane = tid & 63, wave = __builtin_amdgcn_readfirstlane(tid >> 6);
    const int G = gridDim.x;
    Ptrs P;
#pragma unroll
    for (int i = 0; i < 32; ++i) P.in[i] = args.in[i];
    P.out = args.out; P.ws = args.ws;
    for (int u = tid; u < (LDS_BYTES - LDSCTL_OFF) / 4; u += NWAVES * 64) ((LAS unsigned*)(L + LDSCTL_OFF))[u] = 0u;
    __syncthreads();
    gu32* ctl = (gu32*)(P.ws + WS_CTL);
    XcdBarrier bar; bar.bar = (unsigned*)(ctl + CW_BAR); bar.x = 0; bar.st = nullptr;
#if !MK_PER_PHASE
    bar = xcd_barrier_post((unsigned*)(ctl + CW_BAR), MISC + 8);
#endif
    const int lo = args.ph_lo, hi = args.ph_hi;
#define IN(k) (lo <= (k) && (k) < hi)
#define SEAM(k) do { if (IN(k) && IN((k) + 1)) xcd_barrier(bar); } while (0)

    if (IN(0)) _Pragma("unroll") for (int rr_ = 0; rr_ < REPS[0]; ++rr_) { if (rr_) xcd_barrier(bar); p0_prologue(P, L, wave, lane, G); }
    SEAM(0);
    if (IN(1)) _Pragma("unroll") for (int rr_ = 0; rr_ < REPS[1]; ++rr_) { if (rr_) xcd_barrier(bar);
        { pg8::Gemm g{WSP(const bf16, WS_XB), WSP(const bf16, WS_WIN), MP, DIN, DM}; pg8::StaticOrder S; S.init(MP, DIN, G, (int)blockIdx.x);
          pg8::EpiIn E{WSP(const float, WS_R0), WSP(bf16, WS_ZCONV), WSP(bf16, WS_QB), WSP(bf16, WS_KB), WSP(bf16, WS_VB), P.out};
          pg8::gemm_phase<pg8::EpiIn, pg8::StaticOrder, true, true>(L + RING_OFF, g, S, E); }
        { SIn SE{WSP(const float, WS_R0), WSP(bf16, WS_ZCONV), WSP(bf16, WS_QB), WSP(bf16, WS_KB), WSP(bf16, WS_VB), P.out};
          sgemm<SIn>(WSP(const bf16, WS_XB) + (size_t)MP * DM, WSP(const bf16, WS_WIN), DIN, DM, SE, L + RING_OFF, wave, lane, G, 0); }
        { SMem SM{WSP(const float, WS_RMEM), WSP(bf16, WS_MKB), WSP(bf16, WS_MVB), P.out};
          sgemm<SMem>(WSP(const bf16, WS_MEMB), WSP(const bf16, WS_WCKV), 2 * DM, DM, SM, L + RING_OFF, wave, lane, G, 96, (NB * NMEM) / 64); }
    }
    SEAM(1);
    if (IN(2)) {
        const bool g1 = ((blockIdx.x >> 3) & 1) == 0;
        if (g1) { p_decode_split<0>(P, wave, lane, G); p_convmix(P, wave, lane, G); }
        fa::dattn_flash(P, L, wave, lane, G);
        if (!g1) { p_convmix(P, wave, lane, G); p_decode_split<0>(P, wave, lane, G); }
    }
    SEAM(2);
    if (IN(3)) _Pragma("unroll") for (int rr_ = 0; rr_ < REPS[3]; ++rr_) { if (rr_) xcd_barrier(bar); p_decode_combine(P, wave, lane, G); }
    SEAM(3);
    if (IN(4)) _Pragma("unroll") for (int rr_ = 0; rr_ < REPS[4]; ++rr_) { if (rr_) xcd_barrier(bar); pg8::Gemm g{WSP(const bf16, WS_MIX), WSP(const bf16, WS_WOUT), MP, DM, DM}; pg8::StaticOrder S; S.init(MP, DM, G, (int)blockIdx.x);
        pg8::EpiRes<true> E{WSP(const bf16, WS_XB), nullptr, WSP(bf16, WS_X1B), WSP(float, WS_SS1)};
        pg8::gemm_phase<pg8::EpiRes<true>, pg8::StaticOrder, true, true>(L + RING_OFF, g, S, E);
        SRes<false> SE{P.in[1], nullptr, WSP(bf16, WS_X1B) + (size_t)MP * DM, WSP(float, WS_SSS1)};
        sgemm<SRes<false>>(WSP(const bf16, WS_MIX) + (size_t)MP * DM, WSP(const bf16, WS_WOUT), DM, DM, SE, L + RING_OFF, wave, lane, G, 0); }
    SEAM(4);
    if (IN(5)) _Pragma("unroll") for (int rr_ = 0; rr_ < REPS[5]; ++rr_) { if (rr_) xcd_barrier(bar); pg8::Gemm g{WSP(const bf16, WS_X1B), WSP(const bf16, WS_WCQ), MP, DM, DM}; pg8::StaticOrder S; S.init(MP, DM, G, (int)blockIdx.x);
        LAS float* rl = (LAS float*)(L + RL_OFF);
        { pg8::Unit u0; if (S.next(0, u0) && tid < 256) { const f32x4* sp = (const f32x4*)(WSP(const float, WS_SS1) + (size_t)(u0.pm * 256 + tid) * 16); const f32x4 s0 = sp[0], s1 = sp[1], s2 = sp[2], s3 = sp[3];
              const float tot = ((s0[0] + s0[1]) + (s0[2] + s0[3])) + ((s1[0] + s1[1]) + (s1[2] + s1[3])) + ((s2[0] + s2[1]) + (s2[2] + s2[3])) + ((s3[0] + s3[1]) + (s3[2] + s3[3]));
              rl[tid] = CQSC / sqrtf(tot * (1.0f / 1024.0f) + EPS); } }
        __syncthreads();
        pg8::EpiScale E{rl, WSP(bf16, WS_QC), DM};
        pg8::gemm_phase<pg8::EpiScale, pg8::StaticOrder, true, true>(L + RING_OFF, g, S, E);
        SScale SE{WSP(const float, WS_SSS1), WSP(bf16, WS_QC) + (size_t)MP * DM, DM, CQSC};
        sgemm<SScale>(WSP(const bf16, WS_X1B) + (size_t)MP * DM, WSP(const bf16, WS_WCQ), DM, DM, SE, L + RING_OFF, wave, lane, G, 0); }
    SEAM(5);
    if (IN(6)) _Pragma("unroll") for (int rr_ = 0; rr_ < REPS[6]; ++rr_) { if (rr_) xcd_barrier(bar); p_xattn_sample(P, L, wave, lane, G, 0); fx::xattn_flash(P, L, wave, lane, G); }
    SEAM(6);
    if (IN(7)) _Pragma("unroll") for (int rr_ = 0; rr_ < REPS[7]; ++rr_) { if (rr_) xcd_barrier(bar); pg8::Gemm g{WSP(const bf16, WS_OC), WSP(const bf16, WS_WCO), MP, DM, DM}; pg8::StaticOrder S; S.init(MP, DM, G, (int)blockIdx.x);
        pg8::EpiRes<true> E{WSP(const bf16, WS_X1B), nullptr, WSP(bf16, WS_X2B), WSP(float, WS_SS2)};
        pg8::gemm_phase<pg8::EpiRes<true>, pg8::StaticOrder, true, true>(L + RING_OFF, g, S, E);
        SRes<true> SE{WSP(const bf16, WS_X1B) + (size_t)MP * DM, nullptr, WSP(bf16, WS_X2B) + (size_t)MP * DM, WSP(float, WS_SSS2)};
        sgemm<SRes<true>>(WSP(const bf16, WS_OC) + (size_t)MP * DM, WSP(const bf16, WS_WCO), DM, DM, SE, L + RING_OFF, wave, lane, G, 0); }
    SEAM(7);
    if (IN(8)) _Pragma("unroll") for (int rr_ = 0; rr_ < REPS[8]; ++rr_) { if (rr_) xcd_barrier(bar);
        { const float* ss2 = WSP(const float, WS_SS2); float* r2 = WSP(float, WS_R0);
          for (int row = blockIdx.x * (NWAVES * 64) + tid; row < MP; row += G * NWAVES * 64) { const f32x4* sp = (const f32x4*)(ss2 + (size_t)row * 16); const f32x4 s0 = sp[0], s1 = sp[1], s2 = sp[2], s3 = sp[3];
              const float tot = ((s0[0] + s0[1]) + (s0[2] + s0[3])) + ((s1[0] + s1[1]) + (s1[2] + s1[3])) + ((s2[0] + s2[1]) + (s2[2] + s2[3])) + ((s3[0] + s3[1]) + (s3[2] + s3[3]));
              r2[row] = 1.0f / sqrtf(tot * (1.0f / 1024.0f) + EPS); } }
        SHalo SH{WSP(const float, WS_SS2), WSP(float, WS_HALO)};
        sgemm<SHalo>(WSP(const bf16, WS_X2B), WSP(const bf16, WS_WUP), DUP, DM, SH, L + RING_OFF, wave, lane, G, 0);
        SUp SE{WSP(const float, WS_SSS2), WSP(bf16, WS_UPB) + (size_t)MP * DUP};
        sgemm<SUp>(WSP(const bf16, WS_X2B) + (size_t)MP * DM, WSP(const bf16, WS_WUP), DUP, DM, SE, L + RING_OFF, wave, lane, G, 176); }
    SEAM(8);
    if (IN(9)) _Pragma("unroll") for (int rr_ = 0; rr_ < REPS[9]; ++rr_) { if (rr_) xcd_barrier(bar); pg8::Gemm g{WSP(const bf16, WS_X2B), WSP(const bf16, WS_WUP), MP, DUP, DM}; pg8::StaticOrder S; S.init(MP, DUP, G, (int)blockIdx.x);
        EpiUp E{WSP(const float, WS_R0), P.in[28], P.in[29], WSP(const float, WS_HALO), WSP(bf16, WS_ACT), P.out, (LAS float*)(L + BL_OFF)};
        pg8::gemm_phase<EpiUp, pg8::StaticOrder, true, true>(L + RING_OFF, g, S, E);
        p_convffn(P, wave, lane, G); }
    SEAM(9);
    if (IN(10)) _Pragma("unroll") for (int rr_ = 0; rr_ < REPS[10]; ++rr_) { if (rr_) xcd_barrier(bar); pg8::Gemm g{WSP(const bf16, WS_ACT), WSP(const bf16, WS_WDOWN), MP, DM, DFF}; pg8::StaticOrder S; S.init(MP, DM, G, (int)blockIdx.x);
        pg8::EpiRes<true> E{WSP(const bf16, WS_X2B), WSP(float, WS_X3), nullptr, WSP(float, WS_SS3)};
        pg8::gemm_phase<pg8::EpiRes<true>, pg8::StaticOrder, true, true>(L + RING_OFF, g, S, E);
        SRes<true> SE{WSP(const bf16, WS_X2B) + (size_t)MP * DM, WSP(float, WS_X3) + (size_t)MP * DM, nullptr, WSP(float, WS_SSS3)};
        sgemm<SRes<true>>(WSP(const bf16, WS_ACT) + (size_t)MP * DFF, WSP(const bf16, WS_WDOWN), DM, DFF, SE, L + RING_OFF, wave, lane, G, 0); }
    SEAM(10);
    if (IN(11)) _Pragma("unroll") for (int rr_ = 0; rr_ < REPS[11]; ++rr_) { if (rr_) xcd_barrier(bar); p_final(P, wave, lane, G); }
#undef IN
#undef SEAM
}

extern "C" void kernel_launch(void* const* d_in, const int* in_sizes, int n_in, void* d_out, int out_size, void* d_ws, size_t ws_size, hipStream_t stream) {
    static int grid = 0;
    if (grid == 0) {
        if (n_in != 32 || out_size != (int)O_END || ws_size < WS_END) { fprintf(stderr, "kernel_launch: unexpected shapes: n_in %d out %d ws %zu\n", n_in, out_size, ws_size); grid = -1; return; }
        int dev = 0, cus = 0, per_cu = 0;
        if (hipGetDevice(&dev) != hipSuccess || hipDeviceGetAttribute(&cus, hipDeviceAttributeMultiprocessorCount, dev) != hipSuccess) { grid = -1; return; }
        if (hipFuncSetAttribute((const void*)mega_fwd, hipFuncAttributeMaxDynamicSharedMemorySize, LDS_BYTES) != hipSuccess) { fprintf(stderr, "kernel_launch: hipFuncSetAttribute failed\n"); grid = -1; return; }
        if (hipOccupancyMaxActiveBlocksPerMultiprocessor(&per_cu, (const void*)mega_fwd, NWAVES * 64, LDS_BYTES) != hipSuccess || per_cu < 1) fprintf(stderr, "kernel_launch: occupancy query reports %d\n", per_cu);
        (void)hipGetLastError();
        grid = cus;
    }
    if (grid < 0) return;
    if (hipMemsetAsync((char*)d_ws + WS_CTL, 0, CTL_ZERO_BYTES, stream) != hipSuccess) return;
    Args a{};
    for (int i = 0; i < 32; ++i) a.in[i] = (const float*)d_in[i];
    a.out = (float*)d_out; a.ws = (unsigned char*)d_ws;
#if MK_PER_PHASE
    for (int p = 0; p < N_PHASES; ++p) { a.ph_lo = p; a.ph_hi = p + 1; hipLaunchKernelGGL(mega_fwd, dim3(grid), dim3(NWAVES * 64), LDS_BYTES, stream, a); }
#else
    a.ph_lo = 0; a.ph_hi = N_PHASES; hipLaunchKernelGGL(mega_fwd, dim3(grid), dim3(NWAVES * 64), LDS_BYTES, stream, a);
#endif
}
```
